# Optimizing an MI355X kernel written in HIP

```python
import jax
import jax.numpy as jnp
from jax import lax
import numpy as np

D_MODEL = 1024
BATCH = 16
SEQ = 2048
DEPTH = 2

CTX_LEN = 256
GRID_W = 64
D_MIX = D_MODEL
ML_HEADS = 4
ML_DV = D_MIX // (2 * ML_HEADS)
ML_DK = ML_DV // 2
ML_CHUNK = 64
CONV_W = 5
NA_HEADS = 8
NA_DH = (D_MIX - ML_HEADS * ML_DV) // NA_HEADS
NA_WIN_H = 8
NA_WIN_W = 16
NA_QB = 16
NA_BAND_W = 2 * NA_WIN_W
ROPE_BASE = 10000.0
PEER_HEADS = 8
PEER_NKEYS = 128
PEER_EXPERTS = PEER_NKEYS * PEER_NKEYS
PEER_TOPK = 16
PEER_DKEY = 256
PEER_TB = 128
N_MOD = 6
ML_QK_W = 2 * ML_HEADS * ML_DK
ML_V_W = ML_HEADS * ML_DV
ML_G_W = 4 * ML_HEADS
NA_W = NA_HEADS * NA_DH
D_IN = ML_QK_W + 2 * ML_V_W + ML_G_W + 3 * NA_W
DEEPNORM_ALPHA = (2.0 * DEPTH) ** 0.25
DEEPNORM_BETA = (8.0 * DEPTH) ** -0.25
LN_EPS = 1e-5

kernel_name = 'hybrid_mlstm_natten_peer_dit'


def _layer_norm(x, w, b):
    xf = x.astype(jnp.float32)
    mu = xf.mean(-1, keepdims=True)
    var = jnp.square(xf - mu).mean(-1, keepdims=True)
    return ((xf - mu) * lax.rsqrt(var + LN_EPS) * w + b).astype(x.dtype)


def _modulation(cond, w, b):
    return jnp.split(jax.nn.silu(cond) @ w + b, N_MOD, axis=-1)


def _heads(t, h):
    return t.reshape(t.shape[0], t.shape[1], h, -1).transpose(0, 2, 1, 3)


def _merge_heads(t):
    return t.transpose(0, 2, 1, 3).reshape(t.shape[0], t.shape[2], -1)


def _split_in(p):
    sizes = (ML_QK_W, ML_V_W, ML_V_W, ML_G_W, NA_W, NA_W, NA_W)
    offs = [0]
    for s in sizes:
        offs.append(offs[-1] + s)
    return [p[..., a:b] for a, b in zip(offs[:-1], offs[1:])]


def _centred_dwconv(x, w):
    return lax.conv_general_dilated(
        x, w[:, None, :].astype(x.dtype), window_strides=(1,),
        padding=[(CONV_W // 2, CONV_W // 2)],
        dimension_numbers=('NWC', 'WIO', 'NWC'), feature_group_count=x.shape[-1])


def _axial_rope(t):
    T, d = t.shape[2], t.shape[-1]
    pos = jnp.arange(T)
    n_freq = d // 4
    inv = ROPE_BASE ** (-jnp.arange(n_freq, dtype=jnp.float32) / n_freq)
    ang = jnp.concatenate([(pos // GRID_W)[:, None] * inv, (pos % GRID_W)[:, None] * inv], -1)
    cos, sin = jnp.cos(ang), jnp.sin(ang)
    t1, t2 = t[..., : d // 2], t[..., d // 2:]
    return jnp.concatenate([t1 * cos - t2 * sin, t1 * sin + t2 * cos], -1).astype(t.dtype)


def _chunked(t):
    return t.reshape(t.shape[:2] + (t.shape[2] // ML_CHUNK, ML_CHUNK) + t.shape[3:])


def _mlstm_states(k, v, log_i, log_f, state):
    kc, vc = _chunked(k), _chunked(v)
    li, lf = _chunked(log_i), _chunked(log_f)
    b = jnp.cumsum(lf, axis=-1)
    b_last = b[..., -1]
    a = b_last[..., None] - b + li
    m_loc = a.max(-1)
    w = jnp.exp(a - m_loc[..., None])
    c_loc = jnp.einsum('bhcs,bhcsv,bhcsk->bhcvk', w, vc, kc)
    n_loc = jnp.einsum('bhcs,bhcsk->bhck', w, kc)

    def step(carry, xs):
        C, n, m = carry
        C_l, n_l, m_l, bl = xs
        m_new = jnp.maximum(bl + m, m_l)
        s_old = jnp.exp(bl + m - m_new)
        s_loc = jnp.exp(m_l - m_new)
        C_new = s_old[..., None, None] * C + s_loc[..., None, None] * C_l
        n_new = s_old[..., None] * n + s_loc[..., None] * n_l
        return (C_new, n_new, m_new), (C, n, m)

    front = lambda t: jnp.moveaxis(t, 2, 0)
    final, (c_in, n_in, m_in) = lax.scan(step, state, (front(c_loc), front(n_loc), front(m_loc), front(b_last)))
    back = lambda t: jnp.moveaxis(t, 0, 2)
    return (back(c_in), back(n_in), back(m_in)), final


def _mlstm_outputs(q, k, v, log_i, log_f, incoming):
    c_in, n_in, m_in = incoming
    qc, kc, vc = _chunked(q), _chunked(k), _chunked(v)
    li, lf = _chunked(log_i), _chunked(log_f)
    b = jnp.cumsum(lf, axis=-1)
    dmat = b[..., :, None] - b[..., None, :] + li[..., None, :]
    lower = jnp.tril(jnp.ones((ML_CHUNK, ML_CHUNK), bool))
    dmat = jnp.where(lower, dmat, -jnp.inf)
    m_inter = b + m_in[..., None]
    m_j = jnp.maximum(m_inter, dmat.max(-1))
    s = jnp.einsum('bhcjk,bhcsk->bhcjs', qc, kc) * jnp.exp(dmat - m_j[..., None])
    inter = jnp.exp(m_inter - m_j)
    num = jnp.einsum('bhcjs,bhcsv->bhcjv', s, vc) + inter[..., None] * jnp.einsum('bhcvk,bhcjk->bhcjv', c_in, qc)
    den = s.sum(-1) + inter * jnp.einsum('bhck,bhcjk->bhcj', n_in, qc)
    h = num / jnp.maximum(jnp.abs(den), jnp.exp(-m_j))[..., None]
    return h.reshape(h.shape[:2] + (-1, h.shape[-1]))


def _mlstm_bidir(qx, kx, vx, gx, qc, kc, vc, gc, need_ctx):
    B_ = qx.shape[0]
    f32 = jnp.float32
    zero = (jnp.zeros((B_, ML_HEADS, ML_DV, ML_DK), f32), jnp.zeros((B_, ML_HEADS, ML_DK), f32),
            jnp.zeros((B_, ML_HEADS), f32))
    hx, hc = [], []
    for d in range(2):
        o = (lambda t: t) if d == 0 else (lambda t: jnp.flip(t, axis=2))
        li_c, lf_c = o(gc[2 * d]), o(jax.nn.log_sigmoid(gc[2 * d + 1]))
        li_x, lf_x = o(gx[2 * d]), o(jax.nn.log_sigmoid(gx[2 * d + 1]))
        inc_c, final_c = _mlstm_states(o(kc), o(vc), li_c, lf_c, zero)
        inc_x, _ = _mlstm_states(o(kx), o(vx), li_x, lf_x, final_c)
        hx.append(o(_mlstm_outputs(o(qx), o(kx), o(vx), li_x, lf_x, inc_x)))
        if need_ctx:
            hc.append(o(_mlstm_outputs(o(qc), o(kc), o(vc), li_c, lf_c, inc_c)))
    return hx[0] + hx[1], (hc[0] + hc[1] if need_ctx else None)


def _head_norm(h, w):
    mu = h.mean(-1, keepdims=True)
    var = jnp.square(h - mu).mean(-1, keepdims=True)
    return _merge_heads((h - mu) * lax.rsqrt(var + LN_EPS)) * w


def _neighbourhood_attention(qx, kx, vx, qc, kc, vc, rpb, need_ctx):
    B_, T, _ = qx.shape
    rows = T // GRID_W
    kh = min(NA_WIN_H, rows)
    scale = NA_DH ** -0.5
    grid = lambda t: t.reshape(B_, rows, GRID_W, NA_HEADS, NA_DH).transpose(0, 3, 1, 2, 4)
    qg, kg, vg = grid(qx * scale), grid(kx), grid(vx)
    qh_c, kh_c, vh_c = _heads(qc * scale, NA_HEADS), _heads(kc, NA_HEADS), _heads(vc, NA_HEADS)
    n_cb = GRID_W // NA_QB
    q_cols = np.arange(GRID_W).reshape(n_cb, NA_QB)
    band_cols = np.clip(q_cols[:, :1] - NA_WIN_W // 2, 0, GRID_W - NA_BAND_W) + np.arange(NA_BAND_W)
    win_lo = np.clip(q_cols - NA_WIN_W // 2, 0, GRID_W - NA_WIN_W)[..., None]
    col_ok = (band_cols[:, None, :] >= win_lo) & (band_cols[:, None, :] < win_lo + NA_WIN_W)
    col_idx = np.clip(band_cols[:, None, :] - q_cols[..., None], 1 - NA_WIN_W, NA_WIN_W - 1) + NA_WIN_W - 1
    n_loc = kh * NA_BAND_W

    def row_block(r):
        r0 = jnp.clip(r - kh // 2, 0, rows - kh)
        k_band = lax.dynamic_slice_in_dim(kg, r0, kh, axis=2)[:, :, :, band_cols]
        v_band = lax.dynamic_slice_in_dim(vg, r0, kh, axis=2)[:, :, :, band_cols]
        q_blk = lax.dynamic_index_in_dim(qg, r, axis=2, keepdims=False).reshape(B_, NA_HEADS, n_cb, NA_QB, NA_DH)
        row_idx = r0 + jnp.arange(kh) - r + NA_WIN_H - 1
        bias = rpb[:, row_idx[None, None, :, None], col_idx[:, :, None, :]]
        s_loc = jnp.einsum('bhcqd,bhicjd->bhcqij', q_blk, k_band).astype(jnp.float32) + bias
        s_loc = jnp.where(col_ok[:, :, None, :], s_loc, -jnp.inf)
        s_ctx = jnp.einsum('bhcqd,bhnd->bhcqn', q_blk, kh_c).astype(jnp.float32)
        p = jax.nn.softmax(jnp.concatenate([s_loc.reshape(s_loc.shape[:4] + (n_loc,)), s_ctx], -1), axis=-1)
        p = p.astype(vx.dtype)
        out = (jnp.einsum('bhcqij,bhicjd->bhcqd', p[..., :n_loc].reshape(s_loc.shape), v_band)
               + jnp.einsum('bhcqn,bhnd->bhcqd', p[..., n_loc:], vh_c))
        return out.reshape(B_, NA_HEADS, GRID_W, NA_DH)

    out = lax.map(row_block, jnp.arange(rows))
    yx = out.transpose(1, 0, 3, 2, 4).reshape(B_, T, NA_W)
    yc = None
    if need_ctx:
        pc = jax.nn.softmax(jnp.einsum('bhnd,bhmd->bhnm', qh_c, kh_c).astype(jnp.float32), axis=-1)
        yc = _merge_heads(jnp.einsum('bhnm,bhmd->bhnd', pc.astype(vc.dtype), vh_c))
    return yx, yc


def _hybrid_mixer(ux, uc, w_in, b_gate, conv_w, ml_norm_w, rpb, w_out, need_ctx):
    f32 = jnp.float32
    px, pc = ux @ w_in, uc @ w_in

    def prep(p, rope):
        qk, v, o, g, nq, nk, nv = _split_in(p)
        qk = jax.nn.silu(_centred_dwconv(qk, conv_w)).astype(f32)
        q = _heads(qk[..., : ML_QK_W // 2], ML_HEADS)
        k = _heads(qk[..., ML_QK_W // 2:], ML_HEADS) * ML_DK ** -0.5
        if rope:
            q, k = _axial_rope(q), _axial_rope(k)
        gates = (g.astype(f32) + b_gate).reshape(g.shape[:2] + (4, ML_HEADS)).transpose(2, 0, 3, 1)
        return q, k, _heads(v.astype(f32), ML_HEADS), o, gates, nq, nk, nv

    qx, kx, vx, ox, gx, nqx, nkx, nvx = prep(px, True)
    qc, kc, vc, oc, gc, nqc, nkc, nvc = prep(pc, False)
    hx, hc = _mlstm_bidir(qx, kx, vx, gx, qc, kc, vc, gc, need_ctx)
    ml_x = (_head_norm(hx, ml_norm_w) * jax.nn.sigmoid(ox.astype(f32))).astype(ux.dtype)
    na_x, na_c = _neighbourhood_attention(nqx, nkx, nvx, nqc, nkc, nvc, rpb, need_ctx)
    yx = jnp.concatenate([ml_x, na_x], -1) @ w_out
    yc = None
    if need_ctx:
        ml_c = (_head_norm(hc, ml_norm_w) * jax.nn.sigmoid(oc.astype(f32))).astype(uc.dtype)
        yc = jnp.concatenate([ml_c, na_c], -1) @ w_out
    return yx, yc


def _peer(u, wq, sub_keys, up, down):
    B_, T, D = u.shape

    def block(ub):
        tb = ub.shape[0]
        q = (ub @ wq).reshape(tb, PEER_HEADS, 2, PEER_DKEY // 2)
        s1 = jnp.einsum('thd,hnd->thn', q[:, :, 0], sub_keys[:, 0])
        s2 = jnp.einsum('thd,hnd->thn', q[:, :, 1], sub_keys[:, 1])
        t1, i1 = lax.top_k(s1, PEER_TOPK)
        t2, i2 = lax.top_k(s2, PEER_TOPK)
        cand = (t1[..., :, None] + t2[..., None, :]).reshape(tb, PEER_HEADS, PEER_TOPK * PEER_TOPK)
        cidx = (i1[..., :, None] * PEER_NKEYS + i2[..., None, :]).reshape(tb, PEER_HEADS, PEER_TOPK * PEER_TOPK)
        top, pos = lax.top_k(cand, PEER_TOPK)
        eidx = jnp.take_along_axis(cidx, pos, -1).reshape(tb, PEER_HEADS * PEER_TOPK)
        g = jax.nn.softmax(top.astype(jnp.float32), axis=-1).reshape(tb, -1).astype(ub.dtype)
        act = jax.nn.gelu(jnp.einsum('td,tkd->tk', ub, up[eidx]))
        return jnp.einsum('tk,tkd->td', g * act, down[eidx])

    y = lax.map(block, u.reshape(B_ * T // PEER_TB, PEER_TB, D))
    return y.reshape(B_, T, D)


def setup_inputs(seed: int = 0) -> dict:
    key = jax.random.key(seed)
    ks = jax.random.split(key, 20)
    f32 = jnp.float32

    def nrm(k, shape, scale):
        return scale * jax.random.normal(k, shape, f32)

    L = DEPTH
    gate_base = jnp.repeat(jnp.array([0.0, 3.0, 0.0, 3.0], f32), ML_HEADS)
    return {
        'x': nrm(ks[0], (BATCH, SEQ, D_MODEL), 1.0),
        'c': nrm(ks[1], (BATCH, D_MODEL), 1.0),
        'ctx': nrm(ks[2], (BATCH, CTX_LEN, D_MODEL), 1.0),
        'c_ctx': nrm(ks[3], (D_MODEL,), 1.0),
        'ada_w': nrm(ks[4], (L, D_MODEL, N_MOD * D_MODEL), D_MODEL ** -0.5),
        'ada_b': nrm(ks[5], (L, N_MOD * D_MODEL), 0.02),
        'w_in': nrm(ks[6], (L, D_MODEL, D_IN), D_MODEL ** -0.5),
        'b_gate': gate_base + nrm(ks[7], (L, ML_G_W), 0.1),
        'conv_w': nrm(ks[8], (L, CONV_W, ML_QK_W), CONV_W ** -0.5),
        'ml_norm_w': 1.0 + nrm(ks[9], (L, ML_V_W), 0.1),
        'na_rpb': nrm(ks[10], (L, NA_HEADS, 2 * NA_WIN_H - 1, 2 * NA_WIN_W - 1), 0.1),
        'w_out': nrm(ks[11], (L, D_MIX, D_MODEL), DEEPNORM_BETA * D_MIX ** -0.5),
        'ln1_w': 1.0 + nrm(ks[12], (L, D_MODEL), 0.1),
        'ln1_b': nrm(ks[13], (L, D_MODEL), 0.02),
        'peer_wq': nrm(ks[14], (L, D_MODEL, PEER_HEADS * PEER_DKEY), D_MODEL ** -0.5),
        'peer_keys': nrm(ks[15], (L, PEER_HEADS, 2, PEER_NKEYS, PEER_DKEY // 2), (PEER_DKEY // 2) ** -0.5),
        'peer_up': nrm(ks[16], (L, PEER_EXPERTS, D_MODEL), D_MODEL ** -0.5),
        'peer_down': nrm(ks[17], (L, PEER_EXPERTS, D_MODEL), DEEPNORM_BETA),
        'ln2_w': 1.0 + nrm(ks[18], (L, D_MODEL), 0.1),
        'ln2_b': nrm(ks[19], (L, D_MODEL), 0.02),
    }


def reference(x, c, ctx, c_ctx, ada_w, ada_b, w_in, b_gate, conv_w, ml_norm_w, na_rpb, w_out,
              ln1_w, ln1_b, peer_wq, peer_keys, peer_up, peer_down, ln2_w, ln2_b):
    for l in range(DEPTH):
        need_ctx = l < DEPTH - 1
        sh1, sc1, g1, sh2, sc2, g2 = _modulation(c[:, None, :], ada_w[l], ada_b[l])
        csh1, csc1, cg1, csh2, csc2, cg2 = _modulation(c_ctx[None, None, :], ada_w[l], ada_b[l])
        ux = x * (1.0 + sc1) + sh1
        uc = ctx * (1.0 + csc1) + csh1
        yx, yc = _hybrid_mixer(ux, uc, w_in[l], b_gate[l], conv_w[l], ml_norm_w[l], na_rpb[l], w_out[l], need_ctx)
        x = _layer_norm(DEEPNORM_ALPHA * x + g1 * yx, ln1_w[l], ln1_b[l])
        fx = _peer(x * (1.0 + sc2) + sh2, peer_wq[l], peer_keys[l], peer_up[l], peer_down[l])
        x = _layer_norm(DEEPNORM_ALPHA * x + g2 * fx, ln2_w[l], ln2_b[l])
        if need_ctx:
            ctx = _layer_norm(DEEPNORM_ALPHA * ctx + cg1 * yc, ln1_w[l], ln1_b[l])
            fc = _peer(ctx * (1.0 + csc2) + csh2, peer_wq[l], peer_keys[l], peer_up[l], peer_down[l])
            ctx = _layer_norm(DEEPNORM_ALPHA * ctx + cg2 * fc, ln2_w[l], ln2_b[l])
    return x
```

```cpp
#include <hip/hip_runtime.h>
#include <hip/hip_cooperative_groups.h>
#include <cstdio>
#include <cstdint>
namespace cg = cooperative_groups;

#ifndef SINGLE_LAUNCH
#define SINGLE_LAUNCH 1
#endif

typedef unsigned short bf16_t;

constexpr int NT = 512;
constexpr int NW = NT / 64;
constexpr int D = 1024, NB = 16, T = 2048, CT = 256;
constexpr int ML = NB * T, MC = NB * CT, M = ML + MC;
constexpr int D_IN = 3088;
constexpr float ALPHA = 1.4142135623730951f;
constexpr float LN_EPS = 1e-5f;
constexpr int NSTEPS = 19;

constexpr size_t SZ_HALF = (size_t)M * 512 * 2;
constexpr size_t WS_MOD   = 0;
constexpr size_t WS_XCTX  = 1u << 20;
constexpr size_t WS_R1    = WS_XCTX + (size_t)MC * 1024 * 4;
constexpr size_t WS_QKRAW = WS_R1;
constexpr size_t WS_V     = WS_R1 + 1 * SZ_HALF;
constexpr size_t WS_O     = WS_R1 + 2 * SZ_HALF;
constexpr size_t WS_NQ    = WS_R1 + 3 * SZ_HALF;
constexpr size_t WS_NK    = WS_R1 + 4 * SZ_HALF;
constexpr size_t WS_NV    = WS_R1 + 5 * SZ_HALF;
constexpr size_t WS_Y     = WS_R1;
constexpr size_t WS_Q     = WS_R1 + 2 * SZ_HALF;
constexpr size_t WS_GATES = WS_R1 + 6 * SZ_HALF;
constexpr size_t WS_R3    = WS_GATES + (size_t)M * 16 * 4;
constexpr size_t WS_QKACT = WS_R3;
constexpr size_t WS_HDIR  = WS_R3 + SZ_HALF;
constexpr size_t WS_EIDX  = WS_R3;
constexpr size_t WS_EGATE = WS_R3 + (size_t)M * 128 * 4;
constexpr size_t WS_MIX   = WS_R3 + 3 * SZ_HALF;
constexpr size_t WS_U2    = WS_MIX;
constexpr size_t WS_END   = WS_MIX + 2 * SZ_HALF;

constexpr int LDS_BYTES = 120 * 1024;

struct P {
    const float *x, *c, *ctx, *c_ctx, *ada_w, *ada_b, *w_in, *b_gate, *conv_w, *ml_norm_w, *na_rpb, *w_out,
                *ln1_w, *ln1_b, *peer_wq, *peer_keys, *peer_up, *peer_down, *ln2_w, *ln2_b;
    float* out;
    unsigned char* ws;
};

__device__ __forceinline__ bf16_t f2bf(float f) {
    unsigned u = __float_as_uint(f);
    u += 0x7fffu + ((u >> 16) & 1u);
    return (bf16_t)(u >> 16);
}
__device__ __forceinline__ float bf2f(bf16_t h) { return __uint_as_float(((unsigned)h) << 16); }
__device__ __forceinline__ int opaque_tid() { int v = threadIdx.x; asm volatile("" : "+v"(v)); return v; }
__device__ __forceinline__ float wave_sum(float v) {
#pragma unroll
    for (int o = 32; o; o >>= 1) v += __shfl_xor(v, o);
    return v;
}
__device__ __forceinline__ float wave_max(float v) {
#pragma unroll
    for (int o = 32; o; o >>= 1) v = fmaxf(v, __shfl_xor(v, o));
    return v;
}
__device__ __forceinline__ float siluf(float v) { return v / (1.f + expf(-v)); }
__device__ __forceinline__ float sigmoidf(float v) { return 1.f / (1.f + expf(-v)); }
__device__ __forceinline__ float logsigmoidf(float v) { return fminf(v, 0.f) - log1pf(expf(-fabsf(v))); }
__device__ __forceinline__ float gelu_tanh(float v) {
    const float k0 = 0.7978845608028654f;
    return 0.5f * v * (1.f + tanhf(k0 * (v + 0.044715f * v * v * v)));
}
__device__ __forceinline__ int mod_row(int r) { return r < ML ? (r >> 11) : 16; }
__device__ __forceinline__ const float* xrow(const P& p, int l, int r) {
    if (r < ML) return (l == 0 ? p.x : (const float*)p.out) + (size_t)r * D;
    return (l == 0 ? p.ctx : (const float*)(p.ws + WS_XCTX)) + (size_t)(r - ML) * D;
}
__device__ __forceinline__ float* xrow_w(const P& p, int r) {
    if (r < ML) return p.out + (size_t)r * D;
    return (float*)(p.ws + WS_XCTX) + (size_t)(r - ML) * D;
}
__device__ __forceinline__ const float* modp(const P& p, int l, int r) {
    return (const float*)(p.ws + WS_MOD) + (size_t)(l * 17 + mod_row(r)) * 6144;
}

__device__ __forceinline__ void phase_mod(const P& p) {
    float* mod = (float*)(p.ws + WS_MOD);
    const int total = 2 * 17 * 6144;
    for (int i = blockIdx.x * NT + opaque_tid(); i < total; i += gridDim.x * NT) {
        const int col = i % 6144, mr = (i / 6144) % 17, l = i / (6144 * 17);
        const float* cond = mr < 16 ? p.c + mr * D : p.c_ctx;
        const float* w = p.ada_w + (size_t)l * D * 6144 + col;
        float acc = p.ada_b[l * 6144 + col];
        for (int k = 0; k < D; ++k) acc += siluf(cond[k]) * w[(size_t)k * 6144];
        mod[i] = acc;
    }
}

template <class ALoad, class Epi>
__device__ __forceinline__ void gemm_naive(int rows, int N, int K, const float* __restrict__ W, ALoad aload, Epi epi, float* sm) {
    float (*As)[65] = (float (*)[65])sm;
    float (*Bs)[64] = (float (*)[64])(sm + 16 * 65);
    constexpr int TM = 64 * 64 / NT / 4;
    const int tilesM = rows / 64, tilesN = (N + 63) / 64;
    const int tid = opaque_tid(), tx = tid % 16, ty = tid / 16;
    for (int tile = blockIdx.x; tile < tilesM * tilesN; tile += gridDim.x) {
        const int tm = tile / tilesN, tn = tile % tilesN;
        float acc[TM][4];
#pragma unroll
        for (int i = 0; i < TM; ++i)
#pragma unroll
            for (int j = 0; j < 4; ++j) acc[i][j] = 0.f;
        for (int k0 = 0; k0 < K; k0 += 16) {
            for (int i = tid; i < 1024; i += NT) { const int r = i / 16, kk = i % 16; As[kk][r] = aload(tm * 64 + r, k0 + kk); }
            for (int i = tid; i < 1024; i += NT) {
                const int kk = i / 64, n = i % 64, gn = tn * 64 + n;
                Bs[kk][n] = gn < N ? W[(size_t)(k0 + kk) * N + gn] : 0.f;
            }
            __syncthreads();
#pragma unroll
            for (int kk = 0; kk < 16; ++kk) {
                float a[TM], b[4];
#pragma unroll
                for (int i = 0; i < TM; ++i) a[i] = As[kk][ty * TM + i];
#pragma unroll
                for (int j = 0; j < 4; ++j) b[j] = Bs[kk][tx * 4 + j];
#pragma unroll
                for (int i = 0; i < TM; ++i)
#pragma unroll
                    for (int j = 0; j < 4; ++j) acc[i][j] += a[i] * b[j];
            }
            __syncthreads();
        }
#pragma unroll
        for (int i = 0; i < TM; ++i)
#pragma unroll
            for (int j = 0; j < 4; ++j) {
                const int gn = tn * 64 + tx * 4 + j;
                if (gn < N) epi(tm * 64 + ty * TM + i, gn, acc[i][j]);
            }
    }
}

__device__ __forceinline__ void phase_inproj(const P& p, int l, float* sm) {
    bf16_t* qkraw = (bf16_t*)(p.ws + WS_QKRAW); bf16_t* vb = (bf16_t*)(p.ws + WS_V); bf16_t* ob = (bf16_t*)(p.ws + WS_O);
    bf16_t* nq = (bf16_t*)(p.ws + WS_NQ); bf16_t* nk = (bf16_t*)(p.ws + WS_NK); bf16_t* nv = (bf16_t*)(p.ws + WS_NV);
    float* gates = (float*)(p.ws + WS_GATES);
    const float* bg = p.b_gate + l * 16;
    auto aload = [=](int r, int k) -> float {
        const float* xr = xrow(p, l, r); const float* mp = modp(p, l, r);
        return xr[k] * (1.f + mp[1024 + k]) + mp[k];
    };
    auto epi = [=](int r, int n, float v) {
        if (n < 512) qkraw[(size_t)r * 512 + n] = f2bf(v);
        else if (n < 1024) vb[(size_t)r * 512 + n - 512] = f2bf(v);
        else if (n < 1536) ob[(size_t)r * 512 + n - 1024] = f2bf(v);
        else if (n < 1552) gates[(size_t)r * 16 + n - 1536] = v + bg[n - 1536];
        else if (n < 2064) nq[(size_t)r * 512 + n - 1552] = f2bf(v * 0.125f);
        else if (n < 2576) nk[(size_t)r * 512 + n - 2064] = f2bf(v);
        else nv[(size_t)r * 512 + n - 2576] = f2bf(v);
    };
    gemm_naive(M, D_IN, D, p.w_in + (size_t)l * D * D_IN, aload, epi, sm);
}

__device__ __forceinline__ void phase_conv(const P& p, int l) {
    const bf16_t* qkraw = (const bf16_t*)(p.ws + WS_QKRAW);
    bf16_t* qkact = (bf16_t*)(p.ws + WS_QKACT);
    const float* cw = p.conv_w + l * 5 * 512;
    const long total = (long)M * 256;
    for (long i = (long)blockIdx.x * NT + opaque_tid(); i < total; i += (long)gridDim.x * NT) {
        const int r = (int)(i >> 8), hq = (int)((i >> 5) & 7), j = (int)(i & 31);
        const int c1 = hq * 64 + j, c2 = c1 + 32;
        int base, t, Ts;
        if (r < ML) { base = r & ~2047; t = r & 2047; Ts = T; } else { const int rc = r - ML; base = ML + (rc & ~255); t = rc & 255; Ts = CT; }
        float y1 = 0.f, y2 = 0.f;
#pragma unroll
        for (int jj = 0; jj < 5; ++jj) {
            const int tt = t + jj - 2;
            if (tt >= 0 && tt < Ts) {
                const size_t ro = (size_t)(base + tt) * 512;
                y1 += bf2f(qkraw[ro + c1]) * cw[jj * 512 + c1];
                y2 += bf2f(qkraw[ro + c2]) * cw[jj * 512 + c2];
            }
        }
        y1 = siluf(y1); y2 = siluf(y2);
        if (hq >= 4) { y1 *= 0.125f; y2 *= 0.125f; }
        if (r < ML) {
            const int pos = (j < 16) ? (t >> 6) : (t & 63);
            const float inv = powf(10000.f, -(float)(j & 15) / 16.f);
            const float ang = (float)pos * inv;
            const float cs = cosf(ang), sn = sinf(ang);
            const float o1 = y1 * cs - y2 * sn, o2 = y1 * sn + y2 * cs;
            y1 = o1; y2 = o2;
        }
        qkact[(size_t)r * 512 + c1] = f2bf(y1);
        qkact[(size_t)r * 512 + c2] = f2bf(y2);
    }
}

__device__ __forceinline__ void phase_mlstm(const P& p, int l, float* sm) {
    const bool need_ctx = (l == 0);
    const bf16_t* qkact = (const bf16_t*)(p.ws + WS_QKACT);
    const bf16_t* vb = (const bf16_t*)(p.ws + WS_V);
    const float* gates = (const float*)(p.ws + WS_GATES);
    bf16_t* hdir = (bf16_t*)(p.ws + WS_HDIR);
    float* Cs = sm;
    float* qs = Cs + 128 * 65;
    float* ks = qs + 64 * 65;
    float* vs = ks + 64 * 65;
    float* Ss = vs + 64 * 129;
    float* li = Ss + 64 * 65;
    float* bb = li + 64;
    float* gg = bb + 64;
    float* Mj = gg + 64;
    float* den = Mj + 64;
    float* inter = den + 64;
    float* nvec = inter + 64;
    float* wgt = nvec + 64;
    float* msc = wgt + 64;
    const int tid = opaque_tid();
    for (int item = blockIdx.x; item < NB * 4 * 2; item += gridDim.x) {
        const int dir = item & 1, h = (item >> 1) & 3, b = item >> 3;
        for (int i = tid; i < 128 * 65; i += NT) Cs[i] = 0.f;
        if (tid < 64) nvec[tid] = 0.f;
        if (tid == 0) msc[0] = 0.f;
        __syncthreads();
        for (int ci = 0; ci < 36; ++ci) {
            const bool isctx = ci < 4;
            const int base = isctx ? ML + b * CT : b * T;
            const int Ts = isctx ? CT : T;
            const int cl = isctx ? ci : ci - 4;
            const bool do_out = (!isctx) || need_ctx;
            for (int i = tid; i < 64 * 64; i += NT) {
                const int s = i >> 6, d = i & 63;
                const int pos = cl * 64 + s; const int t = dir ? Ts - 1 - pos : pos;
                const size_t ro = (size_t)(base + t) * 512;
                qs[s * 65 + d] = bf2f(qkact[ro + h * 64 + d]);
                ks[s * 65 + d] = bf2f(qkact[ro + 256 + h * 64 + d]);
            }
            for (int i = tid; i < 64 * 128; i += NT) {
                const int s = i >> 7, d = i & 127;
                const int pos = cl * 64 + s; const int t = dir ? Ts - 1 - pos : pos;
                vs[s * 129 + d] = bf2f(vb[(size_t)(base + t) * 512 + h * 128 + d]);
            }
            if (tid < 64) {
                const int pos = cl * 64 + tid; const int t = dir ? Ts - 1 - pos : pos;
                const float* g = gates + (size_t)(base + t) * 16;
                li[tid] = g[(2 * dir) * 4 + h];
                bb[tid] = logsigmoidf(g[(2 * dir + 1) * 4 + h]);
            }
            __syncthreads();
            if (tid == 0) {
                const float m = msc[0];
                float cum = 0.f, pm = -INFINITY;
                for (int s = 0; s < 64; ++s) {
                    cum += bb[s]; bb[s] = cum;
                    const float g = li[s] - cum; gg[s] = g;
                    pm = fmaxf(pm, g);
                    Mj[s] = fmaxf(m, pm);
                }
            }
            __syncthreads();
            const float m_in = msc[0];
            if (do_out) {
                for (int i = tid; i < 64 * 64; i += NT) {
                    const int j = i >> 6, s = i & 63;
                    float val = 0.f;
                    if (s <= j) {
                        float dot = 0.f;
#pragma unroll 8
                        for (int d = 0; d < 64; ++d) dot += qs[j * 65 + d] * ks[s * 65 + d];
                        val = dot * expf(gg[s] - Mj[j]);
                    }
                    Ss[j * 65 + s] = val;
                }
                __syncthreads();
                if (tid < 64) {
                    const int j = tid;
                    float ds = 0.f, nq = 0.f;
                    for (int s = 0; s < 64; ++s) ds += Ss[j * 65 + s];
                    for (int d = 0; d < 64; ++d) nq += nvec[d] * qs[j * 65 + d];
                    const float it = expf(m_in - Mj[j]);
                    inter[j] = it;
                    den[j] = ds + it * nq;
                }
                __syncthreads();
                for (int i = tid; i < 64 * 128; i += NT) {
                    const int j = i >> 7, vv = i & 127;
                    float a = 0.f, cq = 0.f;
#pragma unroll 8
                    for (int s = 0; s < 64; ++s) a += Ss[j * 65 + s] * vs[s * 129 + vv];
#pragma unroll 8
                    for (int d = 0; d < 64; ++d) cq += Cs[vv * 65 + d] * qs[j * 65 + d];
                    const float num = a + inter[j] * cq;
                    const float dn = fmaxf(fabsf(den[j]), expf(-(bb[j] + Mj[j])));
                    const int pos = cl * 64 + j; const int t = dir ? Ts - 1 - pos : pos;
                    hdir[((size_t)dir * M + base + t) * 512 + h * 128 + vv] = f2bf(num / dn);
                }
                __syncthreads();
            }
            if (tid < 64) wgt[tid] = expf(gg[tid] - Mj[63]);
            __syncthreads();
            const float so = expf(m_in - Mj[63]);
            for (int i = tid; i < 128 * 64; i += NT) {
                const int vv = i >> 6, kk = i & 63;
                float a = 0.f;
#pragma unroll 8
                for (int s = 0; s < 64; ++s) a += wgt[s] * vs[s * 129 + vv] * ks[s * 65 + kk];
                Cs[vv * 65 + kk] = so * Cs[vv * 65 + kk] + a;
            }
            if (tid < 64) {
                float a = 0.f;
                for (int s = 0; s < 64; ++s) a += wgt[s] * ks[s * 65 + tid];
                nvec[tid] = so * nvec[tid] + a;
            }
            __syncthreads();
            if (tid == 0) msc[0] = bb[63] + Mj[63];
            __syncthreads();
        }
    }
}

__device__ __forceinline__ void phase_na(const P& p, int l, float* sm) {
    const bool need_ctx = (l == 0);
    const bf16_t* nq = (const bf16_t*)(p.ws + WS_NQ); const bf16_t* nk = (const bf16_t*)(p.ws + WS_NK); const bf16_t* nv = (const bf16_t*)(p.ws + WS_NV);
    bf16_t* mix = (bf16_t*)(p.ws + WS_MIX);
    const int tid_ = opaque_tid(); const int lane = tid_ & 63, wave = tid_ >> 6;
    float* qv = sm + wave * 448;
    float* pb = qv + 64;
    const int rows = need_ctx ? M : ML;
    const long nitems = (long)rows * 8;
    for (long item = (long)blockIdx.x * NW + wave; item < nitems; item += (long)gridDim.x * NW) {
        const int r = (int)(item >> 3), h = (int)(item & 7);
        qv[lane] = bf2f(nq[(size_t)r * 512 + h * 64 + lane]);
        __builtin_amdgcn_wave_barrier();
        const bool lat = r < ML;
        int b, qr = 0, qc = 0, r0 = 0, wl = 0;
        if (lat) { b = r >> 11; const int t = r & 2047; qr = t >> 6; qc = t & 63; r0 = min(max(qr - 4, 0), 24); wl = min(max(qc - 8, 0), 48); }
        else b = (r - ML) >> 8;
        const float* rpb = p.na_rpb + (size_t)(l * 8 + h) * 15 * 31;
        float sc[6];
#pragma unroll
        for (int sl = 0; sl < 6; ++sl) {
            float s = -INFINITY;
            int krow = -1; float bias = 0.f;
            if (sl < 2) {
                if (lat) { const int i = sl * 64 + lane; const int kr = r0 + (i >> 4), kc = wl + (i & 15); krow = b * T + kr * 64 + kc; bias = rpb[(kr - qr + 7) * 31 + (kc - qc + 15)]; }
            } else { krow = ML + b * CT + (sl - 2) * 64 + lane; }
            if (krow >= 0) {
                const bf16_t* kp = nk + (size_t)krow * 512 + h * 64;
                float dot = 0.f;
#pragma unroll 8
                for (int d = 0; d < 64; ++d) dot += qv[d] * bf2f(kp[d]);
                s = dot + bias;
            }
            sc[sl] = s;
        }
        float mx = sc[0];
#pragma unroll
        for (int sl = 1; sl < 6; ++sl) mx = fmaxf(mx, sc[sl]);
        mx = wave_max(mx);
        float sum = 0.f;
#pragma unroll
        for (int sl = 0; sl < 6; ++sl) { sc[sl] = expf(sc[sl] - mx); sum += sc[sl]; }
        sum = wave_sum(sum);
        const float rs = 1.f / sum;
#pragma unroll
        for (int sl = 0; sl < 6; ++sl) pb[sl * 64 + lane] = sc[sl] * rs;
        __builtin_amdgcn_wave_barrier();
        float acc = 0.f;
        if (lat) {
            for (int i = 0; i < 128; ++i) {
                const int kr = r0 + (i >> 4), kc = wl + (i & 15);
                acc += pb[i] * bf2f(nv[(size_t)(b * T + kr * 64 + kc) * 512 + h * 64 + lane]);
            }
        }
        for (int i = 0; i < 256; ++i) acc += pb[128 + i] * bf2f(nv[(size_t)(ML + b * CT + i) * 512 + h * 64 + lane]);
        mix[(size_t)r * 1024 + 512 + h * 64 + lane] = f2bf(acc);
        __builtin_amdgcn_wave_barrier();
    }
}

__device__ __forceinline__ void phase_combine(const P& p, int l) {
    const bool need_ctx = (l == 0);
    const bf16_t* hdir = (const bf16_t*)(p.ws + WS_HDIR); const bf16_t* ob = (const bf16_t*)(p.ws + WS_O);
    bf16_t* mix = (bf16_t*)(p.ws + WS_MIX);
    const float* nw = p.ml_norm_w + l * 512;
    const int tid_ = opaque_tid(); const int lane = tid_ & 63, wave = tid_ >> 6;
    const int rows = need_ctx ? M : ML;
    const long nitems = (long)rows * 4;
    for (long item = (long)blockIdx.x * NW + wave; item < nitems; item += (long)gridDim.x * NW) {
        const int r = (int)(item >> 2), h = (int)(item & 3);
        const size_t o0 = (size_t)r * 512 + h * 128 + lane, o1 = o0 + 64;
        const float a0 = bf2f(hdir[o0]) + bf2f(hdir[(size_t)M * 512 + o0]);
        const float a1 = bf2f(hdir[o1]) + bf2f(hdir[(size_t)M * 512 + o1]);
        const float mu = wave_sum(a0 + a1) * (1.f / 128.f);
        const float d0 = a0 - mu, d1 = a1 - mu;
        const float var = wave_sum(d0 * d0 + d1 * d1) * (1.f / 128.f);
        const float rstd = rsqrtf(var + LN_EPS);
        const int c0 = h * 128 + lane, c1 = c0 + 64;
        mix[(size_t)r * 1024 + c0] = f2bf(d0 * rstd * nw[c0] * sigmoidf(bf2f(ob[o0])));
        mix[(size_t)r * 1024 + c1] = f2bf(d1 * rstd * nw[c1] * sigmoidf(bf2f(ob[o1])));
    }
}

__device__ __forceinline__ void phase_outproj(const P& p, int l, float* sm) {
    const bf16_t* mix = (const bf16_t*)(p.ws + WS_MIX);
    bf16_t* y = (bf16_t*)(p.ws + WS_Y);
    auto aload = [=](int r, int k) -> float { return bf2f(mix[(size_t)r * 1024 + k]); };
    auto epi = [=](int r, int n, float v) { y[(size_t)r * 1024 + n] = f2bf(v); };
    gemm_naive(l == 0 ? M : ML, D, D, p.w_out + (size_t)l * D * D, aload, epi, sm);
}

__device__ __forceinline__ void phase_ln1(const P& p, int l) {
    const bf16_t* y = (const bf16_t*)(p.ws + WS_Y);
    bf16_t* u2 = (bf16_t*)(p.ws + WS_U2);
    const float* lw = p.ln1_w + l * D; const float* lb = p.ln1_b + l * D;
    const int tid_ = opaque_tid(); const int lane = tid_ & 63, wave = tid_ >> 6;
    const int rows = (l == 0) ? M : ML;
    for (int r = blockIdx.x * NW + wave; r < rows; r += gridDim.x * NW) {
        const float* xr = xrow(p, l, r); const float* mp = modp(p, l, r);
        float z[16];
        float s = 0.f;
#pragma unroll
        for (int i = 0; i < 4; ++i)
#pragma unroll
            for (int c = 0; c < 4; ++c) {
                const int k = i * 256 + lane * 4 + c;
                const float v = ALPHA * xr[k] + mp[2048 + k] * bf2f(y[(size_t)r * 1024 + k]);
                z[i * 4 + c] = v; s += v;
            }
        const float mu = wave_sum(s) * (1.f / 1024.f);
        float q = 0.f;
#pragma unroll
        for (int i = 0; i < 16; ++i) { const float d = z[i] - mu; q += d * d; }
        const float rstd = rsqrtf(wave_sum(q) * (1.f / 1024.f) + LN_EPS);
        float* xo = xrow_w(p, r);
#pragma unroll
        for (int i = 0; i < 4; ++i)
#pragma unroll
            for (int c = 0; c < 4; ++c) {
                const int k = i * 256 + lane * 4 + c;
                const float x1 = (z[i * 4 + c] - mu) * rstd * lw[k] + lb[k];
                xo[k] = x1;
                u2[(size_t)r * 1024 + k] = f2bf(x1 * (1.f + mp[4096 + k]) + mp[3072 + k]);
            }
    }
}

__device__ __forceinline__ void phase_peerq(const P& p, int l, float* sm) {
    const bf16_t* u2 = (const bf16_t*)(p.ws + WS_U2);
    bf16_t* q = (bf16_t*)(p.ws + WS_Q);
    auto aload = [=](int r, int k) -> float { return bf2f(u2[(size_t)r * 1024 + k]); };
    auto epi = [=](int r, int n, float v) { q[(size_t)r * 2048 + n] = f2bf(v); };
    gemm_naive(l == 0 ? M : ML, 2048, D, p.peer_wq + (size_t)l * D * 2048, aload, epi, sm);
}

__device__ __forceinline__ void wave_argmax(float& bv, int& bi) {
#pragma unroll
    for (int o = 32; o; o >>= 1) {
        const float ov = __shfl_xor(bv, o); const int oi = __shfl_xor(bi, o);
        if (ov > bv || (ov == bv && oi < bi)) { bv = ov; bi = oi; }
    }
}
__device__ __forceinline__ void phase_topk(const P& p, int l, float* sm) {
    const bf16_t* q = (const bf16_t*)(p.ws + WS_Q);
    int* eidx = (int*)(p.ws + WS_EIDX); float* egate = (float*)(p.ws + WS_EGATE);
    const int tid_ = opaque_tid(); const int lane = tid_ & 63, wave = tid_ >> 6;
    float* qv = sm + wave * 384;
    float* tt = qv + 256;
    int* ti = (int*)(tt + 32);
    const int rows = (l == 0) ? M : ML;
    const long nitems = (long)rows * 8;
    for (long item = (long)blockIdx.x * NW + wave; item < nitems; item += (long)gridDim.x * NW) {
        const int r = (int)(item >> 3), h = (int)(item & 7);
#pragma unroll
        for (int i = 0; i < 4; ++i) qv[i * 64 + lane] = bf2f(q[(size_t)r * 2048 + h * 256 + i * 64 + lane]);
        __builtin_amdgcn_wave_barrier();
#pragma unroll
        for (int half = 0; half < 2; ++half) {
            const float* kb = p.peer_keys + ((size_t)((l * 8 + h) * 2 + half)) * 128 * 128;
            float v0 = 0.f, v1 = 0.f;
            const float* k0 = kb + (size_t)lane * 128; const float* k1 = kb + (size_t)(lane + 64) * 128;
            for (int d = 0; d < 128; ++d) { const float qd = qv[half * 128 + d]; v0 += qd * k0[d]; v1 += qd * k1[d]; }
            for (int j = 0; j < 16; ++j) {
                float bv; int bi;
                if (v0 >= v1) { bv = v0; bi = lane; } else { bv = v1; bi = lane + 64; }
                wave_argmax(bv, bi);
                if (lane == 0) { tt[half * 16 + j] = bv; ti[half * 16 + j] = bi; }
                if (bi == lane) v0 = -INFINITY; else if (bi == lane + 64) v1 = -INFINITY;
            }
        }
        __builtin_amdgcn_wave_barrier();
        float cv[4];
#pragma unroll
        for (int qd = 0; qd < 4; ++qd) { const int ci = lane + 64 * qd; cv[qd] = tt[ci >> 4] + tt[16 + (ci & 15)]; }
        float myv = -INFINITY; int myc = 0;
        for (int j = 0; j < 16; ++j) {
            float bv = cv[0]; int bi = lane;
#pragma unroll
            for (int qd = 1; qd < 4; ++qd) if (cv[qd] > bv) { bv = cv[qd]; bi = lane + 64 * qd; }
            wave_argmax(bv, bi);
            if (lane == j) { myv = bv; myc = bi; }
#pragma unroll
            for (int qd = 0; qd < 4; ++qd) if (bi == lane + 64 * qd) cv[qd] = -INFINITY;
        }
        const float top0 = __shfl(myv, 0);
        const float e = lane < 16 ? expf(myv - top0) : 0.f;
        const float es = wave_sum(e);
        if (lane < 16) {
            eidx[(size_t)r * 128 + h * 16 + lane] = ti[myc >> 4] * 128 + ti[16 + (myc & 15)];
            egate[(size_t)r * 128 + h * 16 + lane] = e / es;
        }
        __builtin_amdgcn_wave_barrier();
    }
}

__device__ __forceinline__ void phase_expert(const P& p, int l, float* sm) {
    const bf16_t* u2 = (const bf16_t*)(p.ws + WS_U2);
    const int* eidx = (const int*)(p.ws + WS_EIDX); const float* egate = (const float*)(p.ws + WS_EGATE);
    const float* up = p.peer_up + (size_t)l * 16384 * 1024; const float* down = p.peer_down + (size_t)l * 16384 * 1024;
    const float* lw = p.ln2_w + l * D; const float* lb = p.ln2_b + l * D;
    const int tid = opaque_tid(), lane = tid & 63, wave = tid >> 6;
    float* ys = sm;
    float* red = sm + NW * 1024;
    const int rows = (l == 0) ? M : ML;
    for (int r = blockIdx.x; r < rows; r += gridDim.x) {
        float u[16], y[16];
#pragma unroll
        for (int i = 0; i < 4; ++i)
#pragma unroll
            for (int c = 0; c < 4; ++c) { u[i * 4 + c] = bf2f(u2[(size_t)r * 1024 + i * 256 + lane * 4 + c]); y[i * 4 + c] = 0.f; }
        for (int j = wave; j < 128; j += NW) {
            const int e = eidx[(size_t)r * 128 + j]; const float g = egate[(size_t)r * 128 + j];
            const float4* ur = (const float4*)(up + (size_t)e * 1024);
            const float4* dr = (const float4*)(down + (size_t)e * 1024);
            float dot = 0.f;
#pragma unroll
            for (int i = 0; i < 4; ++i) { const float4 w = ur[i * 64 + lane]; dot += u[i * 4] * w.x + u[i * 4 + 1] * w.y + u[i * 4 + 2] * w.z + u[i * 4 + 3] * w.w; }
            dot = wave_sum(dot);
            const float a = g * gelu_tanh(dot);
#pragma unroll
            for (int i = 0; i < 4; ++i) { const float4 w = dr[i * 64 + lane]; y[i * 4] += a * w.x; y[i * 4 + 1] += a * w.y; y[i * 4 + 2] += a * w.z; y[i * 4 + 3] += a * w.w; }
        }
#pragma unroll
        for (int i = 0; i < 4; ++i)
#pragma unroll
            for (int c = 0; c < 4; ++c) ys[wave * 1024 + i * 256 + lane * 4 + c] = y[i * 4 + c];
        __syncthreads();
        const float* mp = modp(p, l, r);
        float* xo = xrow_w(p, r);
        float z[2]; float s = 0.f;
#pragma unroll
        for (int c = 0; c < 2; ++c) {
            const int k = tid * 2 + c;
            float fx = 0.f;
#pragma unroll
            for (int w = 0; w < NW; ++w) fx += ys[w * 1024 + k];
            z[c] = ALPHA * xo[k] + mp[5120 + k] * fx; s += z[c];
        }
        s = wave_sum(s);
        if (lane == 0) red[wave] = s;
        __syncthreads();
        float tot = 0.f;
#pragma unroll
        for (int w = 0; w < NW; ++w) tot += red[w];
        const float mu = tot * (1.f / 1024.f);
        float qd = 0.f;
#pragma unroll
        for (int c = 0; c < 2; ++c) { const float d = z[c] - mu; qd += d * d; }
        qd = wave_sum(qd);
        if (lane == 0) red[NW + wave] = qd;
        __syncthreads();
        float tq = 0.f;
#pragma unroll
        for (int w = 0; w < NW; ++w) tq += red[NW + w];
        const float rstd = rsqrtf(tq * (1.f / 1024.f) + LN_EPS);
#pragma unroll
        for (int c = 0; c < 2; ++c) { const int k = tid * 2 + c; xo[k] = (z[c] - mu) * rstd * lw[k] + lb[k]; }
        __syncthreads();
    }
}

__global__ void __launch_bounds__(NT) mega(P p, int lo, int hi) {
    extern __shared__ __attribute__((aligned(16))) unsigned char smem_raw[];
    float* sm = (float*)smem_raw;
    cg::grid_group grid = cg::this_grid();
#define STEP(k, body) do { const int k_ = (k); if (lo <= k_ && k_ < hi) { body; if (k_ + 1 < hi) grid.sync(); } } while (0)
    STEP(0, phase_mod(p));
#pragma unroll 1
    for (int l = 0; l < 2; ++l) {
        const int s0 = 1 + 9 * l;
        STEP(s0 + 0, phase_inproj(p, l, sm));
        STEP(s0 + 1, phase_conv(p, l));
        STEP(s0 + 2, { phase_mlstm(p, l, sm); __syncthreads(); phase_na(p, l, sm); });
        STEP(s0 + 3, phase_combine(p, l));
        STEP(s0 + 4, phase_outproj(p, l, sm));
        STEP(s0 + 5, phase_ln1(p, l));
        STEP(s0 + 6, phase_peerq(p, l, sm));
        STEP(s0 + 7, phase_topk(p, l, sm));
        STEP(s0 + 8, phase_expert(p, l, sm));
    }
#undef STEP
}

extern "C" void kernel_launch(void* const* d_in, const int* in_sizes, int n_in, void* d_out, int out_size, void* d_ws,
                              size_t ws_size, hipStream_t stream) {
    static int grid_blocks = 0;
    if (!grid_blocks) {
        int dev = 0, cus = 0, per_cu = 0;
        hipGetDevice(&dev);
        hipDeviceGetAttribute(&cus, hipDeviceAttributeMultiprocessorCount, dev);
        hipFuncSetAttribute((const void*)mega, hipFuncAttributeMaxDynamicSharedMemorySize, LDS_BYTES);
        hipOccupancyMaxActiveBlocksPerMultiprocessor(&per_cu, (const void*)mega, NT, LDS_BYTES);
        if (per_cu < 1) per_cu = 1;
        grid_blocks = cus * per_cu;
        if (ws_size < WS_END) fprintf(stderr, "kernel_launch: workspace too small: %zu < %zu\n", ws_size, (size_t)WS_END);
    }
    P p{};
    const float** pp = (const float**)&p;
    for (int i = 0; i < 20; ++i) pp[i] = (const float*)d_in[i];
    p.out = (float*)d_out;
    p.ws = (unsigned char*)d_ws;
#if SINGLE_LAUNCH
    int lo = 0, hi = NSTEPS;
    void* args[] = {&p, &lo, &hi};
    hipError_t e = hipLaunchCooperativeKernel((const void*)mega, dim3(grid_blocks), dim3(NT), args, LDS_BYTES, stream);
    if (e != hipSuccess) fprintf(stderr, "cooperative launch failed: %s (grid %d)\n", hipGetErrorString(e), grid_blocks);
#else
    for (int s = 0; s < NSTEPS; ++s) {
        int lo = s, hi = s + 1;
        void* args[] = {&p, &lo, &hi};
        hipError_t e = hipLaunchCooperativeKernel((const void*)mega, dim3(grid_blocks), dim3(NT), args, LDS_BYTES, stream);
        if (e != hipSuccess) fprintf(stderr, "launch %d failed: %s (grid %d)\n", s, hipGetErrorString(e), grid_blocks);
    }
#endif
}
```

```cpp
#include <hip/hip_runtime.h>
#include <hip/hip_cooperative_groups.h>
#include <cstdio>
#include <cstdint>
namespace cg = cooperative_groups;

#ifndef SINGLE_LAUNCH
#define SINGLE_LAUNCH 1
#endif

typedef unsigned short bf16_t;

constexpr int NT = 512;
constexpr int NW = NT / 64;
constexpr int D = 1024, NB = 16, T = 2048, CT = 256;
constexpr int ML = NB * T, MC = NB * CT, M = ML + MC;
constexpr int D_IN = 3088;
constexpr float ALPHA = 1.4142135623730951f;
constexpr float LN_EPS = 1e-5f;
constexpr int NSTEPS = 27;

constexpr size_t SZ_HALF = (size_t)M * 512 * 2;
constexpr size_t WS_MOD   = 0;
constexpr size_t WS_BAR   = 0xE0000;
constexpr size_t WS_XCTX  = 1u << 20;
constexpr size_t WS_R1    = WS_XCTX + (size_t)MC * 1024 * 4;
constexpr size_t WS_QKRAW = WS_R1;
constexpr size_t WS_V     = WS_R1 + 1 * SZ_HALF;
constexpr size_t WS_O     = WS_R1 + 2 * SZ_HALF;
constexpr size_t WS_NQ    = WS_R1 + 3 * SZ_HALF;
constexpr size_t WS_NK    = WS_R1 + 4 * SZ_HALF;
constexpr size_t WS_NV    = WS_R1 + 5 * SZ_HALF;
constexpr size_t WS_Y     = WS_R1;
constexpr size_t WS_Q     = WS_R1 + 2 * SZ_HALF;
constexpr size_t WS_GATES = WS_R1 + 6 * SZ_HALF;
constexpr size_t WS_R3    = WS_GATES + (size_t)M * 16 * 4;
constexpr size_t WS_QKACT = WS_R3;
constexpr size_t WS_HDIR  = WS_R3 + SZ_HALF;
constexpr size_t WS_EIDX  = WS_R3;
constexpr size_t WS_EGATE = WS_R3 + (size_t)M * 128 * 4;
constexpr size_t WS_U2Q   = WS_R3 + SZ_HALF;
constexpr size_t WS_USC   = WS_GATES;
constexpr size_t WS_MIX   = WS_R3 + 3 * SZ_HALF;
constexpr size_t WS_U2    = WS_MIX;
constexpr size_t WS_U1    = WS_MIX;
constexpr size_t WS_WIN   = WS_MIX + 2 * SZ_HALF;
constexpr size_t WS_WOUT  = WS_WIN + (size_t)2 * 3072 * 1024 * 2;
constexpr size_t WS_WQ    = WS_WOUT + (size_t)2 * 1024 * 1024 * 2;
constexpr size_t WS_NVT   = WS_WQ + (size_t)2 * 2048 * 1024 * 2;
constexpr size_t WS_TUP   = WS_NVT + (size_t)128 * 64 * 2304 * 2;
constexpr size_t WS_TDN   = WS_TUP + (size_t)16384 * 1024;
constexpr size_t WS_TSC   = WS_TDN + (size_t)16384 * 1024;
constexpr size_t WS_END   = WS_TSC + (size_t)2 * 16384 * 4;

constexpr int LDS_BYTES = 128 * 1024 + 16;

struct P {
    const float *x, *c, *ctx, *c_ctx, *ada_w, *ada_b, *w_in, *b_gate, *conv_w, *ml_norm_w, *na_rpb, *w_out,
                *ln1_w, *ln1_b, *peer_wq, *peer_keys, *peer_up, *peer_down, *ln2_w, *ln2_b;
    float* out;
    unsigned char* ws;
};

typedef short bf16x8 __attribute__((ext_vector_type(8)));
typedef float f32x16 __attribute__((ext_vector_type(16)));
__device__ __forceinline__ bf16_t f2bf(float f) {
    unsigned u = __float_as_uint(f);
    u += 0x7fffu + ((u >> 16) & 1u);
    return (bf16_t)(u >> 16);
}
__device__ __forceinline__ float bf2f(bf16_t h) { return __uint_as_float(((unsigned)h) << 16); }
__device__ __forceinline__ unsigned pk_bf16(float lo, float hi) { return (unsigned)f2bf(lo) | ((unsigned)f2bf(hi) << 16); }
__device__ __forceinline__ int opaque_tid() { int v = threadIdx.x; asm volatile("" : "+v"(v)); return v; }
__device__ __forceinline__ float wave_sum(float v) {
#pragma unroll
    for (int o = 32; o; o >>= 1) v += __shfl_xor(v, o);
    return v;
}
__device__ __forceinline__ float wave_max(float v) {
#pragma unroll
    for (int o = 32; o; o >>= 1) v = fmaxf(v, __shfl_xor(v, o));
    return v;
}
__device__ __forceinline__ float siluf(float v) { return v / (1.f + expf(-v)); }
__device__ __forceinline__ float sigmoidf(float v) { return 1.f / (1.f + expf(-v)); }
__device__ __forceinline__ float logsigmoidf(float v) { return fminf(v, 0.f) - log1pf(expf(-fabsf(v))); }
__device__ __forceinline__ float gelu_tanh(float v) {
    const float k0 = 0.7978845608028654f;
    return 0.5f * v * (1.f + tanhf(k0 * (v + 0.044715f * v * v * v)));
}
__device__ __forceinline__ int mod_row(int r) { return r < ML ? (r >> 11) : 16; }
__device__ __forceinline__ const float* xrow(const P& p, int l, int r) {
    if (r < ML) return (l == 0 ? p.x : (const float*)p.out) + (size_t)r * D;
    return (l == 0 ? p.ctx : (const float*)(p.ws + WS_XCTX)) + (size_t)(r - ML) * D;
}
__device__ __forceinline__ float* xrow_w(const P& p, int r) {
    if (r < ML) return p.out + (size_t)r * D;
    return (float*)(p.ws + WS_XCTX) + (size_t)(r - ML) * D;
}
__device__ __forceinline__ const float* modp(const P& p, int l, int r) {
    return (const float*)(p.ws + WS_MOD) + (size_t)(l * 17 + mod_row(r)) * 6144;
}

__device__ __forceinline__ float wave_sum16(const float (&v)[16], int lane) {
    const bool b0 = lane & 1, b1 = lane & 2, b2 = lane & 4, b3 = lane & 8;
    float a8[8];
#pragma unroll
    for (int i = 0; i < 8; ++i) { const float lo_ = v[2 * i], hi_ = v[2 * i + 1]; const float keep = b0 ? hi_ : lo_, send = b0 ? lo_ : hi_; a8[i] = keep + __shfl_xor(send, 1); }
    float a4[4];
#pragma unroll
    for (int i = 0; i < 4; ++i) { const float lo_ = a8[2 * i], hi_ = a8[2 * i + 1]; const float keep = b1 ? hi_ : lo_, send = b1 ? lo_ : hi_; a4[i] = keep + __shfl_xor(send, 2); }
    float a2[2];
#pragma unroll
    for (int i = 0; i < 2; ++i) { const float lo_ = a4[2 * i], hi_ = a4[2 * i + 1]; const float keep = b2 ? hi_ : lo_, send = b2 ? lo_ : hi_; a2[i] = keep + __shfl_xor(send, 4); }
    float a1; { const float lo_ = a2[0], hi_ = a2[1]; const float keep = b3 ? hi_ : lo_, send = b3 ? lo_ : hi_; a1 = keep + __shfl_xor(send, 8); }
    a1 += __shfl_xor(a1, 16); a1 += __shfl_xor(a1, 32);
    return a1;
}

__device__ __forceinline__ void phase_mod(const P& p, float* sm) {
    float* mod = (float*)(p.ws + WS_MOD);
    const int tid = opaque_tid();
    for (int i = tid; i < 17 * 1024; i += NT) { const int mr = i >> 10, k = i & 1023; sm[i] = siluf(mr < 16 ? p.c[mr * D + k] : p.c_ctx[k]); }
    __syncthreads();
    const int total = 2 * 6144 * 8;
    for (int i = blockIdx.x * NT + tid; i < total; i += gridDim.x * NT) {
        const int kq = i & 7, col = (i >> 3) % 6144, l = (i >> 3) / 6144;
        const float* w = p.ada_w + (size_t)l * D * 6144 + (size_t)(kq * 128) * 6144 + col;
        float acc[17];
#pragma unroll
        for (int mr = 0; mr < 17; ++mr) acc[mr] = 0.f;
#pragma unroll 1
        for (int k0 = 0; k0 < 128; k0 += 16) {
            float wv[16];
#pragma unroll
            for (int kk = 0; kk < 16; ++kk) wv[kk] = w[(size_t)(k0 + kk) * 6144];
#pragma unroll
            for (int kk = 0; kk < 16; ++kk)
#pragma unroll
                for (int mr = 0; mr < 17; ++mr) acc[mr] += sm[mr * 1024 + kq * 128 + k0 + kk] * wv[kk];
        }
        const float bias = p.ada_b[l * 6144 + col];
#pragma unroll
        for (int mr = 0; mr < 17; ++mr) {
            float v = acc[mr];
            v += __shfl_xor(v, 1); v += __shfl_xor(v, 2); v += __shfl_xor(v, 4);
            if (kq == 0) mod[(size_t)(l * 17 + mr) * 6144 + col] = v + bias;
        }
    }
    __syncthreads();
}

namespace pg8 {
#define PG8_LAS __attribute__((address_space(3)))
typedef unsigned short bf16_t;
typedef short bf16x8 __attribute__((ext_vector_type(8)));
typedef float f32x4 __attribute__((ext_vector_type(4)));
typedef unsigned u32x4 __attribute__((ext_vector_type(4)));
constexpr int BM = 256, BK = 64, HALF = 128, HTB = HALF * BK * 2  , STAGE_BYTES = 8 * HTB, NXCD = 8, WGM = 8;

__host__ __device__ __forceinline__ int lds_byte(int r, int c) { const int st = (r >> 4) * 2 + (c >> 5), rr = r & 15, cc = c & 31, ob = rr * 64 + cc * 2; return st * 1024 + (ob ^ (((ob >> 9) & 1) << 5)); }
__host__ __device__ __forceinline__ void stage_rc(int b, int& R, int& C) { const int st = b / 1024, sb = b % 1024, swz = sb ^ (((sb >> 9) & 1) << 5); R = (st >> 1) * 16 + swz / 64; C = (st & 1) * 32 + (swz % 64) / 2; }
__host__ __device__ __forceinline__ int perm32(int rho) { const int n = rho >> 4, i = rho & 15; return 8 * (i >> 2) + 4 * n + (i & 3); }

struct Unit { int pm, pn; };
struct Gemm { const bf16_t* A; const bf16_t* Bt; int M, N, K; };

struct StaticOrder {
    int nM, nN, nwg, G, c;
    __host__ __device__ void init(int M, int N, int G_, int c_) { nM = M / BM; nN = N / BM; nwg = nM * nN; G = G_; c = c_; }
    __host__ __device__ bool next(int i, Unit& u) const {
        const long L = (long)i * G + c; if (L >= nwg) return false;
        int wgid = (int)L; { const int q = nwg / NXCD, r = nwg % NXCD, xcd = wgid % NXCD, off = wgid / NXCD; wgid = (xcd < r ? xcd * (q + 1) : r * (q + 1) + (xcd - r) * q) + off; }
        const int nig = WGM * nN, gid = wgid / nig, fm = gid * WGM, gsz = (nM - fm) < WGM ? (nM - fm) : WGM;
        u.pm = fm + ((wgid % nig) % gsz); u.pn = (wgid % nig) / gsz; return true;
    }
    __device__ __forceinline__ void a_ready(const Unit&) const {}
    __device__ __forceinline__ void done(const Unit&) const {}
};
__device__ __forceinline__ unsigned cvt_pk_bf16(float lo, float hi) { unsigned r; asm volatile("v_cvt_pk_bf16_f32 %0, %1, %2" : "=v"(r) : "v"(lo), "v"(hi)); return r; }
template <int ACT  > struct EpiBf16 {
    static constexpr bool PERM = true, AFTER_DRAIN = false;
    bf16_t* O; int ldc; const float* bias; int split_cols; size_t split_stride;
    __device__ __forceinline__ void operator()(const f32x4 (&acc)[2][2][4][2], const Unit& u, int wr, int wc, int fr, int fq) const {
        const int row0 = u.pm * BM + wr * 64 + fr; int colt = u.pn * BM; bf16_t* base = O;
        if (split_cols) { const int t = colt / split_cols; base += (size_t)t * split_stride; colt -= t * split_cols; }
        const int col0 = colt + wc * 32 + 8 * fq, bcol0 = u.pn * BM + wc * 32 + 8 * fq;
        f32x4 bv[2][2];
#pragma unroll
        for (int bj = 0; bj < 2; ++bj)
#pragma unroll
            for (int n = 0; n < 2; ++n) bv[bj][n] = bias ? *(const f32x4*)(bias + bcol0 + bj * HALF + 4 * n) : (f32x4){0.f, 0.f, 0.f, 0.f};
#pragma unroll
        for (int ai = 0; ai < 2; ++ai)
#pragma unroll
            for (int m = 0; m < 4; ++m) { bf16_t* rowp = base + (size_t)(row0 + ai * HALF + m * 16) * ldc + col0;
#pragma unroll
                for (int bj = 0; bj < 2; ++bj) { f32x4 v0 = acc[ai][bj][m][0] + bv[bj][0], v1 = acc[ai][bj][m][1] + bv[bj][1];
                    u32x4 w; w.x = cvt_pk_bf16(v0[0], v0[1]); w.y = cvt_pk_bf16(v0[2], v0[3]); w.z = cvt_pk_bf16(v1[0], v1[1]); w.w = cvt_pk_bf16(v1[2], v1[3]);
                    *(u32x4*)(rowp + bj * HALF) = w; } }
    }
};
template <class Epi, class Sched, bool STAMP = false>
__device__ __forceinline__ void gemm_phase(PG8_LAS unsigned char* lds, const Gemm g, const Sched& S, const Epi& E, unsigned long long* stamps) {
    const int tid = opaque_tid(), wid = __builtin_amdgcn_readfirstlane(tid >> 6), lane = tid & 63, wr = wid >> 2, wc = wid & 3, fr = lane & 15, fq = lane >> 4;
    const int K = g.K, nt = K / BK;
    int ts_lo = 0, ts_hi = 0, nts = 0; const unsigned long long rt_entry = STAMP ? (unsigned long long)wall_clock64() : 0ull;
#define PG8_STAMP() do { if (STAMP && wid == 0 && nts < 64) { const unsigned long long _c = (unsigned long long)clock64(); \
        ts_lo = (lane == nts) ? (int)(unsigned)_c : ts_lo; ts_hi = (lane == nts) ? (int)(unsigned)(_c >> 32) : ts_hi; ++nts; } } while (0)
    PG8_STAMP();
    unsigned voffA[2], voffB[2];
#pragma unroll
    for (int i = 0; i < 2; ++i) { int R, C; stage_rc(tid * 16 + i * 8192, R, C); const int Rb = Epi::PERM ? ((R & ~31) + perm32(R & 31)) : R;
        voffA[i] = (unsigned)(R * K + C) * 2u; voffB[i] = (unsigned)(Rb * K + C) * 2u; }
    const size_t kstep = (size_t)(BK * 2);
    const size_t hstep = (size_t)HALF * K * 2;
    const size_t tstep = 2 * hstep;
    const unsigned ldsw = (unsigned)wid * 1024u;
    const int aoff = lds_byte(wr * 64 + fr, fq * 8), boff = lds_byte(wc * 32 + fr, fq * 8);
#define PG8_SA(b, h) (((b) * 2 + (h)) * HTB)
#define PG8_SB(b, h) ((4 + (b) * 2 + (h)) * HTB)
#define PG8_STAGE(bufoff, gbase, voff) do { _Pragma("unroll") for (int _i = 0; _i < 2; ++_i) \
        __builtin_amdgcn_global_load_lds((const unsigned*)((const char*)(gbase) + (voff)[_i]), (PG8_LAS unsigned*)(lds + (bufoff) + ldsw + _i * 8192), 16, 0, 0); } while (0)
#define PG8_LDA(dst, b, h) do { _Pragma("unroll") for (int m = 0; m < 4; ++m) _Pragma("unroll") for (int k = 0; k < 2; ++k) dst[m][k] = *(const PG8_LAS bf16x8*)(lds + PG8_SA(b, h) + aoff + m * 2048 + k * 1024); } while (0)
#define PG8_LDB(dst, b, h) do { _Pragma("unroll") for (int n = 0; n < 2; ++n) _Pragma("unroll") for (int k = 0; k < 2; ++k) dst[n][k] = *(const PG8_LAS bf16x8*)(lds + PG8_SB(b, h) + boff + n * 2048 + k * 1024); } while (0)
#define PG8_MMA(ai, bj, At, Bt) do { __builtin_amdgcn_s_setprio(1); _Pragma("unroll") for (int m = 0; m < 4; ++m) _Pragma("unroll") for (int n = 0; n < 2; ++n) _Pragma("unroll") for (int k = 0; k < 2; ++k) \
        acc[ai][bj][m][n] = __builtin_amdgcn_mfma_f32_16x16x32_bf16(Bt[n][k], At[m][k], acc[ai][bj][m][n], 0, 0, 0); __builtin_amdgcn_s_setprio(0); } while (0)
#define PG8_WAIT_V(n) asm volatile("s_waitcnt vmcnt(" #n ")" ::: "memory")
#define PG8_WAIT_L(n) asm volatile("s_waitcnt lgkmcnt(" #n ")" ::: "memory")
#define PG8_BAR __builtin_amdgcn_s_barrier()
#define PG8_SCHED __builtin_amdgcn_sched_barrier(0)
    Unit cur, nxt; int ui = 0;
    if (!S.next(0, cur)) return;
    f32x4 acc[2][2][4][2];
#pragma unroll
    for (int a = 0; a < 2; ++a)
#pragma unroll
        for (int b = 0; b < 2; ++b)
#pragma unroll
            for (int m = 0; m < 4; ++m)
#pragma unroll
                for (int n = 0; n < 2; ++n) acc[a][b][m][n] = (f32x4){0.f, 0.f, 0.f, 0.f};
    bf16x8 At[4][2], B0[2][2], B1[2][2];
    const char* cA = (const char*)g.A + (size_t)cur.pm * tstep; const char* cB = (const char*)g.Bt + (size_t)cur.pn * tstep;
    S.a_ready(cur);
    PG8_STAGE(PG8_SB(0, 0), cB, voffB); PG8_STAGE(PG8_SA(0, 0), cA, voffA); PG8_STAGE(PG8_SB(0, 1), cB + hstep, voffB); PG8_STAGE(PG8_SA(0, 1), cA + hstep, voffA);
    if (wr == 1) PG8_BAR;
    PG8_WAIT_V(4); PG8_BAR;
    PG8_STAGE(PG8_SB(1, 0), cB + kstep, voffB); PG8_STAGE(PG8_SA(1, 0), cA + kstep, voffA); PG8_STAGE(PG8_SB(1, 1), cB + hstep + kstep, voffB);
    PG8_WAIT_V(6); PG8_BAR;
    PG8_STAMP();
    for (;;) {
        const bool has_next = S.next(ui + 1, nxt);
        const char* nA = has_next ? (const char*)g.A + (size_t)nxt.pm * tstep : cA; const char* nB = has_next ? (const char*)g.Bt + (size_t)nxt.pn * tstep : cB;
        for (int t = 0; t < nt; t += 2) {
            const bool last = (t == nt - 2);
            const char* a1 = cA + (size_t)(t + 1) * kstep;
            const char* a2 = last ? nA : cA + (size_t)(t + 2) * kstep; const char* b2 = last ? nB : cB + (size_t)(t + 2) * kstep;
            const char* a3 = a2 + kstep; const char* b3 = b2 + kstep;
            if (last && has_next) S.a_ready(nxt);
            PG8_LDB(B0, 0, 0); PG8_SCHED; PG8_LDA(At, 0, 0); PG8_STAGE(PG8_SA(1, 1), a1 + hstep, voffA);
            PG8_WAIT_L(8); PG8_BAR; PG8_WAIT_L(0); PG8_MMA(0, 0, At, B0); PG8_BAR; PG8_SCHED;
            PG8_LDB(B1, 0, 1); PG8_STAGE(PG8_SB(0, 0), b2, voffB);
            PG8_BAR; PG8_WAIT_L(0); PG8_MMA(0, 1, At, B1); PG8_BAR;
            PG8_LDA(At, 0, 1); PG8_STAGE(PG8_SA(0, 0), a2, voffA);
            PG8_BAR; PG8_WAIT_L(0); PG8_MMA(1, 0, At, B0); PG8_BAR; PG8_SCHED;
            PG8_STAGE(PG8_SB(0, 1), b2 + hstep, voffB);
            PG8_WAIT_V(6); PG8_BAR; PG8_MMA(1, 1, At, B1); PG8_BAR;
            PG8_LDB(B0, 1, 0); PG8_SCHED; PG8_LDA(At, 1, 0); PG8_STAGE(PG8_SA(0, 1), a2 + hstep, voffA);
            PG8_WAIT_L(8); PG8_BAR; PG8_WAIT_L(0); PG8_MMA(0, 0, At, B0); PG8_BAR; PG8_SCHED;
            PG8_LDB(B1, 1, 1); PG8_STAGE(PG8_SB(1, 0), b3, voffB);
            PG8_BAR; PG8_WAIT_L(0); PG8_MMA(0, 1, At, B1); PG8_BAR;
            PG8_LDA(At, 1, 1); PG8_STAGE(PG8_SA(1, 0), a3, voffA);
            PG8_BAR; PG8_WAIT_L(0); PG8_MMA(1, 0, At, B0); PG8_BAR; PG8_SCHED;
            PG8_STAGE(PG8_SB(1, 1), b3 + hstep, voffB);
            PG8_WAIT_V(6); PG8_BAR; PG8_MMA(1, 1, At, B1); PG8_BAR;
        }
        PG8_STAMP();
        if constexpr (!Epi::AFTER_DRAIN) { E(acc, cur, wr, wc, fr, fq); S.done(cur); }
        PG8_STAMP();
        if (!has_next) break;
#pragma unroll
        for (int a = 0; a < 2; ++a)
#pragma unroll
            for (int b = 0; b < 2; ++b)
#pragma unroll
                for (int m = 0; m < 4; ++m)
#pragma unroll
                    for (int n = 0; n < 2; ++n) acc[a][b][m][n] = (f32x4){0.f, 0.f, 0.f, 0.f};
        cur = nxt; cA = nA; cB = nB; ++ui;
    }
    PG8_WAIT_V(0);
    if (wr == 0) PG8_BAR;
    PG8_BAR;
    if constexpr (Epi::AFTER_DRAIN) { E.fused(acc, cur, wr, wc, fr, fq, lds, wid, lane); S.done(cur); }
    PG8_STAMP();
    if (STAMP && wid == 0) { stamps[lane] = lane < nts ? (((unsigned long long)(unsigned)ts_hi << 32) | (unsigned)ts_lo) : 0ull;
        if (lane == 62) stamps[62] = rt_entry; if (lane == 63) stamps[63] = (unsigned long long)wall_clock64(); }
#undef PG8_STAMP
#undef PG8_SA
#undef PG8_SB
#undef PG8_STAGE
#undef PG8_LDA
#undef PG8_LDB
#undef PG8_MMA
#undef PG8_WAIT_V
#undef PG8_WAIT_L
#undef PG8_BAR
#undef PG8_SCHED
}
}


__device__ __forceinline__ void phase_wprep(const P& p, float* sm) {
    const int tid = opaque_tid();
    float (*tl)[65] = (float (*)[65])sm;
    for (int tile = blockIdx.x; tile < 2 * 1536; tile += gridDim.x) {
        const int l = tile / 1536; int t = tile % 1536;
        const float* src; bf16_t* dst; int Nsrc, which;
        if (t < 768) { which = 0; src = p.w_in + (size_t)l * D * D_IN; Nsrc = D_IN; dst = (bf16_t*)(p.ws + WS_WIN) + (size_t)l * 3072 * 1024; }
        else if (t < 1024) { which = 1; t -= 768; src = p.w_out + (size_t)l * D * D; Nsrc = D; dst = (bf16_t*)(p.ws + WS_WOUT) + (size_t)l * 1024 * 1024; }
        else { which = 2; t -= 1024; src = p.peer_wq + (size_t)l * D * 2048; Nsrc = 2048; dst = (bf16_t*)(p.ws + WS_WQ) + (size_t)l * 2048 * 1024; }
        const int tn = t / 16, tk = t % 16;
        for (int i = tid; i < 4096; i += NT) {
            const int kk = i >> 6, nn = i & 63; const int n = tn * 64 + nn;
            const int nsrc = (which == 0 && n >= 1536) ? n + 16 : n;
            float v = src[(size_t)(tk * 64 + kk) * Nsrc + nsrc];
            if (which == 0 && n >= 1536 && n < 2048) v *= 0.125f;
            tl[kk][nn] = v;
        }
        __syncthreads();
        {
            const int nn = tid >> 3, k8 = (tid & 7) * 8;
            uint4 w;
            w.x = pk_bf16(tl[k8 + 0][nn], tl[k8 + 1][nn]); w.y = pk_bf16(tl[k8 + 2][nn], tl[k8 + 3][nn]);
            w.z = pk_bf16(tl[k8 + 4][nn], tl[k8 + 5][nn]); w.w = pk_bf16(tl[k8 + 6][nn], tl[k8 + 7][nn]);
            *(uint4*)(dst + (size_t)(tn * 64 + nn) * 1024 + tk * 64 + k8) = w;
        }
        __syncthreads();
    }
}

__device__ __forceinline__ void phase_u1prep(const P& p, int l, float* sm) {
    bf16_t* u1 = (bf16_t*)(p.ws + WS_U1);
    float* gates = (float*)(p.ws + WS_GATES);
    const int tid_ = opaque_tid(); const int lane = tid_ & 63, wave = tid_ >> 6;
    __syncthreads();
    for (int i = tid_; i < 16 * 1024; i += NT) { const int k = i >> 4, g = i & 15; sm[g * 1024 + k] = p.w_in[(size_t)l * D * D_IN + (size_t)k * D_IN + 1536 + g]; }
    __syncthreads();
    for (int r = blockIdx.x * NW + wave; r < M; r += gridDim.x * NW) {
        const float* xr = xrow(p, l, r); const float* mp = modp(p, l, r);
        float ga[16];
#pragma unroll
        for (int g = 0; g < 16; ++g) ga[g] = 0.f;
#pragma unroll 1
        for (int i = 0; i < 4; ++i) {
            const int k0 = i * 256 + lane * 4;
            const float4 xv = *(const float4*)(xr + k0), sc = *(const float4*)(mp + 1024 + k0), sh = *(const float4*)(mp + k0);
            const float u[4] = {xv.x * (1.f + sc.x) + sh.x, xv.y * (1.f + sc.y) + sh.y, xv.z * (1.f + sc.z) + sh.z, xv.w * (1.f + sc.w) + sh.w};
            uint2 pk; pk.x = pk_bf16(u[0], u[1]); pk.y = pk_bf16(u[2], u[3]);
            *(uint2*)(u1 + (size_t)r * 1024 + k0) = pk;
#pragma unroll
            for (int g = 0; g < 16; ++g) {
                const float4 w = *(const float4*)(sm + g * 1024 + k0);
                ga[g] += u[0] * w.x + u[1] * w.y + u[2] * w.z + u[3] * w.w;
            }
        }
        const float mine = wave_sum16(ga, lane);
        if (lane < 16) gates[(size_t)r * 16 + lane] = mine + p.b_gate[l * 16 + lane];
    }
    __syncthreads();
}

__device__ __forceinline__ void phase_inproj(const P& p, int l, unsigned char* smraw) {
    pg8::Gemm g{(const pg8::bf16_t*)(p.ws + WS_U1), (const pg8::bf16_t*)(p.ws + WS_WIN) + (size_t)l * 3072 * 1024, M, 3072, 1024};
    pg8::StaticOrder S; S.init(M, 3072, (int)gridDim.x, (int)blockIdx.x);
    pg8::EpiBf16<0> E{(pg8::bf16_t*)(p.ws + WS_QKRAW), 512, nullptr, 512, (size_t)M * 512};
    pg8::gemm_phase<pg8::EpiBf16<0>, pg8::StaticOrder, false>((PG8_LAS unsigned char*)smraw, g, S, E, nullptr);
}

__device__ __forceinline__ void phase_conv(const P& p, int l, float* sm) {
    const bf16_t* qkraw = (const bf16_t*)(p.ws + WS_QKRAW);
    bf16_t* qkact = (bf16_t*)(p.ws + WS_QKACT);
    const int tid = opaque_tid();
    float* cw_s = sm;
    float* cs_s = sm + 2560;
    float* sn_s = sm + 2560 + 1024;
    __syncthreads();
    for (int i = tid; i < 2560; i += NT) cw_s[i] = p.conv_w[l * 2560 + i];
    for (int i = tid; i < 1024; i += NT) { const int pos = i >> 4, f = i & 15; const float ang = (float)pos * powf(10000.f, -(float)f / 16.f); cs_s[i] = cosf(ang); sn_s[i] = sinf(ang); }
    __syncthreads();
    const int total = M * 32;
    for (int it = blockIdx.x * NT + tid; it < total; it += gridDim.x * NT) {
        const int r = it >> 5, hq = (it >> 2) & 7, jg = it & 3;
        const int c1 = hq * 64 + jg * 8;
        int base, t, Ts;
        if (r < ML) { base = r & ~2047; t = r & 2047; Ts = T; } else { const int rc = r - ML; base = ML + (rc & ~255); t = rc & 255; Ts = CT; }
        float y1[8], y2[8];
#pragma unroll
        for (int i = 0; i < 8; ++i) { y1[i] = 0.f; y2[i] = 0.f; }
#pragma unroll
        for (int jj = 0; jj < 5; ++jj) {
            const int tt = t + jj - 2;
            if (tt >= 0 && tt < Ts) {
                const bf16_t* rp = qkraw + (size_t)(base + tt) * 512 + c1;
                const uint4 a = *(const uint4*)rp, b = *(const uint4*)(rp + 32);
                const unsigned aw[4] = {a.x, a.y, a.z, a.w}, bw[4] = {b.x, b.y, b.z, b.w};
                const float* w1 = cw_s + jj * 512 + c1; const float* w2 = w1 + 32;
#pragma unroll
                for (int i = 0; i < 4; ++i) {
                    y1[2 * i] += __uint_as_float(aw[i] << 16) * w1[2 * i]; y1[2 * i + 1] += __uint_as_float(aw[i] & 0xffff0000u) * w1[2 * i + 1];
                    y2[2 * i] += __uint_as_float(bw[i] << 16) * w2[2 * i]; y2[2 * i + 1] += __uint_as_float(bw[i] & 0xffff0000u) * w2[2 * i + 1];
                }
            }
        }
        const float ks = hq >= 4 ? 0.125f : 1.f;
        const bool lat = r < ML;
        const int pos = (jg < 2) ? (t >> 6) : (t & 63);
        float o1[8], o2[8];
#pragma unroll
        for (int i = 0; i < 8; ++i) {
            const float a = siluf(y1[i]) * ks, b = siluf(y2[i]) * ks;
            if (lat) { const float cs = cs_s[pos * 16 + ((jg & 1) * 8 + i)], sn = sn_s[pos * 16 + ((jg & 1) * 8 + i)]; o1[i] = a * cs - b * sn; o2[i] = a * sn + b * cs; }
            else { o1[i] = a; o2[i] = b; }
        }
        bf16_t* op = qkact + (size_t)r * 512 + c1;
        *(uint4*)op = make_uint4(pk_bf16(o1[0], o1[1]), pk_bf16(o1[2], o1[3]), pk_bf16(o1[4], o1[5]), pk_bf16(o1[6], o1[7]));
        *(uint4*)(op + 32) = make_uint4(pk_bf16(o2[0], o2[1]), pk_bf16(o2[2], o2[3]), pk_bf16(o2[4], o2[5]), pk_bf16(o2[6], o2[7]));
    }
    __syncthreads();
}

typedef short bf16x4s __attribute__((ext_vector_type(4)));
constexpr int ML_RS = 144;
constexpr int ML_K = 0, ML_WKT = 9216, ML_Q = 18432, ML_VT = 27648, ML_OUT = 46080, ML_ARR = 63488;
__device__ __forceinline__ bf16x8 cvt8(const f32x16& x, int o) {
    union { unsigned u[4]; bf16x8 v; } r;
    r.u[0] = pg8::cvt_pk_bf16(x[o], x[o + 1]); r.u[1] = pg8::cvt_pk_bf16(x[o + 2], x[o + 3]); r.u[2] = pg8::cvt_pk_bf16(x[o + 4], x[o + 5]); r.u[3] = pg8::cvt_pk_bf16(x[o + 6], x[o + 7]);
    return r.v;
}
__device__ __forceinline__ bf16x8 ld2x4(const unsigned char* p) {
    union { bf16x4s h[2]; bf16x8 v; } r; r.h[0] = *(const bf16x4s*)p; r.h[1] = *(const bf16x4s*)(p + 16); return r.v;
}
__device__ __forceinline__ void lds_barrier() { asm volatile("s_waitcnt lgkmcnt(0)" ::: "memory"); __builtin_amdgcn_s_barrier(); asm volatile("" ::: "memory"); }
__device__ __forceinline__ void phase_mlstm(const P& p, int l, unsigned char* sm) {
    const bool need_ctx = (l == 0);
    const bf16_t* qkact = (const bf16_t*)(p.ws + WS_QKACT);
    const bf16_t* vb = (const bf16_t*)(p.ws + WS_V);
    const float* gates = (const float*)(p.ws + WS_GATES);
    bf16_t* hdir = (bf16_t*)(p.ws + WS_HDIR);
    const int tid = opaque_tid(); const int lane = tid & 63, wave = tid >> 6, r = lane & 31, hh = lane >> 5;
    const int c = wave & 1, vt = wave >> 1, j = c * 32 + r;
    float* a_li = (float*)(sm + ML_ARR); float* a_lf = a_li + 64; float* a_g = a_lf + 64; float* a_M = a_g + 64; float* a_inter = a_M + 64;
    float* a_edn = a_inter + 64; float* a_w = a_edn + 64; float* a_nq = a_w + 64; float* a_n = a_nq + 64; float* a_misc = a_n + 64; float* a_np = a_misc + 16;
    const int srow = tid >> 3, part = tid & 7;
    for (int item = blockIdx.x; item < NB * 4 * 2; item += gridDim.x) {
        const int dir = item & 1, h = (item >> 1) & 3, b = item >> 3;
        f32x16 X0, X1;
#pragma unroll
        for (int i = 0; i < 16; ++i) { X0[i] = 0.f; X1[i] = 0.f; }
        float m_run = 0.f;
        __syncthreads();
        if (tid < 64) a_n[tid] = 0.f;
        a_np[tid] = 0.f;
        float so_prev = 1.f;
        uint4 pq, pk, pv0, pv1; float pli = 0.f, plf = 0.f;
        auto issue = [&](int ci) {
            const bool isctx = ci < 4; const int base = isctx ? ML + b * CT : b * T; const int Ts = isctx ? CT : T; const int cl = isctx ? ci : ci - 4;
            const int pos = cl * 64 + srow; const int t = dir ? Ts - 1 - pos : pos; const size_t ro = (size_t)(base + t) * 512;
            pq = *(const uint4*)(qkact + ro + h * 64 + part * 8); pk = *(const uint4*)(qkact + ro + 256 + h * 64 + part * 8);
            pv0 = *(const uint4*)(vb + ro + h * 128 + part * 16); pv1 = *(const uint4*)(vb + ro + h * 128 + part * 16 + 8);
            if (tid < 64) { const int pos2 = cl * 64 + tid; const int t2 = dir ? Ts - 1 - pos2 : pos2; const float* g = gates + (size_t)(base + t2) * 16;
                pli = g[(2 * dir) * 4 + h]; plf = g[(2 * dir + 1) * 4 + h]; }
        };
        issue(0);
#pragma unroll 1
        for (int ci = 0; ci < 36; ++ci) {
            const bool isctx = ci < 4; const int base = isctx ? ML + b * CT : b * T; const int Ts = isctx ? CT : T; const int cl = isctx ? ci : ci - 4;
            const bool do_out = (!isctx) || need_ctx;
            *(uint4*)(sm + ML_Q + srow * ML_RS + part * 16) = pq;
            *(uint4*)(sm + ML_K + srow * ML_RS + part * 16) = pk;
            {
                const unsigned w[8] = {pv0.x, pv0.y, pv0.z, pv0.w, pv1.x, pv1.y, pv1.z, pv1.w};
#pragma unroll
                for (int i = 0; i < 8; ++i) {
                    *(bf16_t*)(sm + ML_VT + (part * 16 + 2 * i) * ML_RS + srow * 2) = (bf16_t)(w[i] & 0xffffu);
                    *(bf16_t*)(sm + ML_VT + (part * 16 + 2 * i + 1) * ML_RS + srow * 2) = (bf16_t)(w[i] >> 16);
                }
            }
            if (tid < 64) { a_li[tid] = pli; a_lf[tid] = plf; }
            if (ci + 1 < 36) issue(ci + 1);
            lds_barrier();
            if (wave == 0) {
                const float lfx = a_lf[lane]; float bsum = fminf(lfx, 0.f) - __logf(1.f + __expf(-fabsf(lfx)));
#pragma unroll
                for (int d = 1; d < 64; d <<= 1) { const float t = __shfl_up(bsum, d); if (lane >= d) bsum += t; }
                const float g = a_li[lane] - bsum;
                float pm = g;
#pragma unroll
                for (int d = 1; d < 64; d <<= 1) { const float t = __shfl_up(pm, d); if (lane >= d) pm = fmaxf(pm, t); }
                const float Mv = fmaxf(m_run, pm);
                const float M63 = __shfl(Mv, 63), b63 = __shfl(bsum, 63);
                a_g[lane] = g; a_M[lane] = Mv; a_inter[lane] = __expf(m_run - Mv); a_edn[lane] = __expf(-(bsum + Mv)); a_w[lane] = __expf(g - M63);
                if (lane == 0) a_misc[0] = __expf(m_run - M63);
                m_run = b63 + M63;
            } else if (wave == 1) {
                {
                    float nn = so_prev * a_n[lane];
#pragma unroll
                    for (int w8 = 0; w8 < 8; ++w8) nn += a_np[w8 * 64 + lane];
                    a_n[lane] = nn;
                }
                float acc = 0.f;
                const unsigned char* qr = sm + ML_Q + lane * ML_RS;
#pragma unroll
                for (int k8 = 0; k8 < 8; ++k8) {
                    const uint4 w = *(const uint4*)(qr + k8 * 16);
                    const unsigned ww[4] = {w.x, w.y, w.z, w.w};
#pragma unroll
                    for (int i = 0; i < 4; ++i) { acc += a_n[k8 * 8 + 2 * i] * __uint_as_float(ww[i] << 16); acc += a_n[k8 * 8 + 2 * i + 1] * __uint_as_float(ww[i] & 0xffff0000u); }
                }
                a_nq[lane] = acc;
            }
            lds_barrier();
            const float so = a_misc[0];
            {
                const int k = lane, s0 = wave * 8;
                float f[8]; float pn = 0.f;
#pragma unroll
                for (int i = 0; i < 8; ++i) { f[i] = a_w[s0 + i] * bf2f(*(const bf16_t*)(sm + ML_K + (s0 + i) * ML_RS + k * 2)); pn += f[i]; }
                uint4 w; w.x = pg8::cvt_pk_bf16(f[0], f[1]); w.y = pg8::cvt_pk_bf16(f[2], f[3]); w.z = pg8::cvt_pk_bf16(f[4], f[5]); w.w = pg8::cvt_pk_bf16(f[6], f[7]);
                *(uint4*)(sm + ML_WKT + k * ML_RS + s0 * 2) = w;
                a_np[wave * 64 + lane] = pn;
            }
            so_prev = so;
            lds_barrier();
            {
                const float Mjv = a_M[j], interj = a_inter[j];
                f32x16 st0, st1, n2;
#pragma unroll
                for (int i = 0; i < 16; ++i) { st0[i] = 0.f; st1[i] = 0.f; n2[i] = 0.f; }
                float gs[2][16];
                if (do_out) {
#pragma unroll
                    for (int a = 0; a < 2; ++a)
#pragma unroll
                        for (int i = 0; i < 16; ++i) gs[a][i] = a_g[a * 32 + (i & 3) + 8 * (i >> 2) + 4 * hh];
#pragma unroll
                    for (int ks = 0; ks < 4; ++ks) {
                        const bf16x8 B = *(const bf16x8*)(sm + ML_Q + j * ML_RS + ks * 32 + hh * 16);
                        const bf16x8 A0 = *(const bf16x8*)(sm + ML_K + r * ML_RS + ks * 32 + hh * 16);
                        st0 = __builtin_amdgcn_mfma_f32_32x32x16_bf16(A0, B, st0, 0, 0, 0);
                        if (c == 1) {
                            const bf16x8 A1 = *(const bf16x8*)(sm + ML_K + (32 + r) * ML_RS + ks * 32 + hh * 16);
                            st1 = __builtin_amdgcn_mfma_f32_32x32x16_bf16(A1, B, st1, 0, 0, 0);
                        }
                    }
#pragma unroll
                    for (int s2 = 0; s2 < 2; ++s2) {
                        const bf16x8 B0 = ld2x4(sm + ML_Q + j * ML_RS + (16 * s2 + 4 * hh) * 2);
                        n2 = __builtin_amdgcn_mfma_f32_32x32x16_bf16(cvt8(X0, 8 * s2), B0, n2, 0, 0, 0);
                        const bf16x8 B1 = ld2x4(sm + ML_Q + j * ML_RS + (32 + 16 * s2 + 4 * hh) * 2);
                        n2 = __builtin_amdgcn_mfma_f32_32x32x16_bf16(cvt8(X1, 8 * s2), B1, n2, 0, 0, 0);
                    }
                }
#pragma unroll
                for (int i = 0; i < 16; ++i) { X0[i] *= so; X1[i] *= so; }
#pragma unroll
                for (int ks = 0; ks < 4; ++ks) {
                    const bf16x8 Bv = *(const bf16x8*)(sm + ML_VT + (vt * 32 + r) * ML_RS + ks * 32 + hh * 16);
                    const bf16x8 A0 = *(const bf16x8*)(sm + ML_WKT + r * ML_RS + ks * 32 + hh * 16);
                    X0 = __builtin_amdgcn_mfma_f32_32x32x16_bf16(A0, Bv, X0, 0, 0, 0);
                    const bf16x8 A1 = *(const bf16x8*)(sm + ML_WKT + (32 + r) * ML_RS + ks * 32 + hh * 16);
                    X1 = __builtin_amdgcn_mfma_f32_32x32x16_bf16(A1, Bv, X1, 0, 0, 0);
                }
                if (do_out) {
                    float dsum = 0.f;
                    bf16x8 pf[2][2];
#pragma unroll
                    for (int i = 0; i < 16; ++i) {
                        const int s = (i & 3) + 8 * (i >> 2) + 4 * hh;
                        const float v = (s <= j) ? st0[i] * __expf(fminf(gs[0][i] - Mjv, 0.f)) : 0.f;
                        st0[i] = v; dsum += v;
                    }
                    pf[0][0] = cvt8(st0, 0); pf[0][1] = cvt8(st0, 8);
                    if (c == 1) {
#pragma unroll
                        for (int i = 0; i < 16; ++i) {
                            const int s = 32 + (i & 3) + 8 * (i >> 2) + 4 * hh;
                            const float v = (s <= j) ? st1[i] * __expf(fminf(gs[1][i] - Mjv, 0.f)) : 0.f;
                            st1[i] = v; dsum += v;
                        }
                        pf[1][0] = cvt8(st1, 0); pf[1][1] = cvt8(st1, 8);
                    }
                    f32x16 n1;
#pragma unroll
                    for (int i = 0; i < 16; ++i) n1[i] = 0.f;
#pragma unroll
                    for (int s2 = 0; s2 < 2; ++s2) {
                        const bf16x8 A = ld2x4(sm + ML_VT + (vt * 32 + r) * ML_RS + (16 * s2 + 4 * hh) * 2);
                        n1 = __builtin_amdgcn_mfma_f32_32x32x16_bf16(A, pf[0][s2], n1, 0, 0, 0);
                    }
                    if (c == 1) {
#pragma unroll
                        for (int s2 = 0; s2 < 2; ++s2) {
                            const bf16x8 A = ld2x4(sm + ML_VT + (vt * 32 + r) * ML_RS + (32 + 16 * s2 + 4 * hh) * 2);
                            n1 = __builtin_amdgcn_mfma_f32_32x32x16_bf16(A, pf[1][s2], n1, 0, 0, 0);
                        }
                    }
                    dsum += __shfl_xor(dsum, 32);
                    const float den = dsum + interj * a_nq[j];
                    const float rd = 1.f / fmaxf(fabsf(den), a_edn[j]);
#pragma unroll
                    for (int g4 = 0; g4 < 4; ++g4) {
                        uint2 w;
                        w.x = pg8::cvt_pk_bf16((n1[4 * g4] + interj * n2[4 * g4]) * rd, (n1[4 * g4 + 1] + interj * n2[4 * g4 + 1]) * rd);
                        w.y = pg8::cvt_pk_bf16((n1[4 * g4 + 2] + interj * n2[4 * g4 + 2]) * rd, (n1[4 * g4 + 3] + interj * n2[4 * g4 + 3]) * rd);
                        *(uint2*)(sm + ML_OUT + j * 272 + (vt * 32 + 8 * g4 + 4 * hh) * 2) = w;
                    }
                }
            }
            lds_barrier();
            if (do_out) {
                const int pos = cl * 64 + srow; const int t = dir ? Ts - 1 - pos : pos;
                bf16_t* dst = hdir + ((size_t)dir * M + base + t) * 512 + h * 128 + part * 16;
                *(uint4*)dst = *(const uint4*)(sm + ML_OUT + srow * 272 + part * 32);
                *(uint4*)(dst + 8) = *(const uint4*)(sm + ML_OUT + srow * 272 + part * 32 + 16);
            }
        }
    }
}

__device__ __forceinline__ void phase_vtrans(const P& p, unsigned char* sm) {
    const bf16_t* nv = (const bf16_t*)(p.ws + WS_NV);
    bf16_t* nvT = (bf16_t*)(p.ws + WS_NVT);
    const int tid = opaque_tid();
    for (int it = blockIdx.x; it < 128 * 36; it += gridDim.x) {
        const int bh = it / 36, tt = it % 36, b = bh >> 3, h = bh & 7;
        const int row0 = tt < 32 ? b * T + tt * 64 : ML + b * CT + (tt - 32) * 64;
        __syncthreads();
        {
            const int tk = tid >> 3, pc = tid & 7;
            const uint4 v = *(const uint4*)(nv + (size_t)(row0 + tk) * 512 + h * 64 + pc * 8);
            const unsigned w[4] = {v.x, v.y, v.z, v.w};
#pragma unroll
            for (int i = 0; i < 4; ++i) {
                *(bf16_t*)(sm + (pc * 8 + 2 * i) * 144 + tk * 2) = (bf16_t)(w[i] & 0xffffu);
                *(bf16_t*)(sm + (pc * 8 + 2 * i + 1) * 144 + tk * 2) = (bf16_t)(w[i] >> 16);
            }
        }
        __syncthreads();
        {
            const int d = tid >> 3, pc = tid & 7;
            *(uint4*)(nvT + ((size_t)bh * 64 + d) * 2304 + tt * 64 + pc * 8) = *(const uint4*)(sm + d * 144 + pc * 16);
        }
    }
    __syncthreads();
}

typedef float f32x4v __attribute__((ext_vector_type(4)));
constexpr int NA_KC = 0, NA_VC = 36864, NA_RPB = 36864 + 33792, NA_CTL = NA_RPB + 14880;
constexpr size_t WS_CNT = 0xE4000;
__device__ __forceinline__ void phase_na(const P& p, int l, unsigned char* sm) {
    const bool need_ctx = (l == 0);
    const bf16_t* nq = (const bf16_t*)(p.ws + WS_NQ); const bf16_t* nk = (const bf16_t*)(p.ws + WS_NK);
    const bf16_t* nvT = (const bf16_t*)(p.ws + WS_NVT);
    bf16_t* mix = (bf16_t*)(p.ws + WS_MIX);
    unsigned* counter = (unsigned*)(p.ws + WS_CNT) + 16 * l;
    const int tid = opaque_tid(); const int lane = tid & 63, wave = tid >> 6;
    float* rpb_s = (float*)(sm + NA_RPB);
    volatile int* ctl = (volatile int*)(sm + NA_CTL);
    __syncthreads();
    for (int i = tid; i < 8 * 465; i += NT) rpb_s[i] = p.na_rpb[(size_t)l * 8 * 465 + i];
    for (;;) {
        __syncthreads();
        if (tid == 0) ctl[0] = (int)atomicAdd(counter, 1u);
        __syncthreads();
        const int item = ctl[0];
        if (item >= 256) break;
        const int bh = item >> 1, half = item & 1, b = bh >> 3, h = bh & 7;
#pragma unroll
        for (int i = 0; i < 4; ++i) {
            const int id = tid + NT * i;
            { const int key = id >> 3, pc = id & 7;
              *(uint4*)(sm + NA_KC + key * 144 + pc * 16) = *(const uint4*)(nk + (size_t)(ML + b * CT + key) * 512 + h * 64 + pc * 8); }
            { const int d = id >> 5, pc = id & 31;
              *(uint4*)(sm + NA_VC + d * 528 + pc * 16) = *(const uint4*)(nvT + ((size_t)bh * 64 + d) * 2304 + 2048 + pc * 8); }
        }
        __syncthreads();
        const int nun = 64 + (need_ctx ? 8 : 0);
        for (int un = wave; un < nun; un += NW) {
            int lane_o = lane; asm volatile("" : "+v"(lane_o));
            const int fr = lane_o & 15, fq = lane_o >> 4, krow_off = 8 * (fr >> 2) + (fr & 3);
            const bool lat = un < 64;
            int qtok0, r = 0, cb = 0;
            if (lat) { r = half * 16 + (un >> 2); cb = un & 3; qtok0 = b * T + r * 64 + cb * 16; }
            else qtok0 = ML + b * CT + (half * 8 + (un - 64)) * 16;
            const int r0 = min(max(r - 4, 0), 24);
            const int c0 = min(max(cb * 16 - 8, 0), 32);
            const int qc = cb * 16 + fr;
            const int wl = min(max(qc - 8, 0), 48);
            const bf16_t* qp = nq + (size_t)(qtok0 + fr) * 512 + h * 64 + 8 * fq;
            const bf16x8 qf0 = *(const bf16x8*)qp, qf1 = *(const bf16x8*)(qp + 32);
            f32x4v sl[16], sc[16];
            float mx = -INFINITY;
            if (lat) {
                const float* rp = rpb_s + h * 465;
#pragma unroll
                for (int t = 0; t < 16; ++t) {
                    const int i = t >> 1, w = t & 1;
                    const bf16_t* kp = nk + (size_t)(b * T + (r0 + i) * 64 + c0 + krow_off + 4 * w) * 512 + h * 64 + 8 * fq;
                    const bf16x8 k0 = *(const bf16x8*)kp, k1 = *(const bf16x8*)(kp + 32);
                    f32x4v a = {0.f, 0.f, 0.f, 0.f};
                    a = __builtin_amdgcn_mfma_f32_16x16x32_bf16(k0, qf0, a, 0, 0, 0);
                    a = __builtin_amdgcn_mfma_f32_16x16x32_bf16(k1, qf1, a, 0, 0, 0);
                    const int brow = (r0 + i - r + 7) * 31;
#pragma unroll
                    for (int j = 0; j < 4; ++j) {
                        const int kc = c0 + 8 * fq + 4 * w + j;
                        const bool ok = (kc >= wl) && (kc < wl + 16);
                        const int dc = min(max(kc - qc + 15, 0), 30);
                        const float v = ok ? a[j] + rp[brow + dc] : -INFINITY;
                        a[j] = v; mx = fmaxf(mx, v);
                    }
                    sl[t] = a;
                }
            }
#pragma unroll
            for (int t = 0; t < 16; ++t) {
                const int pg = t >> 1, w = t & 1;
                const unsigned char* kp = sm + NA_KC + (32 * pg + krow_off + 4 * w) * 144 + 16 * fq;
                const bf16x8 k0 = *(const bf16x8*)kp, k1 = *(const bf16x8*)(kp + 64);
                f32x4v a = {0.f, 0.f, 0.f, 0.f};
                a = __builtin_amdgcn_mfma_f32_16x16x32_bf16(k0, qf0, a, 0, 0, 0);
                a = __builtin_amdgcn_mfma_f32_16x16x32_bf16(k1, qf1, a, 0, 0, 0);
                mx = fmaxf(mx, fmaxf(fmaxf(a[0], a[1]), fmaxf(a[2], a[3])));
                sc[t] = a;
            }
            mx = fmaxf(mx, __shfl_xor(mx, 16)); mx = fmaxf(mx, __shfl_xor(mx, 32));
            float sum = 0.f;
            f32x4v o[4];
#pragma unroll
            for (int m = 0; m < 4; ++m) o[m] = (f32x4v){0.f, 0.f, 0.f, 0.f};
            if (lat) {
                const bf16_t* vbase = nvT + ((size_t)bh * 64 + fr) * 2304 + 8 * fq;
#pragma unroll
                for (int i = 0; i < 8; ++i) {
                    f32x4v p0 = sl[2 * i], p1 = sl[2 * i + 1];
#pragma unroll
                    for (int j = 0; j < 4; ++j) { p0[j] = __expf(p0[j] - mx); p1[j] = __expf(p1[j] - mx); sum += p0[j] + p1[j]; }
                    union { unsigned u[4]; bf16x8 v; } pf;
                    pf.u[0] = pk_bf16(p0[0], p0[1]); pf.u[1] = pk_bf16(p0[2], p0[3]); pf.u[2] = pk_bf16(p1[0], p1[1]); pf.u[3] = pk_bf16(p1[2], p1[3]);
                    const int tok = (r0 + i) * 64 + c0;
#pragma unroll
                    for (int m = 0; m < 4; ++m) {
                        const bf16x8 vf = *(const bf16x8*)(vbase + (size_t)m * 16 * 2304 + tok);
                        o[m] = __builtin_amdgcn_mfma_f32_16x16x32_bf16(vf, pf.v, o[m], 0, 0, 0);
                    }
                }
            }
#pragma unroll
            for (int i = 0; i < 8; ++i) {
                f32x4v p0 = sc[2 * i], p1 = sc[2 * i + 1];
#pragma unroll
                for (int j = 0; j < 4; ++j) { p0[j] = __expf(p0[j] - mx); p1[j] = __expf(p1[j] - mx); sum += p0[j] + p1[j]; }
                union { unsigned u[4]; bf16x8 v; } pf;
                pf.u[0] = pk_bf16(p0[0], p0[1]); pf.u[1] = pk_bf16(p0[2], p0[3]); pf.u[2] = pk_bf16(p1[0], p1[1]); pf.u[3] = pk_bf16(p1[2], p1[3]);
#pragma unroll
                for (int m = 0; m < 4; ++m) {
                    const bf16x8 vf = *(const bf16x8*)(sm + NA_VC + (m * 16 + fr) * 528 + (32 * i + 8 * fq) * 2);
                    o[m] = __builtin_amdgcn_mfma_f32_16x16x32_bf16(vf, pf.v, o[m], 0, 0, 0);
                }
            }
            sum += __shfl_xor(sum, 16); sum += __shfl_xor(sum, 32);
            const float rs = 1.f / sum;
            bf16_t* op = mix + (size_t)(qtok0 + fr) * 1024 + 512 + h * 64 + 4 * fq;
#pragma unroll
            for (int m = 0; m < 4; ++m) {
                uint2 w; w.x = pk_bf16(o[m][0] * rs, o[m][1] * rs); w.y = pk_bf16(o[m][2] * rs, o[m][3] * rs);
                *(uint2*)(op + m * 16) = w;
            }
        }
    }
}

__device__ __forceinline__ void phase_combine(const P& p, int l) {
    const bool need_ctx = (l == 0);
    const bf16_t* hdir = (const bf16_t*)(p.ws + WS_HDIR); const bf16_t* ob = (const bf16_t*)(p.ws + WS_O);
    bf16_t* mix = (bf16_t*)(p.ws + WS_MIX);
    const int tid_ = opaque_tid(); const int lane = tid_ & 63, wave = tid_ >> 6;
    const float4 nw0 = *(const float4*)(p.ml_norm_w + l * 512 + lane * 8), nw1 = *(const float4*)(p.ml_norm_w + l * 512 + lane * 8 + 4);
    const float nw[8] = {nw0.x, nw0.y, nw0.z, nw0.w, nw1.x, nw1.y, nw1.z, nw1.w};
    const int rows = need_ctx ? M : ML;
    for (int r = blockIdx.x * NW + wave; r < rows; r += gridDim.x * NW) {
        const size_t o0 = (size_t)r * 512 + lane * 8;
        const uint4 a = *(const uint4*)(hdir + o0), b = *(const uint4*)(hdir + (size_t)M * 512 + o0), og = *(const uint4*)(ob + o0);
        const unsigned aw[4] = {a.x, a.y, a.z, a.w}, bw[4] = {b.x, b.y, b.z, b.w}, gw[4] = {og.x, og.y, og.z, og.w};
        float v[8]; float s = 0.f;
#pragma unroll
        for (int i = 0; i < 4; ++i) {
            v[2 * i] = __uint_as_float(aw[i] << 16) + __uint_as_float(bw[i] << 16);
            v[2 * i + 1] = __uint_as_float(aw[i] & 0xffff0000u) + __uint_as_float(bw[i] & 0xffff0000u);
            s += v[2 * i] + v[2 * i + 1];
        }
        s += __shfl_xor(s, 8); s += __shfl_xor(s, 4); s += __shfl_xor(s, 2); s += __shfl_xor(s, 1);
        const float mu = s * (1.f / 128.f);
        float q = 0.f;
#pragma unroll
        for (int i = 0; i < 8; ++i) { v[i] -= mu; q += v[i] * v[i]; }
        q += __shfl_xor(q, 8); q += __shfl_xor(q, 4); q += __shfl_xor(q, 2); q += __shfl_xor(q, 1);
        const float rstd = rsqrtf(q * (1.f / 128.f) + LN_EPS);
        float o[8];
#pragma unroll
        for (int i = 0; i < 4; ++i) {
            o[2 * i] = v[2 * i] * rstd * nw[2 * i] * sigmoidf(__uint_as_float(gw[i] << 16));
            o[2 * i + 1] = v[2 * i + 1] * rstd * nw[2 * i + 1] * sigmoidf(__uint_as_float(gw[i] & 0xffff0000u));
        }
        *(uint4*)(mix + (size_t)r * 1024 + lane * 8) = make_uint4(pk_bf16(o[0], o[1]), pk_bf16(o[2], o[3]), pk_bf16(o[4], o[5]), pk_bf16(o[6], o[7]));
    }
}

__device__ __forceinline__ void phase_outproj(const P& p, int l, unsigned char* smraw) {
    const int rows = (l == 0) ? M : ML;
    pg8::Gemm g{(const pg8::bf16_t*)(p.ws + WS_MIX), (const pg8::bf16_t*)(p.ws + WS_WOUT) + (size_t)l * 1024 * 1024, rows, 1024, 1024};
    pg8::StaticOrder S; S.init(rows, 1024, (int)gridDim.x, (int)blockIdx.x);
    pg8::EpiBf16<0> E{(pg8::bf16_t*)(p.ws + WS_Y), 1024, nullptr, 0, 0};
    pg8::gemm_phase<pg8::EpiBf16<0>, pg8::StaticOrder, false>((PG8_LAS unsigned char*)smraw, g, S, E, nullptr);
}

__device__ __forceinline__ void phase_ln1(const P& p, int l) {
    const bf16_t* y = (const bf16_t*)(p.ws + WS_Y);
    bf16_t* u2 = (bf16_t*)(p.ws + WS_U2);
    const float* lw = p.ln1_w + l * D; const float* lb = p.ln1_b + l * D;
    const int tid_ = opaque_tid(); const int lane = tid_ & 63, wave = tid_ >> 6;
    const int rows = (l == 0) ? M : ML;
    constexpr int NR = 4;
    const int k0 = lane * 16;
    for (int rp = blockIdx.x * NW + wave; rp < rows / NR; rp += gridDim.x * NW) {
        float z[NR][16]; float s[NR];
#pragma unroll
        for (int h = 0; h < NR; ++h) s[h] = 0.f;
#pragma unroll
        for (int h = 0; h < NR; ++h) {
            const int r = NR * rp + h;
            const float* xr = xrow(p, l, r); const float* mp = modp(p, l, r);
            const uint4 ya = *(const uint4*)(y + (size_t)r * 1024 + k0), yb = *(const uint4*)(y + (size_t)r * 1024 + k0 + 8);
            const unsigned yw[8] = {ya.x, ya.y, ya.z, ya.w, yb.x, yb.y, yb.z, yb.w};
#pragma unroll
            for (int v4 = 0; v4 < 4; ++v4) {
                const float4 xv = *(const float4*)(xr + k0 + v4 * 4), g1 = *(const float4*)(mp + 2048 + k0 + v4 * 4);
                z[h][v4 * 4 + 0] = ALPHA * xv.x + g1.x * __uint_as_float(yw[v4 * 2] << 16);
                z[h][v4 * 4 + 1] = ALPHA * xv.y + g1.y * __uint_as_float(yw[v4 * 2] & 0xffff0000u);
                z[h][v4 * 4 + 2] = ALPHA * xv.z + g1.z * __uint_as_float(yw[v4 * 2 + 1] << 16);
                z[h][v4 * 4 + 3] = ALPHA * xv.w + g1.w * __uint_as_float(yw[v4 * 2 + 1] & 0xffff0000u);
                s[h] += (z[h][v4 * 4] + z[h][v4 * 4 + 1]) + (z[h][v4 * 4 + 2] + z[h][v4 * 4 + 3]);
            }
        }
        float mu[NR], rstd[NR];
#pragma unroll
        for (int h = 0; h < NR; ++h) mu[h] = wave_sum(s[h]) * (1.f / 1024.f);
#pragma unroll
        for (int h = 0; h < NR; ++h) {
            float q = 0.f;
#pragma unroll
            for (int i = 0; i < 16; ++i) { const float d = z[h][i] - mu[h]; q += d * d; }
            rstd[h] = rsqrtf(wave_sum(q) * (1.f / 1024.f) + LN_EPS);
        }
#pragma unroll
        for (int h = 0; h < NR; ++h) {
            const int r = NR * rp + h;
            const float* mp = modp(p, l, r);
            float* xo = xrow_w(p, r);
            float uo[16]; float am = 0.f;
#pragma unroll
            for (int v4 = 0; v4 < 4; ++v4) {
                const int k = k0 + v4 * 4;
                const float4 w4 = *(const float4*)(lw + k), b4 = *(const float4*)(lb + k), sc = *(const float4*)(mp + 4096 + k), sh = *(const float4*)(mp + 3072 + k);
                float4 o;
                o.x = (z[h][v4 * 4] - mu[h]) * rstd[h] * w4.x + b4.x; o.y = (z[h][v4 * 4 + 1] - mu[h]) * rstd[h] * w4.y + b4.y;
                o.z = (z[h][v4 * 4 + 2] - mu[h]) * rstd[h] * w4.z + b4.z; o.w = (z[h][v4 * 4 + 3] - mu[h]) * rstd[h] * w4.w + b4.w;
                *(float4*)(xo + k) = o;
                uo[v4 * 4] = o.x * (1.f + sc.x) + sh.x; uo[v4 * 4 + 1] = o.y * (1.f + sc.y) + sh.y; uo[v4 * 4 + 2] = o.z * (1.f + sc.z) + sh.z; uo[v4 * 4 + 3] = o.w * (1.f + sc.w) + sh.w;
            }
            bf16_t* up_ = u2 + (size_t)r * 1024 + k0;
            *(uint4*)up_ = make_uint4(pk_bf16(uo[0], uo[1]), pk_bf16(uo[2], uo[3]), pk_bf16(uo[4], uo[5]), pk_bf16(uo[6], uo[7]));
            *(uint4*)(up_ + 8) = make_uint4(pk_bf16(uo[8], uo[9]), pk_bf16(uo[10], uo[11]), pk_bf16(uo[12], uo[13]), pk_bf16(uo[14], uo[15]));
#pragma unroll
            for (int i = 0; i < 16; ++i) am = fmaxf(am, fabsf(uo[i]));
            am = wave_max(am);
            const float inv = am > 0.f ? 127.f / am : 0.f;
            unsigned w[4];
#pragma unroll
            for (int d = 0; d < 4; ++d) {
                unsigned x = 0;
#pragma unroll
                for (int i = 0; i < 4; ++i) x |= (unsigned)(min(max((int)rintf(uo[d * 4 + i] * inv), -127), 127) & 0xff) << (8 * i);
                w[d] = x;
            }
            *(uint4*)(p.ws + WS_U2Q + (size_t)r * 1024 + k0) = make_uint4(w[0], w[1], w[2], w[3]);
            if (lane == 0) ((float*)(p.ws + WS_USC))[r] = am > 0.f ? am / 127.f : 0.f;
        }
    }
}

__device__ __forceinline__ void phase_peerq(const P& p, int l, unsigned char* smraw) {
    const int rows = (l == 0) ? M : ML;
    pg8::Gemm g{(const pg8::bf16_t*)(p.ws + WS_U2), (const pg8::bf16_t*)(p.ws + WS_WQ) + (size_t)l * 2048 * 1024, rows, 2048, 1024};
    pg8::StaticOrder S; S.init(rows, 2048, (int)gridDim.x, (int)blockIdx.x);
    pg8::EpiBf16<0> E{(pg8::bf16_t*)(p.ws + WS_Q), 2048, nullptr, 0, 0};
    pg8::gemm_phase<pg8::EpiBf16<0>, pg8::StaticOrder, false>((PG8_LAS unsigned char*)smraw, g, S, E, nullptr);
}

__device__ __forceinline__ unsigned f2key(float f) { const unsigned u = __float_as_uint(f); return (u & 0x80000000u) ? ~u : (u | 0x80000000u); }
__device__ __forceinline__ float key2f(unsigned k) { const unsigned u = (k & 0x80000000u) ? (k & 0x7fffffffu) : ~k; return __uint_as_float(u); }
__device__ __forceinline__ void ce_desc(unsigned& a, unsigned& b) { const unsigned mx = a > b ? a : b, mn = a > b ? b : a; a = mx; b = mn; }
__device__ __forceinline__ void sort16_desc(unsigned (&a)[16]) {
#pragma unroll
    for (int k = 2; k <= 16; k <<= 1)
#pragma unroll
        for (int j = k >> 1; j > 0; j >>= 1)
#pragma unroll
            for (int i = 0; i < 16; ++i) { const int l = i ^ j; if (l > i) { if ((i & k) == 0) ce_desc(a[i], a[l]); else ce_desc(a[l], a[i]); } }
}
__device__ __forceinline__ void merge16_desc(unsigned (&a)[16], const unsigned (&b)[16]) {
#pragma unroll
    for (int i = 0; i < 16; ++i) a[i] = a[i] > b[15 - i] ? a[i] : b[15 - i];
#pragma unroll
    for (int j = 8; j > 0; j >>= 1)
#pragma unroll
        for (int i = 0; i < 16; ++i) { const int l = i ^ j; if (l > i) ce_desc(a[i], a[l]); }
}
__device__ __forceinline__ void top16_of_acc(const f32x16 (&acc)[4], int hh, unsigned (&out)[16]) {
    unsigned g1[16], g2[16], g3[16];
#pragma unroll
    for (int r = 0; r < 16; ++r) {
        const int nb = (r & 3) + 8 * (r >> 2);
        out[r] = (f2key(acc[0][r]) & ~127u) | (unsigned)(127 - (nb + 4 * hh));
        g1[r]  = (f2key(acc[1][r]) & ~127u) | (unsigned)(127 - (32 + nb + 4 * hh));
        g2[r]  = (f2key(acc[2][r]) & ~127u) | (unsigned)(127 - (64 + nb + 4 * hh));
        g3[r]  = (f2key(acc[3][r]) & ~127u) | (unsigned)(127 - (96 + nb + 4 * hh));
    }
    sort16_desc(out); sort16_desc(g1); sort16_desc(g2); sort16_desc(g3);
    merge16_desc(out, g1); merge16_desc(g2, g3); merge16_desc(out, g2);
#pragma unroll
    for (int i = 0; i < 16; ++i) g1[i] = (unsigned)__shfl_xor((int)out[i], 32);
    merge16_desc(out, g1);
}
constexpr int TK_KEYS_BYTES = 256 * 272;
__device__ __forceinline__ void phase_topk(const P& p, int l, unsigned char* smraw) {
    const bf16_t* q = (const bf16_t*)(p.ws + WS_Q);
    int* eidx = (int*)(p.ws + WS_EIDX); float* egate = (float*)(p.ws + WS_EGATE);
    const int tid = opaque_tid(); const int lane = tid & 63, wave = tid >> 6, tl = lane & 31, hh = lane >> 5;
    unsigned char* keys_lds = smraw;
    unsigned char* slot = smraw + TK_KEYS_BYTES + wave * 2048 + lane * 32;
    const int rows = (l == 0) ? M : ML;
    const int nchunks = rows / 256;
    int cur_h = -1;
    for (int it = blockIdx.x; it < 8 * nchunks; it += gridDim.x) {
        const int h = it & 7, chunk = it >> 3;
        if (h != cur_h) {
            __syncthreads();
            const float* kb = p.peer_keys + (size_t)(l * 8 + h) * 2 * 128 * 128;
            for (int i = tid; i < 256 * 16; i += NT) {
                const int row = i >> 4, c8 = i & 15;
                const float4 f0 = *(const float4*)(kb + (size_t)row * 128 + c8 * 8), f1 = *(const float4*)(kb + (size_t)row * 128 + c8 * 8 + 4);
                uint4 w; w.x = (unsigned)f2bf(f0.x) | ((unsigned)f2bf(f0.y) << 16); w.y = (unsigned)f2bf(f0.z) | ((unsigned)f2bf(f0.w) << 16);
                w.z = (unsigned)f2bf(f1.x) | ((unsigned)f2bf(f1.y) << 16); w.w = (unsigned)f2bf(f1.z) | ((unsigned)f2bf(f1.w) << 16);
                *(uint4*)(keys_lds + row * 272 + c8 * 16) = w;
            }
            __syncthreads();
            cur_h = h;
        }
        const int t0 = (chunk * 8 + wave) * 32;
        const bf16_t* qrow = q + (size_t)(t0 + tl) * 2048 + h * 256 + 8 * hh;
        unsigned T1[16], T2[16];
#pragma unroll
        for (int half = 0; half < 2; ++half) {
            bf16x8 bq[8];
#pragma unroll
            for (int ks = 0; ks < 8; ++ks) bq[ks] = *(const bf16x8*)(qrow + half * 128 + ks * 16);
            f32x16 acc[4];
#pragma unroll
            for (int mt = 0; mt < 4; ++mt)
#pragma unroll
                for (int r = 0; r < 16; ++r) acc[mt][r] = 0.f;
#pragma unroll
            for (int ks = 0; ks < 8; ++ks)
#pragma unroll
                for (int mt = 0; mt < 4; ++mt) {
                    const bf16x8 a = *(const bf16x8*)(keys_lds + (half * 128 + mt * 32 + tl) * 272 + ks * 32 + 16 * hh);
                    acc[mt] = __builtin_amdgcn_mfma_f32_32x32x16_bf16(a, bq[ks], acc[mt], 0, 0, 0);
                }
            if (half == 0) top16_of_acc(acc, hh, T1); else top16_of_acc(acc, hh, T2);
        }
        {
            uint4 w1, w2;
#define PK4(T, o) ((127u - (T[o] & 127u)) | ((127u - (T[o + 1] & 127u)) << 8) | ((127u - (T[o + 2] & 127u)) << 16) | ((127u - (T[o + 3] & 127u)) << 24))
            w1.x = PK4(T1, 0); w1.y = PK4(T1, 4); w1.z = PK4(T1, 8); w1.w = PK4(T1, 12);
            w2.x = PK4(T2, 0); w2.y = PK4(T2, 4); w2.z = PK4(T2, 8); w2.w = PK4(T2, 12);
#undef PK4
            *(uint4*)slot = w1; *(uint4*)(slot + 16) = w2;
        }
        float v1[16], v2[16];
#pragma unroll
        for (int i = 0; i < 16; ++i) { v1[i] = key2f(T1[i] & ~127u); v2[i] = key2f(T2[i] & ~127u); }
        unsigned cg0[16], cg1[16], cg2[16], cg3[16];
        cg0[0] = (f2key(v1[0] + v2[0]) & ~255u) | 255u;
        cg0[1] = (f2key(v1[0] + v2[1]) & ~255u) | 254u;
        cg0[2] = (f2key(v1[0] + v2[2]) & ~255u) | 253u;
        cg0[3] = (f2key(v1[0] + v2[3]) & ~255u) | 252u;
        cg0[4] = (f2key(v1[0] + v2[4]) & ~255u) | 251u;
        cg0[5] = (f2key(v1[0] + v2[5]) & ~255u) | 250u;
        cg0[6] = (f2key(v1[0] + v2[6]) & ~255u) | 249u;
        cg0[7] = (f2key(v1[0] + v2[7]) & ~255u) | 248u;
        cg0[8] = (f2key(v1[0] + v2[8]) & ~255u) | 247u;
        cg0[9] = (f2key(v1[0] + v2[9]) & ~255u) | 246u;
        cg0[10] = (f2key(v1[0] + v2[10]) & ~255u) | 245u;
        cg0[11] = (f2key(v1[0] + v2[11]) & ~255u) | 244u;
        cg0[12] = (f2key(v1[0] + v2[12]) & ~255u) | 243u;
        cg0[13] = (f2key(v1[0] + v2[13]) & ~255u) | 242u;
        cg0[14] = (f2key(v1[0] + v2[14]) & ~255u) | 241u;
        cg0[15] = (f2key(v1[0] + v2[15]) & ~255u) | 240u;
        cg1[0] = (f2key(v1[1] + v2[0]) & ~255u) | 239u;
        cg1[1] = (f2key(v1[1] + v2[1]) & ~255u) | 238u;
        cg1[2] = (f2key(v1[1] + v2[2]) & ~255u) | 237u;
        cg1[3] = (f2key(v1[1] + v2[3]) & ~255u) | 236u;
        cg1[4] = (f2key(v1[1] + v2[4]) & ~255u) | 235u;
        cg1[5] = (f2key(v1[1] + v2[5]) & ~255u) | 234u;
        cg1[6] = (f2key(v1[1] + v2[6]) & ~255u) | 233u;
        cg1[7] = (f2key(v1[1] + v2[7]) & ~255u) | 232u;
        cg1[8] = (f2key(v1[2] + v2[0]) & ~255u) | 223u;
        cg1[9] = (f2key(v1[2] + v2[1]) & ~255u) | 222u;
        cg1[10] = (f2key(v1[2] + v2[2]) & ~255u) | 221u;
        cg1[11] = (f2key(v1[2] + v2[3]) & ~255u) | 220u;
        cg1[12] = (f2key(v1[2] + v2[4]) & ~255u) | 219u;
        cg1[13] = (f2key(v1[3] + v2[0]) & ~255u) | 207u;
        cg1[14] = (f2key(v1[3] + v2[1]) & ~255u) | 206u;
        cg1[15] = (f2key(v1[3] + v2[2]) & ~255u) | 205u;
        cg2[0] = (f2key(v1[3] + v2[3]) & ~255u) | 204u;
        cg2[1] = (f2key(v1[4] + v2[0]) & ~255u) | 191u;
        cg2[2] = (f2key(v1[4] + v2[1]) & ~255u) | 190u;
        cg2[3] = (f2key(v1[4] + v2[2]) & ~255u) | 189u;
        cg2[4] = (f2key(v1[5] + v2[0]) & ~255u) | 175u;
        cg2[5] = (f2key(v1[5] + v2[1]) & ~255u) | 174u;
        cg2[6] = (f2key(v1[6] + v2[0]) & ~255u) | 159u;
        cg2[7] = (f2key(v1[6] + v2[1]) & ~255u) | 158u;
        cg2[8] = (f2key(v1[7] + v2[0]) & ~255u) | 143u;
        cg2[9] = (f2key(v1[7] + v2[1]) & ~255u) | 142u;
        cg2[10] = (f2key(v1[8] + v2[0]) & ~255u) | 127u;
        cg2[11] = (f2key(v1[9] + v2[0]) & ~255u) | 111u;
        cg2[12] = (f2key(v1[10] + v2[0]) & ~255u) | 95u;
        cg2[13] = (f2key(v1[11] + v2[0]) & ~255u) | 79u;
        cg2[14] = (f2key(v1[12] + v2[0]) & ~255u) | 63u;
        cg2[15] = (f2key(v1[13] + v2[0]) & ~255u) | 47u;
        cg3[0] = (f2key(v1[14] + v2[0]) & ~255u) | 31u;
        cg3[1] = (f2key(v1[15] + v2[0]) & ~255u) | 15u;
        cg3[2] = 0u;
        cg3[3] = 0u;
        cg3[4] = 0u;
        cg3[5] = 0u;
        cg3[6] = 0u;
        cg3[7] = 0u;
        cg3[8] = 0u;
        cg3[9] = 0u;
        cg3[10] = 0u;
        cg3[11] = 0u;
        cg3[12] = 0u;
        cg3[13] = 0u;
        cg3[14] = 0u;
        cg3[15] = 0u;
        sort16_desc(cg0); sort16_desc(cg1); sort16_desc(cg2); sort16_desc(cg3);
        merge16_desc(cg0, cg1); merge16_desc(cg2, cg3); merge16_desc(cg0, cg2);
        const float top0 = key2f(cg0[0] & ~255u);
        float ev[16]; float es = 0.f;
#pragma unroll
        for (int j = 0; j < 16; ++j) { ev[j] = expf(key2f(cg0[j] & ~255u) - top0); es += ev[j]; }
        const float rs = 1.f / es;
        __builtin_amdgcn_wave_barrier();
        int eo[8]; float go[8];
#pragma unroll
        for (int jj = 0; jj < 8; ++jj) {
            const unsigned wlo_ = cg0[jj], whi_ = cg0[jj + 8]; const unsigned w = hh ? whi_ : wlo_;
            const unsigned cid = 255u - (w & 255u);
            const int i1 = slot[cid >> 4], i2 = slot[16 + (cid & 15u)];
            eo[jj] = i1 * 128 + i2;
            const float elo_ = ev[jj], ehi_ = ev[jj + 8]; go[jj] = (hh ? ehi_ : elo_) * rs;
        }
        int* ep = eidx + (size_t)(t0 + tl) * 128 + h * 16 + 8 * hh;
        float* gp = egate + (size_t)(t0 + tl) * 128 + h * 16 + 8 * hh;
        *(int4*)ep = make_int4(eo[0], eo[1], eo[2], eo[3]); *(int4*)(ep + 4) = make_int4(eo[4], eo[5], eo[6], eo[7]);
        *(float4*)gp = make_float4(go[0], go[1], go[2], go[3]); *(float4*)(gp + 4) = make_float4(go[4], go[5], go[6], go[7]);
        __builtin_amdgcn_wave_barrier();
    }
}

__device__ __forceinline__ void phase_tabprep(const P& p, int l, unsigned char* sm) {
    const int tid_ = opaque_tid(); const int lane = tid_ & 63, wave = tid_ >> 6;
    float* sc = (float*)(p.ws + WS_TSC);
    unsigned* counter = (unsigned*)(p.ws + WS_CNT) + 16 * (2 + l);
    volatile int* ctl = (volatile int*)sm;
    for (;;) {
        __syncthreads();
        if (tid_ == 0) ctl[0] = (int)atomicAdd(counter, 1u);
        __syncthreads();
        const int chunk = ctl[0];
        if (chunk >= 512) break;
      for (int jj = 0; jj < 8; ++jj) {
        const int job = chunk * 64 + jj * 8 + wave;
        const int tbl = job >> 14, e = job & 16383;
        const float* src = (tbl ? p.peer_down : p.peer_up) + ((size_t)l * 16384 + e) * 1024 + lane * 16;
        const float4 v0 = *(const float4*)src, v1 = *(const float4*)(src + 4), v2 = *(const float4*)(src + 8), v3 = *(const float4*)(src + 12);
        const float f[16] = {v0.x, v0.y, v0.z, v0.w, v1.x, v1.y, v1.z, v1.w, v2.x, v2.y, v2.z, v2.w, v3.x, v3.y, v3.z, v3.w};
        float am = 0.f;
#pragma unroll
        for (int i = 0; i < 16; ++i) am = fmaxf(am, fabsf(f[i]));
        am = wave_max(am);
        const float inv = am > 0.f ? 127.f / am : 0.f;
        unsigned w[4];
#pragma unroll
        for (int d = 0; d < 4; ++d) {
            unsigned x = 0;
#pragma unroll
            for (int i = 0; i < 4; ++i) { const int q = min(max((int)rintf(f[d * 4 + i] * inv), -127), 127); x |= (unsigned)(q & 0xff) << (8 * i); }
            w[d] = x;
        }
        *(uint4*)(p.ws + (tbl ? WS_TDN : WS_TUP) + (size_t)(lane >> 3) * (16384 * 128) + (size_t)e * 128 + (lane & 7) * 16) = make_uint4(w[0], w[1], w[2], w[3]);
        if (lane == 0) sc[job] = am > 0.f ? am / 127.f : 0.f;
      }
    }
    __syncthreads();
}

constexpr size_t WS_PD = WS_Q;
__device__ __forceinline__ float readlane_f(float v, int l) { return __int_as_float(__builtin_amdgcn_readlane(__float_as_int(v), l)); }
__device__ __forceinline__ float dot16u8(const uint4& w, const float* u, float acc) {
    const unsigned ww[4] = {w.x, w.y, w.z, w.w};
#pragma unroll
    for (int d = 0; d < 4; ++d)
#pragma unroll
        for (int i = 0; i < 4; ++i) acc += u[d * 4 + i] * (float)((ww[d] >> (8 * i)) & 0xffu);
    return acc;
}
__device__ __forceinline__ void fma16u8(float* y, const uint4& w, float a) {
    const unsigned ww[4] = {w.x, w.y, w.z, w.w};
#pragma unroll
    for (int d = 0; d < 4; ++d)
#pragma unroll
        for (int i = 0; i < 4; ++i) y[d * 4 + i] += a * (float)((ww[d] >> (8 * i)) & 0xffu);
}
__device__ __forceinline__ int idot16(const uint4& w, const uint4& u) {
    int a = __builtin_amdgcn_sdot4((int)w.x, (int)u.x, 0, false); a = __builtin_amdgcn_sdot4((int)w.y, (int)u.y, a, false);
    a = __builtin_amdgcn_sdot4((int)w.z, (int)u.z, a, false); return __builtin_amdgcn_sdot4((int)w.w, (int)u.w, a, false);
}
__device__ __forceinline__ void tdot4x4(int* y, const uint4& w0, const uint4& w1, const uint4& w2, const uint4& w3, unsigned cq) {
    const unsigned a0[4] = {w0.x, w0.y, w0.z, w0.w}, a1[4] = {w1.x, w1.y, w1.z, w1.w}, a2[4] = {w2.x, w2.y, w2.z, w2.w}, a3[4] = {w3.x, w3.y, w3.z, w3.w};
#pragma unroll
    for (int r = 0; r < 4; ++r) {
        const unsigned lo01 = __builtin_amdgcn_perm(a1[r], a0[r], 0x05010400u), hi01 = __builtin_amdgcn_perm(a1[r], a0[r], 0x07030602u);
        const unsigned lo23 = __builtin_amdgcn_perm(a3[r], a2[r], 0x05010400u), hi23 = __builtin_amdgcn_perm(a3[r], a2[r], 0x07030602u);
        const unsigned c0 = __builtin_amdgcn_perm(lo23, lo01, 0x05040100u), c1 = __builtin_amdgcn_perm(lo23, lo01, 0x07060302u);
        const unsigned c2 = __builtin_amdgcn_perm(hi23, hi01, 0x05040100u), c3 = __builtin_amdgcn_perm(hi23, hi01, 0x07060302u);
        y[4 * r + 0] = __builtin_amdgcn_sdot4((int)c0, (int)cq, y[4 * r + 0], false);
        y[4 * r + 1] = __builtin_amdgcn_sdot4((int)c1, (int)cq, y[4 * r + 1], false);
        y[4 * r + 2] = __builtin_amdgcn_sdot4((int)c2, (int)cq, y[4 * r + 2], false);
        y[4 * r + 3] = __builtin_amdgcn_sdot4((int)c3, (int)cq, y[4 * r + 3], false);
    }
}
__device__ __forceinline__ unsigned my_xcc() { return (unsigned)__builtin_amdgcn_s_getreg((3 << 11) | 20) & 7u; }

template <int PH>
__device__ __forceinline__ void phase_eslice(const P& p, int l, unsigned char* sm) {
    const bf16_t* u2 = (const bf16_t*)(p.ws + WS_U2);
    const int* eidx = (const int*)(p.ws + WS_EIDX); const float* coefp = (const float*)(p.ws + WS_EGATE);
    const unsigned char* tab = p.ws + (PH == 0 ? WS_TUP : WS_TDN);
    float* pd = (float*)(p.ws + WS_PD);
    unsigned* cnts = (unsigned*)(p.ws + WS_CNT + 256) + (size_t)((l * 2 + PH) * 8) * 16;
    const int tid = opaque_tid(); const int lane = tid & 63, wave = tid >> 6;
    volatile int* ctl = (volatile int*)sm;
    const int rows = (l == 0) ? M : ML;
    const int nchunks = rows / 128;
    const unsigned xcc = my_xcc();
    for (int att = 0; att < 8; ++att) {
        const int slice = (int)((xcc + (unsigned)att) & 7u);
        for (;;) {
            __syncthreads();
            if (tid == 0) ctl[0] = (int)atomicAdd(cnts + slice * 16, 1u);
            __syncthreads();
            const int chunk = ctl[0];
            if (chunk >= nchunks) break;
            int lane_o = lane; asm volatile("" : "+v"(lane_o));
            const int sub = lane_o & 7, g = lane_o >> 3;
            const int t0 = chunk * 128 + wave * 16;
            const unsigned char* tsl = tab + (size_t)slice * (16384 * 128) + sub * 16;
#define LD_EV(dst, tok) do { const int4* ep_ = (const int4*)(eidx + (size_t)(tok) * 128 + 16 * g); dst[0] = ep_[0]; dst[1] = ep_[1]; dst[2] = ep_[2]; dst[3] = ep_[3]; } while (0)
#define GATHER(dst, ev) do { _Pragma("unroll") for (int q_ = 0; q_ < 4; ++q_) { \
            dst[4 * q_ + 0] = *(const uint4*)(tsl + (size_t)ev[q_].x * 128); dst[4 * q_ + 1] = *(const uint4*)(tsl + (size_t)ev[q_].y * 128); \
            dst[4 * q_ + 2] = *(const uint4*)(tsl + (size_t)ev[q_].z * 128); dst[4 * q_ + 3] = *(const uint4*)(tsl + (size_t)ev[q_].w * 128); } } while (0)
#define LD_SMALL(dst, tok) do { if (PH == 0) { dst[0] = *(const uint4*)(p.ws + WS_U2Q + (size_t)(tok) * 1024 + slice * 128 + sub * 16); } \
            else { const unsigned char* rb_ = (const unsigned char*)(coefp + (size_t)(tok) * 128); dst[0] = *(const uint4*)(rb_ + 16 * g); dst[1].x = *(const unsigned*)(rb_ + 128); } } while (0)
            auto compute = [&](const uint4 (&W)[16], const uint4 (&smx)[2], const int t) {
                if (PH == 0) {
                    float acc[16];
#pragma unroll
                    for (int b = 0; b < 16; ++b) acc[b] = (float)idot16(W[b], smx[0]);
                    const bool s4 = sub & 4, s2 = sub & 2, s1 = sub & 1;
                    float d8[8];
#pragma unroll
                    for (int i = 0; i < 8; ++i) { const float lo_ = acc[i], hi_ = acc[i + 8]; const float keep = s4 ? hi_ : lo_, send = s4 ? lo_ : hi_; d8[i] = keep + __shfl_xor(send, 4); }
                    float d4[4];
#pragma unroll
                    for (int i = 0; i < 4; ++i) { const float lo_ = d8[i], hi_ = d8[i + 4]; const float keep = s2 ? hi_ : lo_, send = s2 ? lo_ : hi_; d4[i] = keep + __shfl_xor(send, 2); }
                    float d2[2];
#pragma unroll
                    for (int i = 0; i < 2; ++i) { const float lo_ = d4[i], hi_ = d4[i + 2]; const float keep = s1 ? hi_ : lo_, send = s1 ? lo_ : hi_; d2[i] = keep + __shfl_xor(send, 1); }
                    const int b0 = (s4 ? 8 : 0) + (s2 ? 4 : 0) + (s1 ? 2 : 0);
                    *(float2*)(pd + ((size_t)slice * rows + t) * 128 + 16 * g + b0) = make_float2(d2[0], d2[1]);
                } else {
                    int yi[16];
#pragma unroll
                    for (int i = 0; i < 16; ++i) yi[i] = 0;
                    const unsigned cq[4] = {smx[0].x, smx[0].y, smx[0].z, smx[0].w};
                    const float csc = __uint_as_float(smx[1].x);
                    tdot4x4(yi, W[0], W[1], W[2], W[3], cq[0]); tdot4x4(yi, W[4], W[5], W[6], W[7], cq[1]);
                    tdot4x4(yi, W[8], W[9], W[10], W[11], cq[2]); tdot4x4(yi, W[12], W[13], W[14], W[15], cq[3]);
                    const bool h32 = lane_o & 32, h16 = lane_o & 16, h8 = lane_o & 8;
                    int y8[8];
#pragma unroll
                    for (int i = 0; i < 8; ++i) { const int lo_ = yi[i], hi_ = yi[i + 8]; const int keep = h32 ? hi_ : lo_, send = h32 ? lo_ : hi_; y8[i] = keep + __shfl_xor(send, 32); }
                    int y4[4];
#pragma unroll
                    for (int i = 0; i < 4; ++i) { const int lo_ = y8[i], hi_ = y8[i + 4]; const int keep = h16 ? hi_ : lo_, send = h16 ? lo_ : hi_; y4[i] = keep + __shfl_xor(send, 16); }
                    int y2[2];
#pragma unroll
                    for (int i = 0; i < 2; ++i) { const int lo_ = y4[i], hi_ = y4[i + 2]; const int keep = h8 ? hi_ : lo_, send = h8 ? lo_ : hi_; y2[i] = keep + __shfl_xor(send, 8); }
                    const int col = slice * 128 + sub * 16 + (h32 ? 8 : 0) + (h16 ? 4 : 0) + (h8 ? 2 : 0);
                    const float* mp = modp(p, l, t);
                    float* xo = xrow_w(p, t);
                    const float2 xv = *(const float2*)(xo + col), gg = *(const float2*)(mp + 5120 + col);
                    float2 z; z.x = ALPHA * xv.x + gg.x * ((float)y2[0] * csc); z.y = ALPHA * xv.y + gg.y * ((float)y2[1] * csc);
                    *(float2*)(xo + col) = z;
                }
            };
            int4 ev0[4], ev1[4];
            uint4 WA[16], WB[16];
            uint4 sm0[2], sm1[2];
            sm0[1] = make_uint4(0, 0, 0, 0); sm1[1] = make_uint4(0, 0, 0, 0);
            LD_EV(ev0, t0); LD_EV(ev1, t0 + 1);
            LD_SMALL(sm0, t0); LD_SMALL(sm1, t0 + 1);
            GATHER(WA, ev0);
            LD_EV(ev0, t0 + 2);
#pragma unroll 1
            for (int tk = 0; tk < 16; tk += 2) {
                const int t = t0 + tk;
                GATHER(WB, ev1);
                if (tk + 3 < 16) LD_EV(ev1, t + 3);
                compute(WA, sm0, t);
                if (tk + 2 < 16) { LD_SMALL(sm0, t + 2); GATHER(WA, ev0); }
                if (tk + 4 < 16) LD_EV(ev0, t + 4);
                compute(WB, sm1, t + 1);
                if (tk + 3 < 16) LD_SMALL(sm1, t + 3);
            }
#undef LD_EV
#undef GATHER
#undef LD_SMALL
        }
    }
    __syncthreads();
}

__device__ __forceinline__ void phase_ecoef(const P& p, int l) {
    const int* eidx = (const int*)(p.ws + WS_EIDX); float* egate = (float*)(p.ws + WS_EGATE);
    const float* pd = (const float*)(p.ws + WS_PD);
    const float* scu = (const float*)(p.ws + WS_TSC); const float* scd = scu + 16384;
    const int tid_ = opaque_tid(); const int lane = tid_ & 63, wave = tid_ >> 6;
    const int rows = (l == 0) ? M : ML;
    for (int r = blockIdx.x * NW + wave; r < rows; r += gridDim.x * NW) {
        const float usc = ((const float*)(p.ws + WS_USC))[r];
        float cf[2];
#pragma unroll
        for (int hf = 0; hf < 2; ++hf) {
            const int j = hf * 64 + lane;
            float d = 0.f;
#pragma unroll
            for (int x = 0; x < 8; ++x) d += pd[((size_t)x * rows + r) * 128 + j];
            const int e = eidx[(size_t)r * 128 + j];
            cf[hf] = egate[(size_t)r * 128 + j] * scd[e] * gelu_tanh(scu[e] * usc * d);
        }
        const float am = wave_max(fmaxf(fabsf(cf[0]), fabsf(cf[1])));
        const float inv = am > 0.f ? 127.f / am : 0.f;
        unsigned char* rowb = (unsigned char*)(egate + (size_t)r * 128);
        const int q0 = min(max((int)rintf(cf[0] * inv), -127), 127), q1 = min(max((int)rintf(cf[1] * inv), -127), 127);
        __builtin_amdgcn_wave_barrier();
        rowb[lane] = (unsigned char)(q0 & 0xff); rowb[64 + lane] = (unsigned char)(q1 & 0xff);
        if (lane == 0) *(float*)(rowb + 128) = am > 0.f ? am / 127.f : 0.f;
    }
}

__device__ __forceinline__ void phase_eln(const P& p, int l, float* sm) {
    const float* lw = p.ln2_w + l * D; const float* lb = p.ln2_b + l * D;
    const int tid_ = opaque_tid(); const int lane = tid_ & 63, wave = tid_ >> 6;
    const int rows = (l == 0) ? M : ML;
    const bool nxt = (l == 0);
    bf16_t* u1 = (bf16_t*)(p.ws + WS_U1);
    float* gates = (float*)(p.ws + WS_GATES);
    if (nxt) {
        __syncthreads();
        for (int i = tid_; i < 16 * 1024; i += NT) { const int k = i >> 4, g = i & 15; sm[g * 1024 + k] = p.w_in[(size_t)(l + 1) * D * D_IN + (size_t)k * D_IN + 1536 + g]; }
        __syncthreads();
    }
    for (int r = blockIdx.x * NW + wave; r < rows; r += gridDim.x * NW) {
        float* xo = xrow_w(p, r);
        const int k0 = lane * 16;
        float z[16]; float s = 0.f;
#pragma unroll
        for (int v4 = 0; v4 < 4; ++v4) {
            const float4 v = *(const float4*)(xo + k0 + v4 * 4);
            z[v4 * 4] = v.x; z[v4 * 4 + 1] = v.y; z[v4 * 4 + 2] = v.z; z[v4 * 4 + 3] = v.w;
            s += (v.x + v.y) + (v.z + v.w);
        }
        const float mu = wave_sum(s) * (1.f / 1024.f);
        float q = 0.f;
#pragma unroll
        for (int i = 0; i < 16; ++i) { const float d = z[i] - mu; q += d * d; }
        const float rstd = rsqrtf(wave_sum(q) * (1.f / 1024.f) + LN_EPS);
#pragma unroll
        for (int v4 = 0; v4 < 4; ++v4) {
            const int k = k0 + v4 * 4;
            const float4 w4 = *(const float4*)(lw + k), b4 = *(const float4*)(lb + k);
            float4 o;
            o.x = (z[v4 * 4] - mu) * rstd * w4.x + b4.x; o.y = (z[v4 * 4 + 1] - mu) * rstd * w4.y + b4.y;
            o.z = (z[v4 * 4 + 2] - mu) * rstd * w4.z + b4.z; o.w = (z[v4 * 4 + 3] - mu) * rstd * w4.w + b4.w;
            *(float4*)(xo + k) = o;
            z[v4 * 4] = o.x; z[v4 * 4 + 1] = o.y; z[v4 * 4 + 2] = o.z; z[v4 * 4 + 3] = o.w;
        }
        if (nxt) {
            const float* mp = modp(p, l + 1, r);
            float ga[16];
#pragma unroll
            for (int g = 0; g < 16; ++g) ga[g] = 0.f;
#pragma unroll 1
            for (int v4 = 0; v4 < 4; ++v4) {
                const int k = k0 + v4 * 4;
                const float4 sc = *(const float4*)(mp + 1024 + k), sh = *(const float4*)(mp + k);
                const float u[4] = {z[v4 * 4] * (1.f + sc.x) + sh.x, z[v4 * 4 + 1] * (1.f + sc.y) + sh.y, z[v4 * 4 + 2] * (1.f + sc.z) + sh.z, z[v4 * 4 + 3] * (1.f + sc.w) + sh.w};
                uint2 pk; pk.x = pk_bf16(u[0], u[1]); pk.y = pk_bf16(u[2], u[3]);
                *(uint2*)(u1 + (size_t)r * 1024 + k) = pk;
#pragma unroll
                for (int g = 0; g < 16; ++g) {
                    const float4 w = *(const float4*)(sm + g * 1024 + k);
                    ga[g] += u[0] * w.x + u[1] * w.y + u[2] * w.z + u[3] * w.w;
                }
            }
            const float mine = wave_sum16(ga, lane);
            if (lane < 16) gates[(size_t)r * 16 + lane] = mine + p.b_gate[(l + 1) * 16 + lane];
        }
    }
    __syncthreads();
}

#define XB_TMO      128
#define XB_XCNT(j)  (256  + 64 * (j))
#define XB_XSUB(j)  (1280 + 64 * (j))
#define XB_XGEN(j)  (2304 + 64 * (j))
#define XB_TOP      3328
#define XB_TOPGEN   3392
#define XCD_BAR_WORDS 3456
#define XB_SPIN_CAP (1u << 18)
#define LAS __attribute__((address_space(3)))

__device__ __forceinline__ unsigned xb_ld(unsigned* p)              { return __hip_atomic_load(p, __ATOMIC_RELAXED, __HIP_MEMORY_SCOPE_AGENT); }
__device__ __forceinline__ unsigned xb_add(unsigned* p, unsigned v) { return __hip_atomic_fetch_add(p, v, __ATOMIC_RELAXED, __HIP_MEMORY_SCOPE_AGENT); }
__device__ __forceinline__ unsigned xb_xcc_id() { return (unsigned)__builtin_amdgcn_s_getreg((3 << 11) | 20) & 0xFu; }
#define XB_SPIN(cond, bar) do { unsigned _sp = 0; while (cond) { __builtin_amdgcn_s_sleep(1); \
    if ((++_sp & 255u) == 0u) { if (xb_ld(&(bar)[XB_TMO])) break; if (_sp > XB_SPIN_CAP) { atomicAdd(&(bar)[XB_TMO], 1u); break; } } } } while (0)

struct XcdBarrier {
    unsigned* bar; unsigned x;
    volatile LAS unsigned* st;
};

__device__ __forceinline__ XcdBarrier xcd_barrier_post(unsigned* bar, volatile LAS unsigned* st) {
    XcdBarrier b; b.bar = bar; b.x = xb_xcc_id(); b.st = st;
    if (threadIdx.x == 0) (void)xb_add(&bar[XB_XCNT(b.x)], 1u);
    return b;
}
__device__ __forceinline__ void xcd_barrier_complete(unsigned* bar, unsigned x, unsigned& nloc, unsigned& nx) {
    const unsigned G = gridDim.x * gridDim.y * gridDim.z;
    unsigned sum, cnt, mine, sp = 0u;
    for (;;) {
        sum = 0u; cnt = 0u; mine = 0u;
#pragma unroll
        for (unsigned j = 0; j < 16; ++j) { const unsigned c = xb_ld(&bar[XB_XCNT(j)]); sum += c; cnt += (c > 0u) ? 1u : 0u; mine = (j == x) ? c : mine; }
        if (sum == G) break;
        __builtin_amdgcn_s_sleep(1);
        if ((++sp & 255u) == 0u) { if (xb_ld(&bar[XB_TMO])) break; if (sp > XB_SPIN_CAP) { atomicAdd(&bar[XB_TMO], 1u); break; } }
    }
    nloc = mine > 0u ? mine : 1u; nx = cnt > 0u ? cnt : 1u;
}

__device__ __forceinline__ void xcd_barrier(const XcdBarrier& b) {
    asm volatile("s_waitcnt vmcnt(0)" ::: "memory");
    __syncthreads();
    if (threadIdx.x == 0) {
        unsigned* bar = b.bar;
        __builtin_amdgcn_s_waitcnt(0);
        unsigned nloc = b.st[0], nx = b.st[1];
        if (nloc == 0u) { xcd_barrier_complete(bar, b.x, nloc, nx); b.st[0] = nloc; b.st[1] = nx; }
        const unsigned old = xb_add(&bar[XB_XSUB(b.x)], 1u);
        const unsigned gen = old / nloc;
        if (old + 1u == (gen + 1u) * nloc) {
            __builtin_amdgcn_fence(__ATOMIC_RELEASE, "agent");
            asm volatile("s_waitcnt vmcnt(0)" ::: "memory");
            const unsigned og = xb_add(&bar[XB_TOP], 1u);
            const unsigned tg = og / nx;
            if (og + 1u == (tg + 1u) * nx) xb_add(&bar[XB_TOPGEN], 1u);
            else XB_SPIN(xb_ld(&bar[XB_TOPGEN]) == tg, bar);
            __builtin_amdgcn_fence(__ATOMIC_ACQUIRE, "agent");
            xb_add(&bar[XB_XGEN(b.x)], 1u);
            asm volatile("s_waitcnt vmcnt(0)" ::: "memory");
        } else {
            XB_SPIN(xb_ld(&bar[XB_XGEN(b.x)]) == gen, bar);
            __builtin_amdgcn_fence(__ATOMIC_ACQUIRE, "agent");
            asm volatile("s_waitcnt vmcnt(0)" ::: "memory");
        }
    }
    __syncthreads();
}

__global__ void __launch_bounds__(NT, 2) mega(P p, int lo, int hi) {
    extern __shared__ __attribute__((aligned(16))) unsigned char smem_raw[];
    float* sm = (float*)smem_raw;
    cg::grid_group grid = cg::this_grid();
    volatile LAS unsigned* xb_st = (volatile LAS unsigned*)(smem_raw + 128 * 1024);
    if (threadIdx.x < 4) xb_st[threadIdx.x] = 0u;
    __syncthreads();
    const XcdBarrier xbar = xcd_barrier_post((unsigned*)(p.ws + WS_BAR), xb_st);
#define GRID_SYNC(k) do { if ((k) == 0) grid.sync(); else xcd_barrier(xbar); } while (0)
#ifdef PROBE_MASK
    unsigned long long tacc_ = 0, t0_ = 0;
    const bool timer_ = (blockIdx.x == 0 && threadIdx.x == 0);
#define STEP(k, body) do { const int k_ = (k); if (lo <= k_ && k_ < hi) { if (timer_) t0_ = __builtin_amdgcn_s_memrealtime(); body; if (k_ + 1 < hi) GRID_SYNC(k_); \
        if (timer_ && ((PROBE_MASK >> (k_ == 0 ? 0 : 1 + (k_ - 1) % 13)) & 1)) tacc_ += __builtin_amdgcn_s_memrealtime() - t0_; } } while (0)
#else
#define STEP(k, body) do { const int k_ = (k); if (lo <= k_ && k_ < hi) { body; if (k_ + 1 < hi) GRID_SYNC(k_); } } while (0)
#endif
    STEP(0, { phase_mod(p, sm); phase_wprep(p, sm); });
#pragma unroll 1
    for (int l = 0; l < 2; ++l) {
        const int s0 = 1 + 13 * l;
        if (l == 0) STEP(s0 + 0, phase_u1prep(p, l, sm));
        STEP(s0 + 1, phase_inproj(p, l, smem_raw));
        STEP(s0 + 2, { phase_conv(p, l, sm); phase_vtrans(p, smem_raw); });
        STEP(s0 + 3, { phase_mlstm(p, l, smem_raw); __syncthreads(); phase_na(p, l, smem_raw); phase_tabprep(p, l, smem_raw); });
        STEP(s0 + 4, phase_combine(p, l));
        STEP(s0 + 5, phase_outproj(p, l, smem_raw));
        STEP(s0 + 6, phase_ln1(p, l));
        STEP(s0 + 7, phase_peerq(p, l, smem_raw));
        STEP(s0 + 8, phase_topk(p, l, smem_raw));
        STEP(s0 + 9, phase_eslice<0>(p, l, smem_raw));
        STEP(s0 + 10, phase_ecoef(p, l));
        STEP(s0 + 11, phase_eslice<1>(p, l, smem_raw));
        STEP(s0 + 12, phase_eln(p, l, sm));
    }
#undef STEP
#ifdef PROBE_MASK
    if (timer_) { const unsigned long long te = __builtin_amdgcn_s_memrealtime(); while (__builtin_amdgcn_s_memrealtime() - te < 8ull * tacc_) __builtin_amdgcn_s_sleep(32); }
#endif
}

extern "C" void kernel_launch(void* const* d_in, const int* in_sizes, int n_in, void* d_out, int out_size, void* d_ws,
                              size_t ws_size, hipStream_t stream) {
    static int grid_blocks = 0;
    if (!grid_blocks) {
        int dev = 0, cus = 0, per_cu = 0;
        hipGetDevice(&dev);
        hipDeviceGetAttribute(&cus, hipDeviceAttributeMultiprocessorCount, dev);
        hipFuncSetAttribute((const void*)mega, hipFuncAttributeMaxDynamicSharedMemorySize, LDS_BYTES);
        hipOccupancyMaxActiveBlocksPerMultiprocessor(&per_cu, (const void*)mega, NT, LDS_BYTES);
        if (per_cu < 1) per_cu = 1;
        grid_blocks = cus * per_cu;
        if (ws_size < WS_END) fprintf(stderr, "kernel_launch: workspace too small: %zu < %zu\n", ws_size, (size_t)WS_END);
    }
    P p{};
    const float** pp = (const float**)&p;
    for (int i = 0; i < 20; ++i) pp[i] = (const float*)d_in[i];
    p.out = (float*)d_out;
    p.ws = (unsigned char*)d_ws;
    hipMemsetAsync((unsigned char*)d_ws + WS_BAR, 0, (WS_CNT - WS_BAR) + 8192, stream);
#if SINGLE_LAUNCH
    int lo = 0, hi = NSTEPS;
    void* args[] = {&p, &lo, &hi};
    hipError_t e = hipLaunchCooperativeKernel((const void*)mega, dim3(grid_blocks), dim3(NT), args, LDS_BYTES, stream);
    if (e != hipSuccess) fprintf(stderr, "cooperative launch failed: %s (grid %d)\n", hipGetErrorString(e), grid_blocks);
#else
    for (int s = 0; s < NSTEPS; ++s) {
        int lo = s, hi = s + 1;
        void* args[] = {&p, &lo, &hi};
        hipError_t e = hipLaunchCooperativeKernel((const void*)mega, dim3(grid_blocks), dim3(NT), args, LDS_BYTES, stream);
        if (e != hipSuccess) fprintf(stderr, "launch %d failed: %s (grid %d)\n", s, hipGetErrorString(e), grid_blocks);
    }
#endif
}
```

```cpp
#include <hip/hip_runtime.h>
#include <hip/hip_cooperative_groups.h>
#include <cstdio>
#include <cstdint>
namespace cg = cooperative_groups;

#ifndef SINGLE_LAUNCH
#define SINGLE_LAUNCH 1
#endif

typedef unsigned short bf16_t;

constexpr int NT = 512;
constexpr int NW = NT / 64;
constexpr int D = 1024, NB = 16, T = 2048, CT = 256;
constexpr int ML = NB * T, MC = NB * CT, M = ML + MC;
constexpr int D_IN = 3088;
constexpr float ALPHA = 1.4142135623730951f;
constexpr float LN_EPS = 1e-5f;
constexpr int NSTEPS = 27;

constexpr size_t SZ_HALF = (size_t)M * 512 * 2;
constexpr size_t WS_MOD   = 0;
constexpr size_t WS_BAR   = 0xE0000;
constexpr size_t WS_XCTX  = 1u << 20;
constexpr size_t WS_R1    = WS_XCTX + (size_t)MC * 1024 * 4;
constexpr size_t WS_QKRAW = WS_R1;
constexpr size_t WS_V     = WS_R1 + 1 * SZ_HALF;
constexpr size_t WS_O     = WS_R1 + 2 * SZ_HALF;
constexpr size_t WS_NQ    = WS_R1 + 3 * SZ_HALF;
constexpr size_t WS_NK    = WS_R1 + 4 * SZ_HALF;
constexpr size_t WS_NV    = WS_R1 + 5 * SZ_HALF;
constexpr size_t WS_Y     = WS_R1;
constexpr size_t WS_Q     = WS_R1 + 2 * SZ_HALF;
constexpr size_t WS_GATES = WS_R1 + 6 * SZ_HALF;
constexpr size_t WS_R3    = WS_GATES + (size_t)M * 16 * 4;
constexpr size_t WS_QKACT = WS_R3;
constexpr size_t WS_HDIR  = WS_R3 + SZ_HALF;
constexpr size_t WS_EIDX  = WS_R3;
constexpr size_t WS_EGATE = WS_R3 + (size_t)M * 128 * 4;
constexpr size_t WS_U2Q   = WS_R3 + SZ_HALF;
constexpr size_t WS_USC   = WS_GATES;
constexpr size_t WS_MIX   = WS_R3 + 3 * SZ_HALF;
constexpr size_t WS_U2    = WS_MIX;
constexpr size_t WS_U1    = WS_MIX;
constexpr size_t WS_WIN   = WS_MIX + 2 * SZ_HALF;
constexpr size_t WS_WOUT  = WS_WIN + (size_t)2 * 3072 * 1024 * 2;
constexpr size_t WS_WQ    = WS_WOUT + (size_t)2 * 1024 * 1024 * 2;
constexpr size_t WS_NVT   = WS_WQ + (size_t)2 * 2048 * 1024 * 2;
constexpr size_t WS_TUP   = WS_NVT + (size_t)128 * 64 * 2304 * 2;
constexpr size_t WS_TDN   = WS_TUP + (size_t)16384 * 1024;
constexpr size_t WS_TSC   = WS_TDN + (size_t)16384 * 1024;
constexpr size_t WS_GSC   = WS_TSC + (size_t)2 * 16384 * 4;
constexpr size_t WS_END   = WS_GSC + (size_t)3 * 128 * 2304 * 4 + (size_t)128 * 36 * 4;

constexpr int LDS_BYTES = 128 * 1024 + 16;

struct P {
    const float *x, *c, *ctx, *c_ctx, *ada_w, *ada_b, *w_in, *b_gate, *conv_w, *ml_norm_w, *na_rpb, *w_out,
                *ln1_w, *ln1_b, *peer_wq, *peer_keys, *peer_up, *peer_down, *ln2_w, *ln2_b;
    float* out;
    unsigned char* ws;
};

typedef short bf16x8 __attribute__((ext_vector_type(8)));
typedef float f32x16 __attribute__((ext_vector_type(16)));
__device__ __forceinline__ bf16_t f2bf(float f) {
    unsigned u = __float_as_uint(f);
    u += 0x7fffu + ((u >> 16) & 1u);
    return (bf16_t)(u >> 16);
}
__device__ __forceinline__ float bf2f(bf16_t h) { return __uint_as_float(((unsigned)h) << 16); }
typedef __bf16 bf16x2v_t __attribute__((ext_vector_type(2)));
typedef float f32x2v_t __attribute__((ext_vector_type(2)));
__device__ __forceinline__ unsigned pk_bf16(float lo, float hi) { const f32x2v_t f = {lo, hi}; return __builtin_bit_cast(unsigned, __builtin_convertvector(f, bf16x2v_t)); }
__device__ __forceinline__ int opaque_tid() { int v = threadIdx.x; asm volatile("" : "+v"(v)); return v; }
__device__ __forceinline__ float wave_sum(float v) {
#pragma unroll
    for (int o = 32; o; o >>= 1) v += __shfl_xor(v, o);
    return v;
}
__device__ __forceinline__ float wave_max(float v) {
#pragma unroll
    for (int o = 32; o; o >>= 1) v = fmaxf(v, __shfl_xor(v, o));
    return v;
}
__device__ __forceinline__ float siluf(float v) { return v / (1.f + expf(-v)); }
__device__ __forceinline__ float sigmoidf(float v) { return 1.f / (1.f + expf(-v)); }
__device__ __forceinline__ float logsigmoidf(float v) { return fminf(v, 0.f) - log1pf(expf(-fabsf(v))); }
__device__ __forceinline__ float gelu_tanh(float v) {
    const float k0 = 0.7978845608028654f;
    return 0.5f * v * (1.f + tanhf(k0 * (v + 0.044715f * v * v * v)));
}
__device__ __forceinline__ int mod_row(int r) { return r < ML ? (r >> 11) : 16; }
__device__ __forceinline__ const float* xrow(const P& p, int l, int r) {
    if (r < ML) return (l == 0 ? p.x : (const float*)p.out) + (size_t)r * D;
    return (l == 0 ? p.ctx : (const float*)(p.ws + WS_XCTX)) + (size_t)(r - ML) * D;
}
__device__ __forceinline__ float* xrow_w(const P& p, int r) {
    if (r < ML) return p.out + (size_t)r * D;
    return (float*)(p.ws + WS_XCTX) + (size_t)(r - ML) * D;
}
__device__ __forceinline__ const float* modp(const P& p, int l, int r) {
    return (const float*)(p.ws + WS_MOD) + (size_t)(l * 17 + mod_row(r)) * 6144;
}

__device__ __forceinline__ float wave_sum16(const float (&v)[16], int lane) {
    const bool b0 = lane & 1, b1 = lane & 2, b2 = lane & 4, b3 = lane & 8;
    float a8[8];
#pragma unroll
    for (int i = 0; i < 8; ++i) { const float lo_ = v[2 * i], hi_ = v[2 * i + 1]; const float keep = b0 ? hi_ : lo_, send = b0 ? lo_ : hi_; a8[i] = keep + __shfl_xor(send, 1); }
    float a4[4];
#pragma unroll
    for (int i = 0; i < 4; ++i) { const float lo_ = a8[2 * i], hi_ = a8[2 * i + 1]; const float keep = b1 ? hi_ : lo_, send = b1 ? lo_ : hi_; a4[i] = keep + __shfl_xor(send, 2); }
    float a2[2];
#pragma unroll
    for (int i = 0; i < 2; ++i) { const float lo_ = a4[2 * i], hi_ = a4[2 * i + 1]; const float keep = b2 ? hi_ : lo_, send = b2 ? lo_ : hi_; a2[i] = keep + __shfl_xor(send, 4); }
    float a1; { const float lo_ = a2[0], hi_ = a2[1]; const float keep = b3 ? hi_ : lo_, send = b3 ? lo_ : hi_; a1 = keep + __shfl_xor(send, 8); }
    a1 += __shfl_xor(a1, 16); a1 += __shfl_xor(a1, 32);
    return a1;
}

__device__ __forceinline__ void phase_mod(const P& p, float* sm) {
    float* mod = (float*)(p.ws + WS_MOD);
    const int tid = opaque_tid();
    for (int i = tid; i < 17 * 1024; i += NT) { const int mr = i >> 10, k = i & 1023; sm[i] = siluf(mr < 16 ? p.c[mr * D + k] : p.c_ctx[k]); }
    __syncthreads();
    const int total = 2 * 6144 * 4;
    for (int i = blockIdx.x * NT + tid; i < total; i += gridDim.x * NT) {
        const int kq = i & 3, col = (i >> 2) % 6144, l = (i >> 2) / 6144;
        const float* w = p.ada_w + (size_t)l * D * 6144 + (size_t)(kq * 256) * 6144 + col;
        float acc[17];
#pragma unroll
        for (int mr = 0; mr < 17; ++mr) acc[mr] = 0.f;
#pragma unroll 1
        for (int k0 = 0; k0 < 256; k0 += 16) {
            float wv[16];
#pragma unroll
            for (int kk = 0; kk < 16; ++kk) wv[kk] = w[(size_t)(k0 + kk) * 6144];
#pragma unroll
            for (int kk = 0; kk < 16; ++kk)
#pragma unroll
                for (int mr = 0; mr < 17; ++mr) acc[mr] += sm[mr * 1024 + kq * 256 + k0 + kk] * wv[kk];
        }
        const float bias = p.ada_b[l * 6144 + col];
#pragma unroll
        for (int mr = 0; mr < 17; ++mr) {
            float v = acc[mr];
            v += __shfl_xor(v, 1); v += __shfl_xor(v, 2);
            if (kq == 0) mod[(size_t)(l * 17 + mr) * 6144 + col] = v + bias;
        }
    }
    __syncthreads();
}

namespace pg8 {
#define PG8_LAS __attribute__((address_space(3)))
typedef unsigned short bf16_t;
typedef short bf16x8 __attribute__((ext_vector_type(8)));
typedef float f32x4 __attribute__((ext_vector_type(4)));
typedef unsigned u32x4 __attribute__((ext_vector_type(4)));
constexpr int BM = 256, BK = 64, HALF = 128, HTB = HALF * BK * 2  , STAGE_BYTES = 8 * HTB, NXCD = 8, WGM = 8;

__host__ __device__ __forceinline__ int lds_byte(int r, int c) { const int st = (r >> 4) * 2 + (c >> 5), rr = r & 15, cc = c & 31, ob = rr * 64 + cc * 2; return st * 1024 + (ob ^ (((ob >> 9) & 1) << 5)); }
__host__ __device__ __forceinline__ void stage_rc(int b, int& R, int& C) { const int st = b / 1024, sb = b % 1024, swz = sb ^ (((sb >> 9) & 1) << 5); R = (st >> 1) * 16 + swz / 64; C = (st & 1) * 32 + (swz % 64) / 2; }
__host__ __device__ __forceinline__ int perm32(int rho) { const int n = rho >> 4, i = rho & 15; return 8 * (i >> 2) + 4 * n + (i & 3); }

struct Unit { int pm, pn; };
struct Gemm { const bf16_t* A; const bf16_t* Bt; int M, N, K; };

struct StaticOrder {
    int nM, nN, nwg, G, c;
    __host__ __device__ void init(int M, int N, int G_, int c_) { nM = M / BM; nN = N / BM; nwg = nM * nN; G = G_; c = c_; }
    __host__ __device__ bool next(int i, Unit& u) const {
        const long L = (long)i * G + c; if (L >= nwg) return false;
        int wgid = (int)L; { const int q = nwg / NXCD, r = nwg % NXCD, xcd = wgid % NXCD, off = wgid / NXCD; wgid = (xcd < r ? xcd * (q + 1) : r * (q + 1) + (xcd - r) * q) + off; }
        const int nig = WGM * nN, gid = wgid / nig, fm = gid * WGM, gsz = (nM - fm) < WGM ? (nM - fm) : WGM;
        u.pm = fm + ((wgid % nig) % gsz); u.pn = (wgid % nig) / gsz; return true;
    }
    __device__ __forceinline__ void a_ready(const Unit&) const {}
    __device__ __forceinline__ void done(const Unit&) const {}
};
__device__ __forceinline__ unsigned cvt_pk_bf16(float lo, float hi) { unsigned r; asm volatile("v_cvt_pk_bf16_f32 %0, %1, %2" : "=v"(r) : "v"(lo), "v"(hi)); return r; }
template <int ACT  > struct EpiBf16 {
    static constexpr bool PERM = true, AFTER_DRAIN = false;
    bf16_t* O; int ldc; const float* bias; int split_cols; size_t split_stride;
    __device__ __forceinline__ void operator()(const f32x4 (&acc)[2][2][4][2], const Unit& u, int wr, int wc, int fr, int fq) const {
        const int row0 = u.pm * BM + wr * 64 + fr; int colt = u.pn * BM; bf16_t* base = O;
        if (split_cols) { const int t = colt / split_cols; base += (size_t)t * split_stride; colt -= t * split_cols; }
        const int col0 = colt + wc * 32 + 8 * fq, bcol0 = u.pn * BM + wc * 32 + 8 * fq;
        f32x4 bv[2][2];
#pragma unroll
        for (int bj = 0; bj < 2; ++bj)
#pragma unroll
            for (int n = 0; n < 2; ++n) bv[bj][n] = bias ? *(const f32x4*)(bias + bcol0 + bj * HALF + 4 * n) : (f32x4){0.f, 0.f, 0.f, 0.f};
#pragma unroll
        for (int ai = 0; ai < 2; ++ai)
#pragma unroll
            for (int m = 0; m < 4; ++m) { bf16_t* rowp = base + (size_t)(row0 + ai * HALF + m * 16) * ldc + col0;
#pragma unroll
                for (int bj = 0; bj < 2; ++bj) { f32x4 v0 = acc[ai][bj][m][0] + bv[bj][0], v1 = acc[ai][bj][m][1] + bv[bj][1];
                    u32x4 w; w.x = cvt_pk_bf16(v0[0], v0[1]); w.y = cvt_pk_bf16(v0[2], v0[3]); w.z = cvt_pk_bf16(v1[0], v1[1]); w.w = cvt_pk_bf16(v1[2], v1[3]);
                    *(u32x4*)(rowp + bj * HALF) = w; } }
    }
};
template <class Epi, class Sched, bool STAMP = false>
__device__ __forceinline__ void gemm_phase(PG8_LAS unsigned char* lds, const Gemm g, const Sched& S, const Epi& E, unsigned long long* stamps) {
    const int tid = opaque_tid(), wid = __builtin_amdgcn_readfirstlane(tid >> 6), lane = tid & 63, wr = wid >> 2, wc = wid & 3, fr = lane & 15, fq = lane >> 4;
    const int K = g.K, nt = K / BK;
    int ts_lo = 0, ts_hi = 0, nts = 0; const unsigned long long rt_entry = STAMP ? (unsigned long long)wall_clock64() : 0ull;
#define PG8_STAMP() do { if (STAMP && wid == 0 && nts < 64) { const unsigned long long _c = (unsigned long long)clock64(); \
        ts_lo = (lane == nts) ? (int)(unsigned)_c : ts_lo; ts_hi = (lane == nts) ? (int)(unsigned)(_c >> 32) : ts_hi; ++nts; } } while (0)
    PG8_STAMP();
    unsigned voffA[2], voffB[2];
#pragma unroll
    for (int i = 0; i < 2; ++i) { int R, C; stage_rc(tid * 16 + i * 8192, R, C); const int Rb = Epi::PERM ? ((R & ~31) + perm32(R & 31)) : R;
        voffA[i] = (unsigned)(R * K + C) * 2u; voffB[i] = (unsigned)(Rb * K + C) * 2u; }
    const size_t kstep = (size_t)(BK * 2);
    const size_t hstep = (size_t)HALF * K * 2;
    const size_t tstep = 2 * hstep;
    const unsigned ldsw = (unsigned)wid * 1024u;
    const int aoff = lds_byte(wr * 64 + fr, fq * 8), boff = lds_byte(wc * 32 + fr, fq * 8);
#define PG8_SA(b, h) (((b) * 2 + (h)) * HTB)
#define PG8_SB(b, h) ((4 + (b) * 2 + (h)) * HTB)
#define PG8_STAGE(bufoff, gbase, voff) do { _Pragma("unroll") for (int _i = 0; _i < 2; ++_i) \
        __builtin_amdgcn_global_load_lds((const unsigned*)((const char*)(gbase) + (voff)[_i]), (PG8_LAS unsigned*)(lds + (bufoff) + ldsw + _i * 8192), 16, 0, 0); } while (0)
#define PG8_LDA(dst, b, h) do { _Pragma("unroll") for (int m = 0; m < 4; ++m) _Pragma("unroll") for (int k = 0; k < 2; ++k) dst[m][k] = *(const PG8_LAS bf16x8*)(lds + PG8_SA(b, h) + aoff + m * 2048 + k * 1024); } while (0)
#define PG8_LDB(dst, b, h) do { _Pragma("unroll") for (int n = 0; n < 2; ++n) _Pragma("unroll") for (int k = 0; k < 2; ++k) dst[n][k] = *(const PG8_LAS bf16x8*)(lds + PG8_SB(b, h) + boff + n * 2048 + k * 1024); } while (0)
#define PG8_MMA(ai, bj, At, Bt) do { __builtin_amdgcn_s_setprio(1); _Pragma("unroll") for (int m = 0; m < 4; ++m) _Pragma("unroll") for (int n = 0; n < 2; ++n) _Pragma("unroll") for (int k = 0; k < 2; ++k) \
        acc[ai][bj][m][n] = __builtin_amdgcn_mfma_f32_16x16x32_bf16(Bt[n][k], At[m][k], acc[ai][bj][m][n], 0, 0, 0); __builtin_amdgcn_s_setprio(0); } while (0)
#define PG8_WAIT_V(n) asm volatile("s_waitcnt vmcnt(" #n ")" ::: "memory")
#define PG8_WAIT_L(n) asm volatile("s_waitcnt lgkmcnt(" #n ")" ::: "memory")
#define PG8_BAR __builtin_amdgcn_s_barrier()
#define PG8_SCHED __builtin_amdgcn_sched_barrier(0)
    Unit cur, nxt; int ui = 0;
    if (!S.next(0, cur)) return;
    f32x4 acc[2][2][4][2];
#pragma unroll
    for (int a = 0; a < 2; ++a)
#pragma unroll
        for (int b = 0; b < 2; ++b)
#pragma unroll
            for (int m = 0; m < 4; ++m)
#pragma unroll
                for (int n = 0; n < 2; ++n) acc[a][b][m][n] = (f32x4){0.f, 0.f, 0.f, 0.f};
    bf16x8 At[4][2], B0[2][2], B1[2][2];
    const char* cA = (const char*)g.A + (size_t)cur.pm * tstep; const char* cB = (const char*)g.Bt + (size_t)cur.pn * tstep;
    S.a_ready(cur);
    PG8_STAGE(PG8_SB(0, 0), cB, voffB); PG8_STAGE(PG8_SA(0, 0), cA, voffA); PG8_STAGE(PG8_SB(0, 1), cB + hstep, voffB); PG8_STAGE(PG8_SA(0, 1), cA + hstep, voffA);
    if (wr == 1) PG8_BAR;
    PG8_WAIT_V(4); PG8_BAR;
    PG8_STAGE(PG8_SB(1, 0), cB + kstep, voffB); PG8_STAGE(PG8_SA(1, 0), cA + kstep, voffA); PG8_STAGE(PG8_SB(1, 1), cB + hstep + kstep, voffB);
    PG8_WAIT_V(6); PG8_BAR;
    PG8_STAMP();
    for (;;) {
        const bool has_next = S.next(ui + 1, nxt);
        const char* nA = has_next ? (const char*)g.A + (size_t)nxt.pm * tstep : cA; const char* nB = has_next ? (const char*)g.Bt + (size_t)nxt.pn * tstep : cB;
        for (int t = 0; t < nt; t += 2) {
            const bool last = (t == nt - 2);
            const char* a1 = cA + (size_t)(t + 1) * kstep;
            const char* a2 = last ? nA : cA + (size_t)(t + 2) * kstep; const char* b2 = last ? nB : cB + (size_t)(t + 2) * kstep;
            const char* a3 = a2 + kstep; const char* b3 = b2 + kstep;
            if (last && has_next) S.a_ready(nxt);
            PG8_LDB(B0, 0, 0); PG8_SCHED; PG8_LDA(At, 0, 0); PG8_STAGE(PG8_SA(1, 1), a1 + hstep, voffA);
            PG8_WAIT_L(8); PG8_BAR; PG8_WAIT_L(0); PG8_MMA(0, 0, At, B0); PG8_BAR; PG8_SCHED;
            PG8_LDB(B1, 0, 1); PG8_STAGE(PG8_SB(0, 0), b2, voffB);
            PG8_BAR; PG8_WAIT_L(0); PG8_MMA(0, 1, At, B1); PG8_BAR;
            PG8_LDA(At, 0, 1); PG8_STAGE(PG8_SA(0, 0), a2, voffA);
            PG8_BAR; PG8_WAIT_L(0); PG8_MMA(1, 0, At, B0); PG8_BAR; PG8_SCHED;
            PG8_STAGE(PG8_SB(0, 1), b2 + hstep, voffB);
            PG8_WAIT_V(6); PG8_BAR; PG8_MMA(1, 1, At, B1); PG8_BAR;
            PG8_LDB(B0, 1, 0); PG8_SCHED; PG8_LDA(At, 1, 0); PG8_STAGE(PG8_SA(0, 1), a2 + hstep, voffA);
            PG8_WAIT_L(8); PG8_BAR; PG8_WAIT_L(0); PG8_MMA(0, 0, At, B0); PG8_BAR; PG8_SCHED;
            PG8_LDB(B1, 1, 1); PG8_STAGE(PG8_SB(1, 0), b3, voffB);
            PG8_BAR; PG8_WAIT_L(0); PG8_MMA(0, 1, At, B1); PG8_BAR;
            PG8_LDA(At, 1, 1); PG8_STAGE(PG8_SA(1, 0), a3, voffA);
            PG8_BAR; PG8_WAIT_L(0); PG8_MMA(1, 0, At, B0); PG8_BAR; PG8_SCHED;
            PG8_STAGE(PG8_SB(1, 1), b3 + hstep, voffB);
            PG8_WAIT_V(6); PG8_BAR; PG8_MMA(1, 1, At, B1); PG8_BAR;
        }
        PG8_STAMP();
        if constexpr (!Epi::AFTER_DRAIN) { E(acc, cur, wr, wc, fr, fq); S.done(cur); }
        PG8_STAMP();
        if (!has_next) break;
#pragma unroll
        for (int a = 0; a < 2; ++a)
#pragma unroll
            for (int b = 0; b < 2; ++b)
#pragma unroll
                for (int m = 0; m < 4; ++m)
#pragma unroll
                    for (int n = 0; n < 2; ++n) acc[a][b][m][n] = (f32x4){0.f, 0.f, 0.f, 0.f};
        cur = nxt; cA = nA; cB = nB; ++ui;
    }
    PG8_WAIT_V(0);
    if (wr == 0) PG8_BAR;
    PG8_BAR;
    if constexpr (Epi::AFTER_DRAIN) { E.fused(acc, cur, wr, wc, fr, fq, lds, wid, lane); S.done(cur); }
    PG8_STAMP();
    if (STAMP && wid == 0) { stamps[lane] = lane < nts ? (((unsigned long long)(unsigned)ts_hi << 32) | (unsigned)ts_lo) : 0ull;
        if (lane == 62) stamps[62] = rt_entry; if (lane == 63) stamps[63] = (unsigned long long)wall_clock64(); }
#undef PG8_STAMP
#undef PG8_SA
#undef PG8_SB
#undef PG8_STAGE
#undef PG8_LDA
#undef PG8_LDB
#undef PG8_MMA
#undef PG8_WAIT_V
#undef PG8_WAIT_L
#undef PG8_BAR
#undef PG8_SCHED
}
}


__device__ __forceinline__ void phase_wprep(const P& p, float* sm) {
    const int tid = opaque_tid();
    float (*tl)[65] = (float (*)[65])sm;
    for (int tile = blockIdx.x; tile < 2 * 1536; tile += gridDim.x) {
        const int l = tile / 1536; int t = tile % 1536;
        const float* src; bf16_t* dst; int Nsrc, which;
        if (t < 768) { which = 0; src = p.w_in + (size_t)l * D * D_IN; Nsrc = D_IN; dst = (bf16_t*)(p.ws + WS_WIN) + (size_t)l * 3072 * 1024; }
        else if (t < 1024) { which = 1; t -= 768; src = p.w_out + (size_t)l * D * D; Nsrc = D; dst = (bf16_t*)(p.ws + WS_WOUT) + (size_t)l * 1024 * 1024; }
        else { which = 2; t -= 1024; src = p.peer_wq + (size_t)l * D * 2048; Nsrc = 2048; dst = (bf16_t*)(p.ws + WS_WQ) + (size_t)l * 2048 * 1024; }
        const int tn = t / 16, tk = t % 16;
        for (int i = tid; i < 4096; i += NT) {
            const int kk = i >> 6, nn = i & 63; const int n = tn * 64 + nn;
            const int nsrc = (which == 0 && n >= 1536) ? n + 16 : n;
            float v = src[(size_t)(tk * 64 + kk) * Nsrc + nsrc];
            if (which == 0 && n >= 1536 && n < 2048) v *= 0.125f;
            tl[kk][nn] = v;
        }
        __syncthreads();
        for (int i = tid; i < 4096; i += NT) {
            const int nn = i >> 6, kk = i & 63;
            dst[(size_t)(tn * 64 + nn) * 1024 + tk * 64 + kk] = f2bf(tl[kk][nn]);
        }
        __syncthreads();
    }
}

__device__ __forceinline__ void phase_u1prep(const P& p, int l, float* sm) {
    bf16_t* u1 = (bf16_t*)(p.ws + WS_U1);
    float* gates = (float*)(p.ws + WS_GATES);
    const int tid_ = opaque_tid(); const int lane = tid_ & 63, wave = tid_ >> 6;
    __syncthreads();
    for (int i = tid_; i < 16 * 1024; i += NT) { const int k = i >> 4, g = i & 15; sm[g * 1024 + k] = p.w_in[(size_t)l * D * D_IN + (size_t)k * D_IN + 1536 + g]; }
    __syncthreads();
    for (int r = blockIdx.x * NW + wave; r < M; r += gridDim.x * NW) {
        const float* xr = xrow(p, l, r); const float* mp = modp(p, l, r);
        float ga[16];
#pragma unroll
        for (int g = 0; g < 16; ++g) ga[g] = 0.f;
#pragma unroll 1
        for (int i = 0; i < 4; ++i) {
            const int k0 = i * 256 + lane * 4;
            const float4 xv = *(const float4*)(xr + k0), sc = *(const float4*)(mp + 1024 + k0), sh = *(const float4*)(mp + k0);
            const float u[4] = {xv.x * (1.f + sc.x) + sh.x, xv.y * (1.f + sc.y) + sh.y, xv.z * (1.f + sc.z) + sh.z, xv.w * (1.f + sc.w) + sh.w};
            uint2 pk; pk.x = pk_bf16(u[0], u[1]); pk.y = pk_bf16(u[2], u[3]);
            *(uint2*)(u1 + (size_t)r * 1024 + k0) = pk;
#pragma unroll
            for (int g = 0; g < 16; ++g) {
                const float4 w = *(const float4*)(sm + g * 1024 + k0);
                ga[g] += u[0] * w.x + u[1] * w.y + u[2] * w.z + u[3] * w.w;
            }
        }
        const float mine = wave_sum16(ga, lane);
        if (lane < 16) gates[(size_t)r * 16 + lane] = mine + p.b_gate[l * 16 + lane];
    }
    __syncthreads();
}

__device__ __forceinline__ void phase_inproj(const P& p, int l, unsigned char* smraw) {
    pg8::Gemm g{(const pg8::bf16_t*)(p.ws + WS_U1), (const pg8::bf16_t*)(p.ws + WS_WIN) + (size_t)l * 3072 * 1024, M, 3072, 1024};
    pg8::StaticOrder S; S.init(M, 3072, (int)gridDim.x, (int)blockIdx.x);
    pg8::EpiBf16<0> E{(pg8::bf16_t*)(p.ws + WS_QKRAW), 512, nullptr, 512, (size_t)M * 512};
    pg8::gemm_phase<pg8::EpiBf16<0>, pg8::StaticOrder, false>((PG8_LAS unsigned char*)smraw, g, S, E, nullptr);
}

__device__ __forceinline__ void phase_conv(const P& p, int l, float* sm) {
    const bf16_t* qkraw = (const bf16_t*)(p.ws + WS_QKRAW);
    bf16_t* qkact = (bf16_t*)(p.ws + WS_QKACT);
    const int tid = opaque_tid();
    float* cw_s = sm;
    float* cs_s = sm + 2560;
    float* sn_s = sm + 2560 + 1024;
    __syncthreads();
    for (int i = tid; i < 2560; i += NT) cw_s[i] = p.conv_w[l * 2560 + i];
    for (int i = tid; i < 1024; i += NT) { const int pos = i >> 4, f = i & 15; const float ang = (float)pos * powf(10000.f, -(float)f / 16.f); cs_s[i] = cosf(ang); sn_s[i] = sinf(ang); }
    __syncthreads();
    const int total = M * 32;
    for (int it = blockIdx.x * NT + tid; it < total; it += gridDim.x * NT) {
        const int r = it >> 5, hq = (it >> 2) & 7, jg = it & 3;
        const int c1 = hq * 64 + jg * 8;
        int base, t, Ts;
        if (r < ML) { base = r & ~2047; t = r & 2047; Ts = T; } else { const int rc = r - ML; base = ML + (rc & ~255); t = rc & 255; Ts = CT; }
        float y1[8], y2[8];
#pragma unroll
        for (int i = 0; i < 8; ++i) { y1[i] = 0.f; y2[i] = 0.f; }
#pragma unroll
        for (int jj = 0; jj < 5; ++jj) {
            const int tt = t + jj - 2;
            if (tt >= 0 && tt < Ts) {
                const bf16_t* rp = qkraw + (size_t)(base + tt) * 512 + c1;
                const uint4 a = *(const uint4*)rp, b = *(const uint4*)(rp + 32);
                const unsigned aw[4] = {a.x, a.y, a.z, a.w}, bw[4] = {b.x, b.y, b.z, b.w};
                const float* w1 = cw_s + jj * 512 + c1; const float* w2 = w1 + 32;
#pragma unroll
                for (int i = 0; i < 4; ++i) {
                    y1[2 * i] += __uint_as_float(aw[i] << 16) * w1[2 * i]; y1[2 * i + 1] += __uint_as_float(aw[i] & 0xffff0000u) * w1[2 * i + 1];
                    y2[2 * i] += __uint_as_float(bw[i] << 16) * w2[2 * i]; y2[2 * i + 1] += __uint_as_float(bw[i] & 0xffff0000u) * w2[2 * i + 1];
                }
            }
        }
        const float ks = hq >= 4 ? 0.125f : 1.f;
        const bool lat = r < ML;
        const int pos = (jg < 2) ? (t >> 6) : (t & 63);
        float o1[8], o2[8];
#pragma unroll
        for (int i = 0; i < 8; ++i) {
            const float a = siluf(y1[i]) * ks, b = siluf(y2[i]) * ks;
            if (lat) { const float cs = cs_s[pos * 16 + ((jg & 1) * 8 + i)], sn = sn_s[pos * 16 + ((jg & 1) * 8 + i)]; o1[i] = a * cs - b * sn; o2[i] = a * sn + b * cs; }
            else { o1[i] = a; o2[i] = b; }
        }
        bf16_t* op = qkact + (size_t)r * 512 + c1;
        *(uint4*)op = make_uint4(pk_bf16(o1[0], o1[1]), pk_bf16(o1[2], o1[3]), pk_bf16(o1[4], o1[5]), pk_bf16(o1[6], o1[7]));
        *(uint4*)(op + 32) = make_uint4(pk_bf16(o2[0], o2[1]), pk_bf16(o2[2], o2[3]), pk_bf16(o2[4], o2[5]), pk_bf16(o2[6], o2[7]));
    }
    __syncthreads();
}

typedef short bf16x4s __attribute__((ext_vector_type(4)));
constexpr int ML_RS = 144;
constexpr int ML_K = 0, ML_WKT = 9216, ML_Q = 18432, ML_VT = 27648, ML_OUT = 46080, ML_ARR = 63488;
__device__ __forceinline__ bf16x8 cvt8(const f32x16& x, int o) {
    union { unsigned u[4]; bf16x8 v; } r;
    r.u[0] = pk_bf16(x[o], x[o + 1]); r.u[1] = pk_bf16(x[o + 2], x[o + 3]); r.u[2] = pk_bf16(x[o + 4], x[o + 5]); r.u[3] = pk_bf16(x[o + 6], x[o + 7]);
    return r.v;
}
__device__ __forceinline__ bf16x8 ld2x4(const unsigned char* p) {
    union { bf16x4s h[2]; bf16x8 v; } r; r.h[0] = *(const bf16x4s*)p; r.h[1] = *(const bf16x4s*)(p + 16); return r.v;
}
__device__ __forceinline__ void lds_barrier() { asm volatile("s_waitcnt lgkmcnt(0)" ::: "memory"); __builtin_amdgcn_s_barrier(); asm volatile("" ::: "memory"); }
__device__ __forceinline__ void phase_gatescan(const P& p, int l, float* sm) {
    const float* gates = (const float*)(p.ws + WS_GATES);
    float* Gs = (float*)(p.ws + WS_GSC); float* PMs = Gs + 128 * 2304; float* Bs = PMs + 128 * 2304; float* MINs = Bs + 128 * 2304;
    const int tid = opaque_tid(); const int lane = tid & 63, wave = tid >> 6;
    float* b63 = sm; float* pm63 = sm + 64;
    for (int item = blockIdx.x; item < NB * 4 * 2; item += gridDim.x) {
        const int dir = item & 1, h = (item >> 1) & 3, b = item >> 3;
        __syncthreads();
        for (int ci = wave; ci < 36; ci += NW) {
            const bool isctx = ci < 4; const int base = isctx ? ML + b * CT : b * T; const int Ts = isctx ? CT : T; const int cl = isctx ? ci : ci - 4;
            const int pos = cl * 64 + lane; const int t = dir ? Ts - 1 - pos : pos;
            const float* gp = gates + (size_t)(base + t) * 16;
            const float li = gp[(2 * dir) * 4 + h], lfx = gp[(2 * dir + 1) * 4 + h];
            float bsum = fminf(lfx, 0.f) - __logf(1.f + __expf(-fabsf(lfx)));
#pragma unroll
            for (int d = 1; d < 64; d <<= 1) { const float tt = __shfl_up(bsum, d); if (lane >= d) bsum += tt; }
            const float g = li - bsum;
            float pm = g;
#pragma unroll
            for (int d = 1; d < 64; d <<= 1) { const float tt = __shfl_up(pm, d); if (lane >= d) pm = fmaxf(pm, tt); }
            const size_t idx = (size_t)item * 2304 + ci * 64 + lane;
            Gs[idx] = g; PMs[idx] = pm; Bs[idx] = bsum;
            if (lane == 63) { b63[ci] = bsum; pm63[ci] = pm; }
        }
        __syncthreads();
        if (tid == 0) {
            float m = 0.f;
            for (int ci = 0; ci < 36; ++ci) { MINs[item * 36 + ci] = m; m = b63[ci] + fmaxf(m, pm63[ci]); }
        }
    }
    __syncthreads();
}

__device__ __forceinline__ void phase_mlstm(const P& p, int l, unsigned char* sm) {
    const bool need_ctx = (l == 0);
    const bf16_t* qkact = (const bf16_t*)(p.ws + WS_QKACT);
    const bf16_t* vb = (const bf16_t*)(p.ws + WS_V);
    const float* Gs = (const float*)(p.ws + WS_GSC); const float* PMs = Gs + 128 * 2304; const float* Bs = PMs + 128 * 2304; const float* MINs = Bs + 128 * 2304;
    bf16_t* hdir = (bf16_t*)(p.ws + WS_HDIR);
    const int tid = opaque_tid(); const int lane = tid & 63, wave = tid >> 6, r = lane & 31, hh = lane >> 5;
    const int c = wave & 1, vt = wave >> 1, j = c * 32 + r;
    float* a_g = (float*)(sm + ML_ARR); float* a_M = a_g + 64; float* a_inter = a_M + 64; float* a_edn = a_inter + 64; float* a_n = a_edn + 64;
    const int srow = tid >> 3, part = tid & 7;
    for (int item = blockIdx.x; item < NB * 4 * 2; item += gridDim.x) {
        const int dir = item & 1, h = (item >> 1) & 3, b = item >> 3;
        f32x16 X0, X1;
#pragma unroll
        for (int i = 0; i < 16; ++i) { X0[i] = 0.f; X1[i] = 0.f; }
        __syncthreads();
        if (tid < 128) a_n[tid] = 0.f;
        uint4 pq, pk, pv0, pv1; float pg = 0.f, pgj = 0.f, ppm = 0.f, pb = 0.f, pmin = 0.f, ppm63 = 0.f;
        auto issue = [&](int ci) {
            const bool isctx = ci < 4; const int base = isctx ? ML + b * CT : b * T; const int Ts = isctx ? CT : T; const int cl = isctx ? ci : ci - 4;
            const int pos = cl * 64 + srow; const int t = dir ? Ts - 1 - pos : pos; const size_t ro = (size_t)(base + t) * 512;
            pq = *(const uint4*)(qkact + ro + h * 64 + part * 8); pk = *(const uint4*)(qkact + ro + 256 + h * 64 + part * 8);
            pv0 = *(const uint4*)(vb + ro + h * 128 + part * 16); pv1 = *(const uint4*)(vb + ro + h * 128 + part * 16 + 8);
            const size_t gi = (size_t)item * 2304 + ci * 64;
            pg = Gs[gi + srow]; pmin = MINs[item * 36 + ci]; ppm63 = PMs[gi + 63];
            if (tid < 64) { pgj = Gs[gi + tid]; ppm = PMs[gi + tid]; pb = Bs[gi + tid]; }
        };
        issue(0);
#pragma unroll 1
        for (int ci = 0; ci < 36; ++ci) {
            const bool isctx = ci < 4; const int base = isctx ? ML + b * CT : b * T; const int Ts = isctx ? CT : T; const int cl = isctx ? ci : ci - 4;
            const bool do_out = (!isctx) || need_ctx;
            const int nb = (ci & 1) * 64;
            const float m_in = pmin, M63 = fmaxf(pmin, ppm63);
            const float so = __expf(m_in - M63);
            const float wrow = __expf(pg - M63);
            *(uint4*)(sm + ML_Q + srow * ML_RS + part * 16) = pq;
            *(uint4*)(sm + ML_K + srow * ML_RS + part * 16) = pk;
            {
                const unsigned kw[4] = {pk.x, pk.y, pk.z, pk.w};
                const unsigned w[8] = {pv0.x, pv0.y, pv0.z, pv0.w, pv1.x, pv1.y, pv1.z, pv1.w};
#pragma unroll
                for (int i = 0; i < 4; ++i) {
                    *(bf16_t*)(sm + ML_WKT + (part * 8 + 2 * i) * ML_RS + srow * 2) = f2bf(wrow * __uint_as_float(kw[i] << 16));
                    *(bf16_t*)(sm + ML_WKT + (part * 8 + 2 * i + 1) * ML_RS + srow * 2) = f2bf(wrow * __uint_as_float(kw[i] & 0xffff0000u));
                }
#pragma unroll
                for (int i = 0; i < 8; ++i) {
                    *(bf16_t*)(sm + ML_VT + (part * 16 + 2 * i) * ML_RS + srow * 2) = (bf16_t)(w[i] & 0xffffu);
                    *(bf16_t*)(sm + ML_VT + (part * 16 + 2 * i + 1) * ML_RS + srow * 2) = (bf16_t)(w[i] >> 16);
                }
            }
            if (tid < 64) { const float Mv = fmaxf(m_in, ppm); a_g[tid] = pgj; a_M[tid] = Mv; a_inter[tid] = __expf(m_in - Mv); a_edn[tid] = __expf(-(pb + Mv)); }
            if (ci + 1 < 36) issue(ci + 1);
            lds_barrier();
            {
                const float Mjv = a_M[j], interj = a_inter[j];
                float nq;
                {
                    float acc = 0.f;
                    const unsigned char* qr = sm + ML_Q + j * ML_RS + hh * 64;
#pragma unroll
                    for (int k8 = 0; k8 < 4; ++k8) {
                        const uint4 w = *(const uint4*)(qr + k8 * 16);
                        const float4 n0 = *(const float4*)(a_n + nb + hh * 32 + k8 * 8), n1 = *(const float4*)(a_n + nb + hh * 32 + k8 * 8 + 4);
                        acc += n0.x * __uint_as_float(w.x << 16) + n0.y * __uint_as_float(w.x & 0xffff0000u) + n0.z * __uint_as_float(w.y << 16) + n0.w * __uint_as_float(w.y & 0xffff0000u);
                        acc += n1.x * __uint_as_float(w.z << 16) + n1.y * __uint_as_float(w.z & 0xffff0000u) + n1.z * __uint_as_float(w.w << 16) + n1.w * __uint_as_float(w.w & 0xffff0000u);
                    }
                    nq = acc + __shfl_xor(acc, 32);
                }
                {
                    const int k = wave * 8 + (lane >> 3), pc = lane & 7;
                    const uint4 w = *(const uint4*)(sm + ML_WKT + k * ML_RS + pc * 16);
                    float sacc = (__uint_as_float(w.x << 16) + __uint_as_float(w.x & 0xffff0000u)) + (__uint_as_float(w.y << 16) + __uint_as_float(w.y & 0xffff0000u))
                               + (__uint_as_float(w.z << 16) + __uint_as_float(w.z & 0xffff0000u)) + (__uint_as_float(w.w << 16) + __uint_as_float(w.w & 0xffff0000u));
                    sacc += __shfl_xor(sacc, 1); sacc += __shfl_xor(sacc, 2); sacc += __shfl_xor(sacc, 4);
                    if (pc == 0) a_n[(nb ^ 64) + k] = so * a_n[nb + k] + sacc;
                }
                f32x16 st0, st1, n2;
#pragma unroll
                for (int i = 0; i < 16; ++i) { st0[i] = 0.f; st1[i] = 0.f; n2[i] = 0.f; }
                float gs[2][16];
                if (do_out) {
#pragma unroll
                    for (int a = 0; a < 2; ++a)
#pragma unroll
                        for (int i = 0; i < 16; ++i) gs[a][i] = a_g[a * 32 + (i & 3) + 8 * (i >> 2) + 4 * hh];
#pragma unroll
                    for (int ks = 0; ks < 4; ++ks) {
                        const bf16x8 B = *(const bf16x8*)(sm + ML_Q + j * ML_RS + ks * 32 + hh * 16);
                        const bf16x8 A0 = *(const bf16x8*)(sm + ML_K + r * ML_RS + ks * 32 + hh * 16);
                        st0 = __builtin_amdgcn_mfma_f32_32x32x16_bf16(A0, B, st0, 0, 0, 0);
                        if (c == 1) {
                            const bf16x8 A1 = *(const bf16x8*)(sm + ML_K + (32 + r) * ML_RS + ks * 32 + hh * 16);
                            st1 = __builtin_amdgcn_mfma_f32_32x32x16_bf16(A1, B, st1, 0, 0, 0);
                        }
                    }
#pragma unroll
                    for (int s2 = 0; s2 < 2; ++s2) {
                        const bf16x8 B0 = ld2x4(sm + ML_Q + j * ML_RS + (16 * s2 + 4 * hh) * 2);
                        n2 = __builtin_amdgcn_mfma_f32_32x32x16_bf16(cvt8(X0, 8 * s2), B0, n2, 0, 0, 0);
                        const bf16x8 B1 = ld2x4(sm + ML_Q + j * ML_RS + (32 + 16 * s2 + 4 * hh) * 2);
                        n2 = __builtin_amdgcn_mfma_f32_32x32x16_bf16(cvt8(X1, 8 * s2), B1, n2, 0, 0, 0);
                    }
                }
#pragma unroll
                for (int i = 0; i < 16; ++i) { X0[i] *= so; X1[i] *= so; }
#pragma unroll
                for (int ks = 0; ks < 4; ++ks) {
                    const bf16x8 Bv = *(const bf16x8*)(sm + ML_VT + (vt * 32 + r) * ML_RS + ks * 32 + hh * 16);
                    const bf16x8 A0 = *(const bf16x8*)(sm + ML_WKT + r * ML_RS + ks * 32 + hh * 16);
                    X0 = __builtin_amdgcn_mfma_f32_32x32x16_bf16(A0, Bv, X0, 0, 0, 0);
                    const bf16x8 A1 = *(const bf16x8*)(sm + ML_WKT + (32 + r) * ML_RS + ks * 32 + hh * 16);
                    X1 = __builtin_amdgcn_mfma_f32_32x32x16_bf16(A1, Bv, X1, 0, 0, 0);
                }
                if (do_out) {
                    float dsum = 0.f;
                    bf16x8 pf[2][2];
#pragma unroll
                    for (int i = 0; i < 16; ++i) {
                        const int s = (i & 3) + 8 * (i >> 2) + 4 * hh;
                        const float v = (s <= j) ? st0[i] * __expf(fminf(gs[0][i] - Mjv, 0.f)) : 0.f;
                        st0[i] = v; dsum += v;
                    }
                    pf[0][0] = cvt8(st0, 0); pf[0][1] = cvt8(st0, 8);
                    if (c == 1) {
#pragma unroll
                        for (int i = 0; i < 16; ++i) {
                            const int s = 32 + (i & 3) + 8 * (i >> 2) + 4 * hh;
                            const float v = (s <= j) ? st1[i] * __expf(fminf(gs[1][i] - Mjv, 0.f)) : 0.f;
                            st1[i] = v; dsum += v;
                        }
                        pf[1][0] = cvt8(st1, 0); pf[1][1] = cvt8(st1, 8);
                    }
                    f32x16 n1;
#pragma unroll
                    for (int i = 0; i < 16; ++i) n1[i] = 0.f;
#pragma unroll
                    for (int s2 = 0; s2 < 2; ++s2) {
                        const bf16x8 A = ld2x4(sm + ML_VT + (vt * 32 + r) * ML_RS + (16 * s2 + 4 * hh) * 2);
                        n1 = __builtin_amdgcn_mfma_f32_32x32x16_bf16(A, pf[0][s2], n1, 0, 0, 0);
                    }
                    if (c == 1) {
#pragma unroll
                        for (int s2 = 0; s2 < 2; ++s2) {
                            const bf16x8 A = ld2x4(sm + ML_VT + (vt * 32 + r) * ML_RS + (32 + 16 * s2 + 4 * hh) * 2);
                            n1 = __builtin_amdgcn_mfma_f32_32x32x16_bf16(A, pf[1][s2], n1, 0, 0, 0);
                        }
                    }
                    dsum += __shfl_xor(dsum, 32);
                    const float den = dsum + interj * nq;
                    const float rd = 1.f / fmaxf(fabsf(den), a_edn[j]);
#pragma unroll
                    for (int g4 = 0; g4 < 4; ++g4) {
                        uint2 w;
                        w.x = pk_bf16((n1[4 * g4] + interj * n2[4 * g4]) * rd, (n1[4 * g4 + 1] + interj * n2[4 * g4 + 1]) * rd);
                        w.y = pk_bf16((n1[4 * g4 + 2] + interj * n2[4 * g4 + 2]) * rd, (n1[4 * g4 + 3] + interj * n2[4 * g4 + 3]) * rd);
                        *(uint2*)(sm + ML_OUT + j * 272 + (vt * 32 + 8 * g4 + 4 * hh) * 2) = w;
                    }
                }
            }
            lds_barrier();
            if (do_out) {
                const int pos = cl * 64 + srow; const int t = dir ? Ts - 1 - pos : pos;
                bf16_t* dst = hdir + ((size_t)dir * M + base + t) * 512 + h * 128 + part * 16;
                *(uint4*)dst = *(const uint4*)(sm + ML_OUT + srow * 272 + part * 32);
                *(uint4*)(dst + 8) = *(const uint4*)(sm + ML_OUT + srow * 272 + part * 32 + 16);
            }
        }
    }
}

__device__ __forceinline__ void phase_vtrans(const P& p, unsigned char* sm) {
    const bf16_t* nv = (const bf16_t*)(p.ws + WS_NV);
    bf16_t* nvT = (bf16_t*)(p.ws + WS_NVT);
    const int tid = opaque_tid();
    for (int it = blockIdx.x; it < 128 * 36; it += gridDim.x) {
        const int bh = it / 36, tt = it % 36, b = bh >> 3, h = bh & 7;
        const int row0 = tt < 32 ? b * T + tt * 64 : ML + b * CT + (tt - 32) * 64;
        __syncthreads();
        {
            const int tk = tid >> 3, pc = tid & 7;
            const uint4 v = *(const uint4*)(nv + (size_t)(row0 + tk) * 512 + h * 64 + pc * 8);
            const unsigned w[4] = {v.x, v.y, v.z, v.w};
#pragma unroll
            for (int i = 0; i < 4; ++i) {
                *(bf16_t*)(sm + (pc * 8 + 2 * i) * 144 + tk * 2) = (bf16_t)(w[i] & 0xffffu);
                *(bf16_t*)(sm + (pc * 8 + 2 * i + 1) * 144 + tk * 2) = (bf16_t)(w[i] >> 16);
            }
        }
        __syncthreads();
        {
            const int d = tid >> 3, pc = tid & 7;
            *(uint4*)(nvT + ((size_t)bh * 64 + d) * 2304 + tt * 64 + pc * 8) = *(const uint4*)(sm + d * 144 + pc * 16);
        }
    }
    __syncthreads();
}

typedef float f32x4v __attribute__((ext_vector_type(4)));
constexpr int NA_KC = 0, NA_VC = 36864, NA_RPB = 36864 + 33792, NA_CTL = NA_RPB + 14880;
constexpr size_t WS_CNT = 0xE4000;
__device__ __forceinline__ void phase_na(const P& p, int l, unsigned char* sm) {
    const bool need_ctx = (l == 0);
    const bf16_t* nq = (const bf16_t*)(p.ws + WS_NQ); const bf16_t* nk = (const bf16_t*)(p.ws + WS_NK);
    const bf16_t* nvT = (const bf16_t*)(p.ws + WS_NVT);
    bf16_t* mix = (bf16_t*)(p.ws + WS_MIX);
    unsigned* counter = (unsigned*)(p.ws + WS_CNT) + 16 * l;
    const int tid = opaque_tid(); const int lane = tid & 63, wave = tid >> 6;
    float* rpb_s = (float*)(sm + NA_RPB);
    volatile int* ctl = (volatile int*)(sm + NA_CTL);
    __syncthreads();
    for (int i = tid; i < 8 * 465; i += NT) rpb_s[i] = p.na_rpb[(size_t)l * 8 * 465 + i];
    for (;;) {
        __syncthreads();
        if (tid == 0) ctl[0] = (int)atomicAdd(counter, 1u);
        __syncthreads();
        const int item = ctl[0];
        const int nitems = need_ctx ? 640 : 512;
        if (item >= nitems) break;
        const bool cq_item = item >= 512;
        const int bh = cq_item ? (item - 512) : (item >> 2), quarter = item & 3, b = bh >> 3, h = bh & 7;
#pragma unroll
        for (int i = 0; i < 4; ++i) {
            const int id = tid + NT * i;
            { const int key = id >> 3, pc = id & 7;
              *(uint4*)(sm + NA_KC + key * 144 + pc * 16) = *(const uint4*)(nk + (size_t)(ML + b * CT + key) * 512 + h * 64 + pc * 8); }
            { const int d = id >> 5, pc = id & 31;
              *(uint4*)(sm + NA_VC + d * 528 + pc * 16) = *(const uint4*)(nvT + ((size_t)bh * 64 + d) * 2304 + 2048 + pc * 8); }
        }
        __syncthreads();
        const int nun = cq_item ? 16 : 32;
        for (int un = wave; un < nun; un += NW) {
            int lane_o = lane; asm volatile("" : "+v"(lane_o));
            const int fr = lane_o & 15, fq = lane_o >> 4, krow_off = 8 * (fr >> 2) + (fr & 3);
            const bool lat = !cq_item;
            int qtok0, r = 0, cb = 0;
            if (lat) { r = quarter * 8 + (un >> 2); cb = un & 3; qtok0 = b * T + r * 64 + cb * 16; }
            else qtok0 = ML + b * CT + un * 16;
            const int r0 = min(max(r - 4, 0), 24);
            const int c0 = min(max(cb * 16 - 8, 0), 32);
            const int qc = cb * 16 + fr;
            const int wl = min(max(qc - 8, 0), 48);
            const bf16_t* qp = nq + (size_t)(qtok0 + fr) * 512 + h * 64 + 8 * fq;
            const bf16x8 qf0 = *(const bf16x8*)qp, qf1 = *(const bf16x8*)(qp + 32);
            float mrun = -1e30f, sum = 0.f;
            f32x4v o[4];
#pragma unroll
            for (int m = 0; m < 4; ++m) o[m] = (f32x4v){0.f, 0.f, 0.f, 0.f};
#define NA_GROUP(S0, S1, VF0, VF1, VF2, VF3) do { \
                float gm_ = fmaxf(fmaxf(fmaxf(S0[0], S0[1]), fmaxf(S0[2], S0[3])), fmaxf(fmaxf(S1[0], S1[1]), fmaxf(S1[2], S1[3]))); \
                gm_ = fmaxf(gm_, __shfl_xor(gm_, 16)); gm_ = fmaxf(gm_, __shfl_xor(gm_, 32)); \
                const float mn_ = fmaxf(mrun, gm_); const float al_ = __expf(mrun - mn_); mrun = mn_; \
                float ps_ = 0.f; \
                _Pragma("unroll") for (int j_ = 0; j_ < 4; ++j_) { S0[j_] = __expf(S0[j_] - mn_); S1[j_] = __expf(S1[j_] - mn_); ps_ += S0[j_] + S1[j_]; } \
                sum = sum * al_ + ps_; \
                _Pragma("unroll") for (int m_ = 0; m_ < 4; ++m_) { o[m_][0] *= al_; o[m_][1] *= al_; o[m_][2] *= al_; o[m_][3] *= al_; } \
                union { unsigned u[4]; bf16x8 v; } pf_; \
                pf_.u[0] = pk_bf16(S0[0], S0[1]); pf_.u[1] = pk_bf16(S0[2], S0[3]); pf_.u[2] = pk_bf16(S1[0], S1[1]); pf_.u[3] = pk_bf16(S1[2], S1[3]); \
                o[0] = __builtin_amdgcn_mfma_f32_16x16x32_bf16(VF0, pf_.v, o[0], 0, 0, 0); o[1] = __builtin_amdgcn_mfma_f32_16x16x32_bf16(VF1, pf_.v, o[1], 0, 0, 0); \
                o[2] = __builtin_amdgcn_mfma_f32_16x16x32_bf16(VF2, pf_.v, o[2], 0, 0, 0); o[3] = __builtin_amdgcn_mfma_f32_16x16x32_bf16(VF3, pf_.v, o[3], 0, 0, 0); } while (0)
            if (lat) {
                const float* rp = rpb_s + h * 465;
                const bf16_t* vbase = nvT + ((size_t)bh * 64 + fr) * 2304 + 8 * fq;
                const bf16_t* kbase = nk + (size_t)(b * T + r0 * 64 + c0 + krow_off) * 512 + h * 64 + 8 * fq;
                int dcv[8]; bool okv[8];
#pragma unroll
                for (int j = 0; j < 8; ++j) { const int kc = c0 + 8 * fq + j; okv[j] = (kc >= wl) && (kc < wl + 16); dcv[j] = min(max(kc - qc + 15, 0), 30); }
#define NA_LOADG(K, V, BB, i) do { \
                    const bf16_t* kp_ = kbase + (size_t)(i) * 64 * 512; \
                    K[0] = *(const bf16x8*)kp_; K[1] = *(const bf16x8*)(kp_ + 32); K[2] = *(const bf16x8*)(kp_ + 4 * 512); K[3] = *(const bf16x8*)(kp_ + 4 * 512 + 32); \
                    const bf16_t* vp_ = vbase + (r0 + (i)) * 64 + c0; \
                    V[0] = *(const bf16x8*)vp_; V[1] = *(const bf16x8*)(vp_ + (size_t)16 * 2304); V[2] = *(const bf16x8*)(vp_ + (size_t)32 * 2304); V[3] = *(const bf16x8*)(vp_ + (size_t)48 * 2304); \
                    const float* rr_ = rp + (r0 + (i) - r + 7) * 31; \
                    _Pragma("unroll") for (int j_ = 0; j_ < 8; ++j_) BB[j_] = rr_[dcv[j_]]; } while (0)
#define NA_COMPG(K, V, BB) do { \
                    f32x4v a0_ = {0.f, 0.f, 0.f, 0.f}, a1_ = {0.f, 0.f, 0.f, 0.f}; \
                    a0_ = __builtin_amdgcn_mfma_f32_16x16x32_bf16(K[0], qf0, a0_, 0, 0, 0); a0_ = __builtin_amdgcn_mfma_f32_16x16x32_bf16(K[1], qf1, a0_, 0, 0, 0); \
                    a1_ = __builtin_amdgcn_mfma_f32_16x16x32_bf16(K[2], qf0, a1_, 0, 0, 0); a1_ = __builtin_amdgcn_mfma_f32_16x16x32_bf16(K[3], qf1, a1_, 0, 0, 0); \
                    _Pragma("unroll") for (int j_ = 0; j_ < 4; ++j_) { a0_[j_] = okv[j_] ? a0_[j_] + BB[j_] : -1e30f; a1_[j_] = okv[4 + j_] ? a1_[j_] + BB[4 + j_] : -1e30f; } \
                    NA_GROUP(a0_, a1_, V[0], V[1], V[2], V[3]); } while (0)
                bf16x8 KA[4], VA[4], KB[4], VB[4], KC[4], VC[4]; float BA[8], BB_[8], BC[8];
                NA_LOADG(KA, VA, BA, 0); NA_LOADG(KB, VB, BB_, 1);
                NA_LOADG(KC, VC, BC, 2); NA_COMPG(KA, VA, BA);
                NA_LOADG(KA, VA, BA, 3); NA_COMPG(KB, VB, BB_);
                NA_LOADG(KB, VB, BB_, 4); NA_COMPG(KC, VC, BC);
                NA_LOADG(KC, VC, BC, 5); NA_COMPG(KA, VA, BA);
                NA_LOADG(KA, VA, BA, 6); NA_COMPG(KB, VB, BB_);
                NA_LOADG(KB, VB, BB_, 7); NA_COMPG(KC, VC, BC);
                NA_COMPG(KA, VA, BA);
                NA_COMPG(KB, VB, BB_);
#undef NA_LOADG
#undef NA_COMPG
            }
#pragma unroll
            for (int pg = 0; pg < 8; ++pg) {
                const unsigned char* kp = sm + NA_KC + (32 * pg + krow_off) * 144 + 16 * fq;
                const bf16x8 k00 = *(const bf16x8*)kp, k01 = *(const bf16x8*)(kp + 64);
                const bf16x8 k10 = *(const bf16x8*)(kp + 4 * 144), k11 = *(const bf16x8*)(kp + 4 * 144 + 64);
                const unsigned char* vp = sm + NA_VC + fr * 528 + (32 * pg + 8 * fq) * 2;
                const bf16x8 vf0 = *(const bf16x8*)vp, vf1 = *(const bf16x8*)(vp + 16 * 528), vf2 = *(const bf16x8*)(vp + 32 * 528), vf3 = *(const bf16x8*)(vp + 48 * 528);
                f32x4v a0 = {0.f, 0.f, 0.f, 0.f}, a1 = {0.f, 0.f, 0.f, 0.f};
                a0 = __builtin_amdgcn_mfma_f32_16x16x32_bf16(k00, qf0, a0, 0, 0, 0); a0 = __builtin_amdgcn_mfma_f32_16x16x32_bf16(k01, qf1, a0, 0, 0, 0);
                a1 = __builtin_amdgcn_mfma_f32_16x16x32_bf16(k10, qf0, a1, 0, 0, 0); a1 = __builtin_amdgcn_mfma_f32_16x16x32_bf16(k11, qf1, a1, 0, 0, 0);
                NA_GROUP(a0, a1, vf0, vf1, vf2, vf3);
            }
#undef NA_GROUP
            sum += __shfl_xor(sum, 16); sum += __shfl_xor(sum, 32);
            const float rs = 1.f / sum;
            bf16_t* op = mix + (size_t)(qtok0 + fr) * 1024 + 512 + h * 64 + 4 * fq;
#pragma unroll
            for (int m = 0; m < 4; ++m) {
                uint2 w; w.x = pk_bf16(o[m][0] * rs, o[m][1] * rs); w.y = pk_bf16(o[m][2] * rs, o[m][3] * rs);
                *(uint2*)(op + m * 16) = w;
            }
        }
    }
}

__device__ __forceinline__ void phase_combine(const P& p, int l) {
    const bool need_ctx = (l == 0);
    const bf16_t* hdir = (const bf16_t*)(p.ws + WS_HDIR); const bf16_t* ob = (const bf16_t*)(p.ws + WS_O);
    bf16_t* mix = (bf16_t*)(p.ws + WS_MIX);
    const int tid_ = opaque_tid(); const int lane = tid_ & 63, wave = tid_ >> 6;
    const float4 nw0 = *(const float4*)(p.ml_norm_w + l * 512 + lane * 8), nw1 = *(const float4*)(p.ml_norm_w + l * 512 + lane * 8 + 4);
    const float nw[8] = {nw0.x, nw0.y, nw0.z, nw0.w, nw1.x, nw1.y, nw1.z, nw1.w};
    const int rows = need_ctx ? M : ML;
    for (int r = blockIdx.x * NW + wave; r < rows; r += gridDim.x * NW) {
        const size_t o0 = (size_t)r * 512 + lane * 8;
        const uint4 a = *(const uint4*)(hdir + o0), b = *(const uint4*)(hdir + (size_t)M * 512 + o0), og = *(const uint4*)(ob + o0);
        const unsigned aw[4] = {a.x, a.y, a.z, a.w}, bw[4] = {b.x, b.y, b.z, b.w}, gw[4] = {og.x, og.y, og.z, og.w};
        float v[8]; float s = 0.f;
#pragma unroll
        for (int i = 0; i < 4; ++i) {
            v[2 * i] = __uint_as_float(aw[i] << 16) + __uint_as_float(bw[i] << 16);
            v[2 * i + 1] = __uint_as_float(aw[i] & 0xffff0000u) + __uint_as_float(bw[i] & 0xffff0000u);
            s += v[2 * i] + v[2 * i + 1];
        }
        s += __shfl_xor(s, 8); s += __shfl_xor(s, 4); s += __shfl_xor(s, 2); s += __shfl_xor(s, 1);
        const float mu = s * (1.f / 128.f);
        float q = 0.f;
#pragma unroll
        for (int i = 0; i < 8; ++i) { v[i] -= mu; q += v[i] * v[i]; }
        q += __shfl_xor(q, 8); q += __shfl_xor(q, 4); q += __shfl_xor(q, 2); q += __shfl_xor(q, 1);
        const float rstd = rsqrtf(q * (1.f / 128.f) + LN_EPS);
        float o[8];
#pragma unroll
        for (int i = 0; i < 4; ++i) {
            o[2 * i] = v[2 * i] * rstd * nw[2 * i] * sigmoidf(__uint_as_float(gw[i] << 16));
            o[2 * i + 1] = v[2 * i + 1] * rstd * nw[2 * i + 1] * sigmoidf(__uint_as_float(gw[i] & 0xffff0000u));
        }
        *(uint4*)(mix + (size_t)r * 1024 + lane * 8) = make_uint4(pk_bf16(o[0], o[1]), pk_bf16(o[2], o[3]), pk_bf16(o[4], o[5]), pk_bf16(o[6], o[7]));
    }
}

__device__ __forceinline__ void phase_outproj(const P& p, int l, unsigned char* smraw) {
    const int rows = (l == 0) ? M : ML;
    pg8::Gemm g{(const pg8::bf16_t*)(p.ws + WS_MIX), (const pg8::bf16_t*)(p.ws + WS_WOUT) + (size_t)l * 1024 * 1024, rows, 1024, 1024};
    pg8::StaticOrder S; S.init(rows, 1024, (int)gridDim.x, (int)blockIdx.x);
    pg8::EpiBf16<0> E{(pg8::bf16_t*)(p.ws + WS_Y), 1024, nullptr, 0, 0};
    pg8::gemm_phase<pg8::EpiBf16<0>, pg8::StaticOrder, false>((PG8_LAS unsigned char*)smraw, g, S, E, nullptr);
}

__device__ __forceinline__ void phase_ln1(const P& p, int l) {
    const bf16_t* y = (const bf16_t*)(p.ws + WS_Y);
    bf16_t* u2 = (bf16_t*)(p.ws + WS_U2);
    const float* lw = p.ln1_w + l * D; const float* lb = p.ln1_b + l * D;
    const int tid_ = opaque_tid(); const int lane = tid_ & 63, wave = tid_ >> 6;
    const int rows = (l == 0) ? M : ML;
    const int k0 = lane * 16;
    for (int rp = blockIdx.x * NW + wave; rp < rows / 2; rp += gridDim.x * NW) {
        float z[2][16]; float s[2] = {0.f, 0.f};
#pragma unroll
        for (int h = 0; h < 2; ++h) {
            const int r = 2 * rp + h;
            const float* xr = xrow(p, l, r); const float* mp = modp(p, l, r);
            const uint4 ya = *(const uint4*)(y + (size_t)r * 1024 + k0), yb = *(const uint4*)(y + (size_t)r * 1024 + k0 + 8);
            const unsigned yw[8] = {ya.x, ya.y, ya.z, ya.w, yb.x, yb.y, yb.z, yb.w};
#pragma unroll
            for (int v4 = 0; v4 < 4; ++v4) {
                const float4 xv = *(const float4*)(xr + k0 + v4 * 4), g1 = *(const float4*)(mp + 2048 + k0 + v4 * 4);
                z[h][v4 * 4 + 0] = ALPHA * xv.x + g1.x * __uint_as_float(yw[v4 * 2] << 16);
                z[h][v4 * 4 + 1] = ALPHA * xv.y + g1.y * __uint_as_float(yw[v4 * 2] & 0xffff0000u);
                z[h][v4 * 4 + 2] = ALPHA * xv.z + g1.z * __uint_as_float(yw[v4 * 2 + 1] << 16);
                z[h][v4 * 4 + 3] = ALPHA * xv.w + g1.w * __uint_as_float(yw[v4 * 2 + 1] & 0xffff0000u);
                s[h] += (z[h][v4 * 4] + z[h][v4 * 4 + 1]) + (z[h][v4 * 4 + 2] + z[h][v4 * 4 + 3]);
            }
        }
        float mu[2], rstd[2];
#pragma unroll
        for (int h = 0; h < 2; ++h) mu[h] = wave_sum(s[h]) * (1.f / 1024.f);
#pragma unroll
        for (int h = 0; h < 2; ++h) {
            float q = 0.f;
#pragma unroll
            for (int i = 0; i < 16; ++i) { const float d = z[h][i] - mu[h]; q += d * d; }
            rstd[h] = rsqrtf(wave_sum(q) * (1.f / 1024.f) + LN_EPS);
        }
#pragma unroll
        for (int h = 0; h < 2; ++h) {
            const int r = 2 * rp + h;
            const float* mp = modp(p, l, r);
            float* xo = xrow_w(p, r);
            float uo[16]; float am = 0.f;
#pragma unroll
            for (int v4 = 0; v4 < 4; ++v4) {
                const int k = k0 + v4 * 4;
                const float4 w4 = *(const float4*)(lw + k), b4 = *(const float4*)(lb + k), sc = *(const float4*)(mp + 4096 + k), sh = *(const float4*)(mp + 3072 + k);
                float4 o;
                o.x = (z[h][v4 * 4] - mu[h]) * rstd[h] * w4.x + b4.x; o.y = (z[h][v4 * 4 + 1] - mu[h]) * rstd[h] * w4.y + b4.y;
                o.z = (z[h][v4 * 4 + 2] - mu[h]) * rstd[h] * w4.z + b4.z; o.w = (z[h][v4 * 4 + 3] - mu[h]) * rstd[h] * w4.w + b4.w;
                *(float4*)(xo + k) = o;
                uo[v4 * 4] = o.x * (1.f + sc.x) + sh.x; uo[v4 * 4 + 1] = o.y * (1.f + sc.y) + sh.y; uo[v4 * 4 + 2] = o.z * (1.f + sc.z) + sh.z; uo[v4 * 4 + 3] = o.w * (1.f + sc.w) + sh.w;
            }
            bf16_t* up_ = u2 + (size_t)r * 1024 + k0;
            *(uint4*)up_ = make_uint4(pk_bf16(uo[0], uo[1]), pk_bf16(uo[2], uo[3]), pk_bf16(uo[4], uo[5]), pk_bf16(uo[6], uo[7]));
            *(uint4*)(up_ + 8) = make_uint4(pk_bf16(uo[8], uo[9]), pk_bf16(uo[10], uo[11]), pk_bf16(uo[12], uo[13]), pk_bf16(uo[14], uo[15]));
#pragma unroll
            for (int i = 0; i < 16; ++i) am = fmaxf(am, fabsf(uo[i]));
            am = wave_max(am);
            const float inv = am > 0.f ? 127.f / am : 0.f;
            unsigned w[4];
#pragma unroll
            for (int d = 0; d < 4; ++d) {
                unsigned x = 0;
#pragma unroll
                for (int i = 0; i < 4; ++i) x |= (unsigned)(min(max((int)rintf(uo[d * 4 + i] * inv), -127), 127) & 0xff) << (8 * i);
                w[d] = x;
            }
            *(uint4*)(p.ws + WS_U2Q + (size_t)r * 1024 + k0) = make_uint4(w[0], w[1], w[2], w[3]);
            if (lane == 0) ((float*)(p.ws + WS_USC))[r] = am > 0.f ? am / 127.f : 0.f;
        }
    }
}

__device__ __forceinline__ void phase_peerq(const P& p, int l, unsigned char* smraw) {
    const int rows = (l == 0) ? M : ML;
    pg8::Gemm g{(const pg8::bf16_t*)(p.ws + WS_U2), (const pg8::bf16_t*)(p.ws + WS_WQ) + (size_t)l * 2048 * 1024, rows, 2048, 1024};
    pg8::StaticOrder S; S.init(rows, 2048, (int)gridDim.x, (int)blockIdx.x);
    pg8::EpiBf16<0> E{(pg8::bf16_t*)(p.ws + WS_Q), 2048, nullptr, 0, 0};
    pg8::gemm_phase<pg8::EpiBf16<0>, pg8::StaticOrder, false>((PG8_LAS unsigned char*)smraw, g, S, E, nullptr);
}

__device__ __forceinline__ unsigned f2key(float f) { const unsigned u = __float_as_uint(f); return (u & 0x80000000u) ? ~u : (u | 0x80000000u); }
__device__ __forceinline__ float key2f(unsigned k) { const unsigned u = (k & 0x80000000u) ? (k & 0x7fffffffu) : ~k; return __uint_as_float(u); }
__device__ __forceinline__ void ce_desc(unsigned& a, unsigned& b) { const unsigned mx = a > b ? a : b, mn = a > b ? b : a; a = mx; b = mn; }
__device__ __forceinline__ void sort16_desc(unsigned (&a)[16]) {
#pragma unroll
    for (int k = 2; k <= 16; k <<= 1)
#pragma unroll
        for (int j = k >> 1; j > 0; j >>= 1)
#pragma unroll
            for (int i = 0; i < 16; ++i) { const int l = i ^ j; if (l > i) { if ((i & k) == 0) ce_desc(a[i], a[l]); else ce_desc(a[l], a[i]); } }
}
__device__ __forceinline__ void merge16_desc(unsigned (&a)[16], const unsigned (&b)[16]) {
#pragma unroll
    for (int i = 0; i < 16; ++i) a[i] = a[i] > b[15 - i] ? a[i] : b[15 - i];
#pragma unroll
    for (int j = 8; j > 0; j >>= 1)
#pragma unroll
        for (int i = 0; i < 16; ++i) { const int l = i ^ j; if (l > i) ce_desc(a[i], a[l]); }
}
__device__ __forceinline__ void top16_of_acc(const f32x16 (&acc)[4], int hh, unsigned (&out)[16]) {
    unsigned g1[16], g2[16], g3[16];
#pragma unroll
    for (int r = 0; r < 16; ++r) {
        const int nb = (r & 3) + 8 * (r >> 2);
        out[r] = (f2key(acc[0][r]) & ~127u) | (unsigned)(127 - (nb + 4 * hh));
        g1[r]  = (f2key(acc[1][r]) & ~127u) | (unsigned)(127 - (32 + nb + 4 * hh));
        g2[r]  = (f2key(acc[2][r]) & ~127u) | (unsigned)(127 - (64 + nb + 4 * hh));
        g3[r]  = (f2key(acc[3][r]) & ~127u) | (unsigned)(127 - (96 + nb + 4 * hh));
    }
    sort16_desc(out); sort16_desc(g1); sort16_desc(g2); sort16_desc(g3);
    merge16_desc(out, g1); merge16_desc(g2, g3); merge16_desc(out, g2);
#pragma unroll
    for (int i = 0; i < 16; ++i) g1[i] = (unsigned)__shfl_xor((int)out[i], 32);
    merge16_desc(out, g1);
}
constexpr int TK_KEYS_BYTES = 256 * 272;
__device__ __forceinline__ void phase_topk(const P& p, int l, unsigned char* smraw) {
    const bf16_t* q = (const bf16_t*)(p.ws + WS_Q);
    int* eidx = (int*)(p.ws + WS_EIDX); float* egate = (float*)(p.ws + WS_EGATE);
    const int tid = opaque_tid(); const int lane = tid & 63, wave = tid >> 6, tl = lane & 31, hh = lane >> 5;
    unsigned char* keys_lds = smraw;
    unsigned char* slot = smraw + TK_KEYS_BYTES + wave * 2048 + lane * 32;
    const int rows = (l == 0) ? M : ML;
    const int nchunks = rows / 256;
    int cur_h = -1;
    for (int it = blockIdx.x; it < 8 * nchunks; it += gridDim.x) {
        const int h = it & 7, chunk = it >> 3;
        if (h != cur_h) {
            __syncthreads();
            const float* kb = p.peer_keys + (size_t)(l * 8 + h) * 2 * 128 * 128;
            for (int i = tid; i < 256 * 16; i += NT) {
                const int row = i >> 4, c8 = i & 15;
                const float4 f0 = *(const float4*)(kb + (size_t)row * 128 + c8 * 8), f1 = *(const float4*)(kb + (size_t)row * 128 + c8 * 8 + 4);
                uint4 w; w.x = (unsigned)f2bf(f0.x) | ((unsigned)f2bf(f0.y) << 16); w.y = (unsigned)f2bf(f0.z) | ((unsigned)f2bf(f0.w) << 16);
                w.z = (unsigned)f2bf(f1.x) | ((unsigned)f2bf(f1.y) << 16); w.w = (unsigned)f2bf(f1.z) | ((unsigned)f2bf(f1.w) << 16);
                *(uint4*)(keys_lds + row * 272 + c8 * 16) = w;
            }
            __syncthreads();
            cur_h = h;
        }
        const int t0 = (chunk * 8 + wave) * 32;
        const bf16_t* qrow = q + (size_t)(t0 + tl) * 2048 + h * 256 + 8 * hh;
        unsigned T1[16], T2[16];
#pragma unroll
        for (int half = 0; half < 2; ++half) {
            bf16x8 bq[8];
#pragma unroll
            for (int ks = 0; ks < 8; ++ks) bq[ks] = *(const bf16x8*)(qrow + half * 128 + ks * 16);
            f32x16 acc[4];
#pragma unroll
            for (int mt = 0; mt < 4; ++mt)
#pragma unroll
                for (int r = 0; r < 16; ++r) acc[mt][r] = 0.f;
#pragma unroll
            for (int ks = 0; ks < 8; ++ks)
#pragma unroll
                for (int mt = 0; mt < 4; ++mt) {
                    const bf16x8 a = *(const bf16x8*)(keys_lds + (half * 128 + mt * 32 + tl) * 272 + ks * 32 + 16 * hh);
                    acc[mt] = __builtin_amdgcn_mfma_f32_32x32x16_bf16(a, bq[ks], acc[mt], 0, 0, 0);
                }
            if (half == 0) top16_of_acc(acc, hh, T1); else top16_of_acc(acc, hh, T2);
        }
        {
            uint4 w1, w2;
#define PK4(T, o) ((127u - (T[o] & 127u)) | ((127u - (T[o + 1] & 127u)) << 8) | ((127u - (T[o + 2] & 127u)) << 16) | ((127u - (T[o + 3] & 127u)) << 24))
            w1.x = PK4(T1, 0); w1.y = PK4(T1, 4); w1.z = PK4(T1, 8); w1.w = PK4(T1, 12);
            w2.x = PK4(T2, 0); w2.y = PK4(T2, 4); w2.z = PK4(T2, 8); w2.w = PK4(T2, 12);
#undef PK4
            *(uint4*)slot = w1; *(uint4*)(slot + 16) = w2;
        }
        float v1[16], v2[16];
#pragma unroll
        for (int i = 0; i < 16; ++i) { v1[i] = key2f(T1[i] & ~127u); v2[i] = key2f(T2[i] & ~127u); }
        unsigned cg0[16], cg1[16], cg2[16], cg3[16];
        cg0[0] = (f2key(v1[0] + v2[0]) & ~255u) | 255u;
        cg0[1] = (f2key(v1[0] + v2[1]) & ~255u) | 254u;
        cg0[2] = (f2key(v1[0] + v2[2]) & ~255u) | 253u;
        cg0[3] = (f2key(v1[0] + v2[3]) & ~255u) | 252u;
        cg0[4] = (f2key(v1[0] + v2[4]) & ~255u) | 251u;
        cg0[5] = (f2key(v1[0] + v2[5]) & ~255u) | 250u;
        cg0[6] = (f2key(v1[0] + v2[6]) & ~255u) | 249u;
        cg0[7] = (f2key(v1[0] + v2[7]) & ~255u) | 248u;
        cg0[8] = (f2key(v1[0] + v2[8]) & ~255u) | 247u;
        cg0[9] = (f2key(v1[0] + v2[9]) & ~255u) | 246u;
        cg0[10] = (f2key(v1[0] + v2[10]) & ~255u) | 245u;
        cg0[11] = (f2key(v1[0] + v2[11]) & ~255u) | 244u;
        cg0[12] = (f2key(v1[0] + v2[12]) & ~255u) | 243u;
        cg0[13] = (f2key(v1[0] + v2[13]) & ~255u) | 242u;
        cg0[14] = (f2key(v1[0] + v2[14]) & ~255u) | 241u;
        cg0[15] = (f2key(v1[0] + v2[15]) & ~255u) | 240u;
        cg1[0] = (f2key(v1[1] + v2[0]) & ~255u) | 239u;
        cg1[1] = (f2key(v1[1] + v2[1]) & ~255u) | 238u;
        cg1[2] = (f2key(v1[1] + v2[2]) & ~255u) | 237u;
        cg1[3] = (f2key(v1[1] + v2[3]) & ~255u) | 236u;
        cg1[4] = (f2key(v1[1] + v2[4]) & ~255u) | 235u;
        cg1[5] = (f2key(v1[1] + v2[5]) & ~255u) | 234u;
        cg1[6] = (f2key(v1[1] + v2[6]) & ~255u) | 233u;
        cg1[7] = (f2key(v1[1] + v2[7]) & ~255u) | 232u;
        cg1[8] = (f2key(v1[2] + v2[0]) & ~255u) | 223u;
        cg1[9] = (f2key(v1[2] + v2[1]) & ~255u) | 222u;
        cg1[10] = (f2key(v1[2] + v2[2]) & ~255u) | 221u;
        cg1[11] = (f2key(v1[2] + v2[3]) & ~255u) | 220u;
        cg1[12] = (f2key(v1[2] + v2[4]) & ~255u) | 219u;
        cg1[13] = (f2key(v1[3] + v2[0]) & ~255u) | 207u;
        cg1[14] = (f2key(v1[3] + v2[1]) & ~255u) | 206u;
        cg1[15] = (f2key(v1[3] + v2[2]) & ~255u) | 205u;
        cg2[0] = (f2key(v1[3] + v2[3]) & ~255u) | 204u;
        cg2[1] = (f2key(v1[4] + v2[0]) & ~255u) | 191u;
        cg2[2] = (f2key(v1[4] + v2[1]) & ~255u) | 190u;
        cg2[3] = (f2key(v1[4] + v2[2]) & ~255u) | 189u;
        cg2[4] = (f2key(v1[5] + v2[0]) & ~255u) | 175u;
        cg2[5] = (f2key(v1[5] + v2[1]) & ~255u) | 174u;
        cg2[6] = (f2key(v1[6] + v2[0]) & ~255u) | 159u;
        cg2[7] = (f2key(v1[6] + v2[1]) & ~255u) | 158u;
        cg2[8] = (f2key(v1[7] + v2[0]) & ~255u) | 143u;
        cg2[9] = (f2key(v1[7] + v2[1]) & ~255u) | 142u;
        cg2[10] = (f2key(v1[8] + v2[0]) & ~255u) | 127u;
        cg2[11] = (f2key(v1[9] + v2[0]) & ~255u) | 111u;
        cg2[12] = (f2key(v1[10] + v2[0]) & ~255u) | 95u;
        cg2[13] = (f2key(v1[11] + v2[0]) & ~255u) | 79u;
        cg2[14] = (f2key(v1[12] + v2[0]) & ~255u) | 63u;
        cg2[15] = (f2key(v1[13] + v2[0]) & ~255u) | 47u;
        cg3[0] = (f2key(v1[14] + v2[0]) & ~255u) | 31u;
        cg3[1] = (f2key(v1[15] + v2[0]) & ~255u) | 15u;
        cg3[2] = 0u;
        cg3[3] = 0u;
        cg3[4] = 0u;
        cg3[5] = 0u;
        cg3[6] = 0u;
        cg3[7] = 0u;
        cg3[8] = 0u;
        cg3[9] = 0u;
        cg3[10] = 0u;
        cg3[11] = 0u;
        cg3[12] = 0u;
        cg3[13] = 0u;
        cg3[14] = 0u;
        cg3[15] = 0u;
        sort16_desc(cg0); sort16_desc(cg1); sort16_desc(cg2); sort16_desc(cg3);
        merge16_desc(cg0, cg1); merge16_desc(cg2, cg3); merge16_desc(cg0, cg2);
        const float top0 = key2f(cg0[0] & ~255u);
        float ev[16]; float es = 0.f;
#pragma unroll
        for (int j = 0; j < 16; ++j) { ev[j] = expf(key2f(cg0[j] & ~255u) - top0); es += ev[j]; }
        const float rs = 1.f / es;
        __builtin_amdgcn_wave_barrier();
        int eo[8]; float go[8];
#pragma unroll
        for (int jj = 0; jj < 8; ++jj) {
            const unsigned wlo_ = cg0[jj], whi_ = cg0[jj + 8]; const unsigned w = hh ? whi_ : wlo_;
            const unsigned cid = 255u - (w & 255u);
            const int i1 = slot[cid >> 4], i2 = slot[16 + (cid & 15u)];
            eo[jj] = i1 * 128 + i2;
            const float elo_ = ev[jj], ehi_ = ev[jj + 8]; go[jj] = (hh ? ehi_ : elo_) * rs;
        }
        int* ep = eidx + (size_t)(t0 + tl) * 128 + h * 16 + 8 * hh;
        float* gp = egate + (size_t)(t0 + tl) * 128 + h * 16 + 8 * hh;
        *(int4*)ep = make_int4(eo[0], eo[1], eo[2], eo[3]); *(int4*)(ep + 4) = make_int4(eo[4], eo[5], eo[6], eo[7]);
        *(float4*)gp = make_float4(go[0], go[1], go[2], go[3]); *(float4*)(gp + 4) = make_float4(go[4], go[5], go[6], go[7]);
        __builtin_amdgcn_wave_barrier();
    }
}

__device__ __forceinline__ void phase_tabprep(const P& p, int l, unsigned char* sm) {
    const int tid_ = opaque_tid(); const int lane = tid_ & 63, wave = tid_ >> 6;
    float* sc = (float*)(p.ws + WS_TSC);
    unsigned* counter = (unsigned*)(p.ws + WS_CNT) + 16 * (2 + l);
    volatile int* ctl = (volatile int*)sm;
    for (;;) {
        __syncthreads();
        if (tid_ == 0) ctl[0] = (int)atomicAdd(counter, 1u);
        __syncthreads();
        const int chunk = ctl[0];
        if (chunk >= 512) break;
      for (int jj = 0; jj < 8; ++jj) {
        const int job = chunk * 64 + jj * 8 + wave;
        const int tbl = job >> 14, e = job & 16383;
        const float* src = (tbl ? p.peer_down : p.peer_up) + ((size_t)l * 16384 + e) * 1024 + lane * 16;
        const float4 v0 = *(const float4*)src, v1 = *(const float4*)(src + 4), v2 = *(const float4*)(src + 8), v3 = *(const float4*)(src + 12);
        const float f[16] = {v0.x, v0.y, v0.z, v0.w, v1.x, v1.y, v1.z, v1.w, v2.x, v2.y, v2.z, v2.w, v3.x, v3.y, v3.z, v3.w};
        float am = 0.f;
#pragma unroll
        for (int i = 0; i < 16; ++i) am = fmaxf(am, fabsf(f[i]));
        am = wave_max(am);
        const float inv = am > 0.f ? 127.f / am : 0.f;
        unsigned w[4];
#pragma unroll
        for (int d = 0; d < 4; ++d) {
            unsigned x = 0;
#pragma unroll
            for (int i = 0; i < 4; ++i) { const int q = min(max((int)rintf(f[d * 4 + i] * inv), -127), 127); x |= (unsigned)(q & 0xff) << (8 * i); }
            w[d] = x;
        }
        *(uint4*)(p.ws + (tbl ? WS_TDN : WS_TUP) + (size_t)(lane >> 3) * (16384 * 128) + (size_t)e * 128 + (lane & 7) * 16) = make_uint4(w[0], w[1], w[2], w[3]);
        if (lane == 0) sc[job] = am > 0.f ? am / 127.f : 0.f;
      }
    }
    __syncthreads();
}

constexpr size_t WS_PD = WS_Q;
__device__ __forceinline__ float readlane_f(float v, int l) { return __int_as_float(__builtin_amdgcn_readlane(__float_as_int(v), l)); }
__device__ __forceinline__ float dot16u8(const uint4& w, const float* u, float acc) {
    const unsigned ww[4] = {w.x, w.y, w.z, w.w};
#pragma unroll
    for (int d = 0; d < 4; ++d)
#pragma unroll
        for (int i = 0; i < 4; ++i) acc += u[d * 4 + i] * (float)((ww[d] >> (8 * i)) & 0xffu);
    return acc;
}
__device__ __forceinline__ void fma16u8(float* y, const uint4& w, float a) {
    const unsigned ww[4] = {w.x, w.y, w.z, w.w};
#pragma unroll
    for (int d = 0; d < 4; ++d)
#pragma unroll
        for (int i = 0; i < 4; ++i) y[d * 4 + i] += a * (float)((ww[d] >> (8 * i)) & 0xffu);
}
__device__ __forceinline__ int idot16(const uint4& w, const uint4& u) {
    int a = __builtin_amdgcn_sdot4((int)w.x, (int)u.x, 0, false); a = __builtin_amdgcn_sdot4((int)w.y, (int)u.y, a, false);
    a = __builtin_amdgcn_sdot4((int)w.z, (int)u.z, a, false); return __builtin_amdgcn_sdot4((int)w.w, (int)u.w, a, false);
}
__device__ __forceinline__ void tdot4x4(int* y, const uint4& w0, const uint4& w1, const uint4& w2, const uint4& w3, unsigned cq) {
    const unsigned a0[4] = {w0.x, w0.y, w0.z, w0.w}, a1[4] = {w1.x, w1.y, w1.z, w1.w}, a2[4] = {w2.x, w2.y, w2.z, w2.w}, a3[4] = {w3.x, w3.y, w3.z, w3.w};
#pragma unroll
    for (int r = 0; r < 4; ++r) {
        const unsigned lo01 = __builtin_amdgcn_perm(a1[r], a0[r], 0x05010400u), hi01 = __builtin_amdgcn_perm(a1[r], a0[r], 0x07030602u);
        const unsigned lo23 = __builtin_amdgcn_perm(a3[r], a2[r], 0x05010400u), hi23 = __builtin_amdgcn_perm(a3[r], a2[r], 0x07030602u);
        const unsigned c0 = __builtin_amdgcn_perm(lo23, lo01, 0x05040100u), c1 = __builtin_amdgcn_perm(lo23, lo01, 0x07060302u);
        const unsigned c2 = __builtin_amdgcn_perm(hi23, hi01, 0x05040100u), c3 = __builtin_amdgcn_perm(hi23, hi01, 0x07060302u);
        y[4 * r + 0] = __builtin_amdgcn_sdot4((int)c0, (int)cq, y[4 * r + 0], false);
        y[4 * r + 1] = __builtin_amdgcn_sdot4((int)c1, (int)cq, y[4 * r + 1], false);
        y[4 * r + 2] = __builtin_amdgcn_sdot4((int)c2, (int)cq, y[4 * r + 2], false);
        y[4 * r + 3] = __builtin_amdgcn_sdot4((int)c3, (int)cq, y[4 * r + 3], false);
    }
}
__device__ __forceinline__ unsigned my_xcc() { return (unsigned)__builtin_amdgcn_s_getreg((3 << 11) | 20) & 7u; }

template <int PH>
__device__ __forceinline__ void phase_eslice(const P& p, int l, unsigned char* sm) {
    const bf16_t* u2 = (const bf16_t*)(p.ws + WS_U2);
    const int* eidx = (const int*)(p.ws + WS_EIDX); const float* coefp = (const float*)(p.ws + WS_EGATE);
    const unsigned char* tab = p.ws + (PH == 0 ? WS_TUP : WS_TDN);
    float* pd = (float*)(p.ws + WS_PD);
    unsigned* cnts = (unsigned*)(p.ws + WS_CNT + 256) + (size_t)((l * 2 + PH) * 8) * 16;
    const int tid = opaque_tid(); const int lane = tid & 63, wave = tid >> 6;
    volatile int* ctl = (volatile int*)sm;
    const int rows = (l == 0) ? M : ML;
    const int nchunks = rows / 128;
    const unsigned xcc = my_xcc();
    for (int att = 0; att < 8; ++att) {
        const int slice = (int)((xcc + (unsigned)att) & 7u);
        for (;;) {
            __syncthreads();
            if (tid == 0) ctl[0] = (int)atomicAdd(cnts + slice * 16, 1u);
            __syncthreads();
            const int chunk = ctl[0];
            if (chunk >= nchunks) break;
            int lane_o = lane; asm volatile("" : "+v"(lane_o));
            const int sub = lane_o & 7, g = lane_o >> 3;
            const int t0 = chunk * 128 + wave * 16;
            const unsigned char* tsl = tab + (size_t)slice * (16384 * 128) + sub * 16;
#define LD_EV(dst, tok) do { const int4* ep_ = (const int4*)(eidx + (size_t)(tok) * 128 + 16 * g); dst[0] = ep_[0]; dst[1] = ep_[1]; dst[2] = ep_[2]; dst[3] = ep_[3]; } while (0)
#define GATHER(dst, ev) do { _Pragma("unroll") for (int q_ = 0; q_ < 4; ++q_) { \
            dst[4 * q_ + 0] = *(const uint4*)(tsl + (size_t)ev[q_].x * 128); dst[4 * q_ + 1] = *(const uint4*)(tsl + (size_t)ev[q_].y * 128); \
            dst[4 * q_ + 2] = *(const uint4*)(tsl + (size_t)ev[q_].z * 128); dst[4 * q_ + 3] = *(const uint4*)(tsl + (size_t)ev[q_].w * 128); } } while (0)
#define LD_SMALL(dst, tok) do { if (PH == 0) { dst[0] = *(const uint4*)(p.ws + WS_U2Q + (size_t)(tok) * 1024 + slice * 128 + sub * 16); } \
            else { const unsigned char* rb_ = (const unsigned char*)(coefp + (size_t)(tok) * 128); dst[0] = *(const uint4*)(rb_ + 16 * g); dst[1].x = *(const unsigned*)(rb_ + 128); } } while (0)
            auto compute = [&](const uint4 (&W)[16], const uint4 (&smx)[2], const int t) {
                if (PH == 0) {
                    float acc[16];
#pragma unroll
                    for (int b = 0; b < 16; ++b) acc[b] = (float)idot16(W[b], smx[0]);
                    const bool s4 = sub & 4, s2 = sub & 2, s1 = sub & 1;
                    float d8[8];
#pragma unroll
                    for (int i = 0; i < 8; ++i) { const float lo_ = acc[i], hi_ = acc[i + 8]; const float keep = s4 ? hi_ : lo_, send = s4 ? lo_ : hi_; d8[i] = keep + __shfl_xor(send, 4); }
                    float d4[4];
#pragma unroll
                    for (int i = 0; i < 4; ++i) { const float lo_ = d8[i], hi_ = d8[i + 4]; const float keep = s2 ? hi_ : lo_, send = s2 ? lo_ : hi_; d4[i] = keep + __shfl_xor(send, 2); }
                    float d2[2];
#pragma unroll
                    for (int i = 0; i < 2; ++i) { const float lo_ = d4[i], hi_ = d4[i + 2]; const float keep = s1 ? hi_ : lo_, send = s1 ? lo_ : hi_; d2[i] = keep + __shfl_xor(send, 1); }
                    const int b0 = (s4 ? 8 : 0) + (s2 ? 4 : 0) + (s1 ? 2 : 0);
                    *(float2*)(pd + ((size_t)slice * rows + t) * 128 + 16 * g + b0) = make_float2(d2[0], d2[1]);
                } else {
                    int yi[16];
#pragma unroll
                    for (int i = 0; i < 16; ++i) yi[i] = 0;
                    const unsigned cq[4] = {smx[0].x, smx[0].y, smx[0].z, smx[0].w};
                    const float csc = __uint_as_float(smx[1].x);
                    tdot4x4(yi, W[0], W[1], W[2], W[3], cq[0]); tdot4x4(yi, W[4], W[5], W[6], W[7], cq[1]);
                    tdot4x4(yi, W[8], W[9], W[10], W[11], cq[2]); tdot4x4(yi, W[12], W[13], W[14], W[15], cq[3]);
                    const bool h32 = lane_o & 32, h16 = lane_o & 16, h8 = lane_o & 8;
                    int y8[8];
#pragma unroll
                    for (int i = 0; i < 8; ++i) { const int lo_ = yi[i], hi_ = yi[i + 8]; const int keep = h32 ? hi_ : lo_, send = h32 ? lo_ : hi_; y8[i] = keep + __shfl_xor(send, 32); }
                    int y4[4];
#pragma unroll
                    for (int i = 0; i < 4; ++i) { const int lo_ = y8[i], hi_ = y8[i + 4]; const int keep = h16 ? hi_ : lo_, send = h16 ? lo_ : hi_; y4[i] = keep + __shfl_xor(send, 16); }
                    int y2[2];
#pragma unroll
                    for (int i = 0; i < 2; ++i) { const int lo_ = y4[i], hi_ = y4[i + 2]; const int keep = h8 ? hi_ : lo_, send = h8 ? lo_ : hi_; y2[i] = keep + __shfl_xor(send, 8); }
                    const int col = slice * 128 + sub * 16 + (h32 ? 8 : 0) + (h16 ? 4 : 0) + (h8 ? 2 : 0);
                    const float* mp = modp(p, l, t);
                    float* xo = xrow_w(p, t);
                    const float2 xv = *(const float2*)(xo + col), gg = *(const float2*)(mp + 5120 + col);
                    float2 z; z.x = ALPHA * xv.x + gg.x * ((float)y2[0] * csc); z.y = ALPHA * xv.y + gg.y * ((float)y2[1] * csc);
                    *(float2*)(xo + col) = z;
                }
            };
            int4 ev0[4], ev1[4];
            uint4 WA[16], WB[16];
            uint4 sm0[2], sm1[2];
            sm0[1] = make_uint4(0, 0, 0, 0); sm1[1] = make_uint4(0, 0, 0, 0);
            LD_EV(ev0, t0); LD_EV(ev1, t0 + 1);
            LD_SMALL(sm0, t0); LD_SMALL(sm1, t0 + 1);
            GATHER(WA, ev0);
            LD_EV(ev0, t0 + 2);
#pragma unroll 1
            for (int tk = 0; tk < 16; tk += 2) {
                const int t = t0 + tk;
                GATHER(WB, ev1);
                if (tk + 3 < 16) LD_EV(ev1, t + 3);
                compute(WA, sm0, t);
                if (tk + 2 < 16) { LD_SMALL(sm0, t + 2); GATHER(WA, ev0); }
                if (tk + 4 < 16) LD_EV(ev0, t + 4);
                compute(WB, sm1, t + 1);
                if (tk + 3 < 16) LD_SMALL(sm1, t + 3);
            }
#undef LD_EV
#undef GATHER
#undef LD_SMALL
        }
    }
    __syncthreads();
}

__device__ __forceinline__ void phase_ecoef(const P& p, int l) {
    const int* eidx = (const int*)(p.ws + WS_EIDX); float* egate = (float*)(p.ws + WS_EGATE);
    const float* pd = (const float*)(p.ws + WS_PD);
    const float* scu = (const float*)(p.ws + WS_TSC); const float* scd = scu + 16384;
    const int tid_ = opaque_tid(); const int lane = tid_ & 63, wave = tid_ >> 6;
    const int rows = (l == 0) ? M : ML;
    for (int r = blockIdx.x * NW + wave; r < rows; r += gridDim.x * NW) {
        const float usc = ((const float*)(p.ws + WS_USC))[r];
        float cf[2];
#pragma unroll
        for (int hf = 0; hf < 2; ++hf) {
            const int j = hf * 64 + lane;
            float d = 0.f;
#pragma unroll
            for (int x = 0; x < 8; ++x) d += pd[((size_t)x * rows + r) * 128 + j];
            const int e = eidx[(size_t)r * 128 + j];
            cf[hf] = egate[(size_t)r * 128 + j] * scd[e] * gelu_tanh(scu[e] * usc * d);
        }
        const float am = wave_max(fmaxf(fabsf(cf[0]), fabsf(cf[1])));
        const float inv = am > 0.f ? 127.f / am : 0.f;
        unsigned char* rowb = (unsigned char*)(egate + (size_t)r * 128);
        const int q0 = min(max((int)rintf(cf[0] * inv), -127), 127), q1 = min(max((int)rintf(cf[1] * inv), -127), 127);
        __builtin_amdgcn_wave_barrier();
        rowb[lane] = (unsigned char)(q0 & 0xff); rowb[64 + lane] = (unsigned char)(q1 & 0xff);
        if (lane == 0) *(float*)(rowb + 128) = am > 0.f ? am / 127.f : 0.f;
    }
}

__device__ __forceinline__ void phase_eln(const P& p, int l, float* sm) {
    const float* lw = p.ln2_w + l * D; const float* lb = p.ln2_b + l * D;
    const int tid_ = opaque_tid(); const int lane = tid_ & 63, wave = tid_ >> 6;
    const int rows = (l == 0) ? M : ML;
    const bool nxt = (l == 0);
    bf16_t* u1 = (bf16_t*)(p.ws + WS_U1);
    float* gates = (float*)(p.ws + WS_GATES);
    if (nxt) {
        __syncthreads();
        for (int i = tid_; i < 16 * 1024; i += NT) { const int k = i >> 4, g = i & 15; sm[g * 1024 + k] = p.w_in[(size_t)(l + 1) * D * D_IN + (size_t)k * D_IN + 1536 + g]; }
        __syncthreads();
    }
    for (int r = blockIdx.x * NW + wave; r < rows; r += gridDim.x * NW) {
        float* xo = xrow_w(p, r);
        const int k0 = lane * 16;
        float z[16]; float s = 0.f;
#pragma unroll
        for (int v4 = 0; v4 < 4; ++v4) {
            const float4 v = *(const float4*)(xo + k0 + v4 * 4);
            z[v4 * 4] = v.x; z[v4 * 4 + 1] = v.y; z[v4 * 4 + 2] = v.z; z[v4 * 4 + 3] = v.w;
            s += (v.x + v.y) + (v.z + v.w);
        }
        const float mu = wave_sum(s) * (1.f / 1024.f);
        float q = 0.f;
#pragma unroll
        for (int i = 0; i < 16; ++i) { const float d = z[i] - mu; q += d * d; }
        const float rstd = rsqrtf(wave_sum(q) * (1.f / 1024.f) + LN_EPS);
#pragma unroll
        for (int v4 = 0; v4 < 4; ++v4) {
            const int k = k0 + v4 * 4;
            const float4 w4 = *(const float4*)(lw + k), b4 = *(const float4*)(lb + k);
            float4 o;
            o.x = (z[v4 * 4] - mu) * rstd * w4.x + b4.x; o.y = (z[v4 * 4 + 1] - mu) * rstd * w4.y + b4.y;
            o.z = (z[v4 * 4 + 2] - mu) * rstd * w4.z + b4.z; o.w = (z[v4 * 4 + 3] - mu) * rstd * w4.w + b4.w;
            *(float4*)(xo + k) = o;
            z[v4 * 4] = o.x; z[v4 * 4 + 1] = o.y; z[v4 * 4 + 2] = o.z; z[v4 * 4 + 3] = o.w;
        }
        if (nxt) {
            const float* mp = modp(p, l + 1, r);
            float ga[16];
#pragma unroll
            for (int g = 0; g < 16; ++g) ga[g] = 0.f;
#pragma unroll 1
            for (int v4 = 0; v4 < 4; ++v4) {
                const int k = k0 + v4 * 4;
                const float4 sc = *(const float4*)(mp + 1024 + k), sh = *(const float4*)(mp + k);
                const float u[4] = {z[v4 * 4] * (1.f + sc.x) + sh.x, z[v4 * 4 + 1] * (1.f + sc.y) + sh.y, z[v4 * 4 + 2] * (1.f + sc.z) + sh.z, z[v4 * 4 + 3] * (1.f + sc.w) + sh.w};
                uint2 pk; pk.x = pk_bf16(u[0], u[1]); pk.y = pk_bf16(u[2], u[3]);
                *(uint2*)(u1 + (size_t)r * 1024 + k) = pk;
#pragma unroll
                for (int g = 0; g < 16; ++g) {
                    const float4 w = *(const float4*)(sm + g * 1024 + k);
                    ga[g] += u[0] * w.x + u[1] * w.y + u[2] * w.z + u[3] * w.w;
                }
            }
            const float mine = wave_sum16(ga, lane);
            if (lane < 16) gates[(size_t)r * 16 + lane] = mine + p.b_gate[(l + 1) * 16 + lane];
        }
    }
    __syncthreads();
}

#define XB_TMO      128
#define XB_XCNT(j)  (256  + 64 * (j))
#define XB_XSUB(j)  (1280 + 64 * (j))
#define XB_XGEN(j)  (2304 + 64 * (j))
#define XB_TOP      3328
#define XB_TOPGEN   3392
#define XCD_BAR_WORDS 3456
#define XB_SPIN_CAP (1u << 18)
#define LAS __attribute__((address_space(3)))

__device__ __forceinline__ unsigned xb_ld(unsigned* p)              { return __hip_atomic_load(p, __ATOMIC_RELAXED, __HIP_MEMORY_SCOPE_AGENT); }
__device__ __forceinline__ unsigned xb_add(unsigned* p, unsigned v) { return __hip_atomic_fetch_add(p, v, __ATOMIC_RELAXED, __HIP_MEMORY_SCOPE_AGENT); }
__device__ __forceinline__ unsigned xb_xcc_id() { return (unsigned)__builtin_amdgcn_s_getreg((3 << 11) | 20) & 0xFu; }
#define XB_SPIN(cond, bar) do { unsigned _sp = 0; while (cond) { __builtin_amdgcn_s_sleep(1); \
    if ((++_sp & 255u) == 0u) { if (xb_ld(&(bar)[XB_TMO])) break; if (_sp > XB_SPIN_CAP) { atomicAdd(&(bar)[XB_TMO], 1u); break; } } } } while (0)

struct XcdBarrier {
    unsigned* bar; unsigned x;
    volatile LAS unsigned* st;
};

__device__ __forceinline__ XcdBarrier xcd_barrier_post(unsigned* bar, volatile LAS unsigned* st) {
    XcdBarrier b; b.bar = bar; b.x = xb_xcc_id(); b.st = st;
    if (threadIdx.x == 0) (void)xb_add(&bar[XB_XCNT(b.x)], 1u);
    return b;
}
__device__ __forceinline__ void xcd_barrier_complete(unsigned* bar, unsigned x, unsigned& nloc, unsigned& nx) {
    const unsigned G = gridDim.x * gridDim.y * gridDim.z;
    unsigned sum, cnt, mine, sp = 0u;
    for (;;) {
        sum = 0u; cnt = 0u; mine = 0u;
#pragma unroll
        for (unsigned j = 0; j < 16; ++j) { const unsigned c = xb_ld(&bar[XB_XCNT(j)]); sum += c; cnt += (c > 0u) ? 1u : 0u; mine = (j == x) ? c : mine; }
        if (sum == G) break;
        __builtin_amdgcn_s_sleep(1);
        if ((++sp & 255u) == 0u) { if (xb_ld(&bar[XB_TMO])) break; if (sp > XB_SPIN_CAP) { atomicAdd(&bar[XB_TMO], 1u); break; } }
    }
    nloc = mine > 0u ? mine : 1u; nx = cnt > 0u ? cnt : 1u;
}

__device__ __forceinline__ void xcd_barrier(const XcdBarrier& b) {
    asm volatile("s_waitcnt vmcnt(0)" ::: "memory");
    __syncthreads();
    if (threadIdx.x == 0) {
        unsigned* bar = b.bar;
        __builtin_amdgcn_s_waitcnt(0);
        unsigned nloc = b.st[0], nx = b.st[1];
        if (nloc == 0u) { xcd_barrier_complete(bar, b.x, nloc, nx); b.st[0] = nloc; b.st[1] = nx; }
        const unsigned old = xb_add(&bar[XB_XSUB(b.x)], 1u);
        const unsigned gen = old / nloc;
        if (old + 1u == (gen + 1u) * nloc) {
            __builtin_amdgcn_fence(__ATOMIC_RELEASE, "agent");
            asm volatile("s_waitcnt vmcnt(0)" ::: "memory");
            const unsigned og = xb_add(&bar[XB_TOP], 1u);
            const unsigned tg = og / nx;
            if (og + 1u == (tg + 1u) * nx) xb_add(&bar[XB_TOPGEN], 1u);
            else XB_SPIN(xb_ld(&bar[XB_TOPGEN]) == tg, bar);
            __builtin_amdgcn_fence(__ATOMIC_ACQUIRE, "agent");
            xb_add(&bar[XB_XGEN(b.x)], 1u);
            asm volatile("s_waitcnt vmcnt(0)" ::: "memory");
        } else {
            XB_SPIN(xb_ld(&bar[XB_XGEN(b.x)]) == gen, bar);
            __builtin_amdgcn_fence(__ATOMIC_ACQUIRE, "agent");
            asm volatile("s_waitcnt vmcnt(0)" ::: "memory");
        }
    }
    __syncthreads();
}

__global__ void __launch_bounds__(NT, 2) mega(P p, int lo, int hi) {
    extern __shared__ __attribute__((aligned(16))) unsigned char smem_raw[];
    float* sm = (float*)smem_raw;
    cg::grid_group grid = cg::this_grid();
    volatile LAS unsigned* xb_st = (volatile LAS unsigned*)(smem_raw + 128 * 1024);
    if (threadIdx.x < 4) xb_st[threadIdx.x] = 0u;
    __syncthreads();
    const XcdBarrier xbar = xcd_barrier_post((unsigned*)(p.ws + WS_BAR), xb_st);
#define GRID_SYNC(k) do { if ((k) == 0) grid.sync(); else xcd_barrier(xbar); } while (0)
#ifdef PROBE_MASK
    unsigned long long tacc_ = 0, t0_ = 0;
    const bool timer_ = (blockIdx.x == 0 && threadIdx.x == 0);
#define STEP(k, body) do { const int k_ = (k); if (lo <= k_ && k_ < hi) { if (timer_) t0_ = __builtin_amdgcn_s_memrealtime(); body; if (k_ + 1 < hi) GRID_SYNC(k_); \
        if (timer_ && ((PROBE_MASK >> (k_ == 0 ? 0 : 1 + (k_ - 1) % 13)) & 1)) tacc_ += __builtin_amdgcn_s_memrealtime() - t0_; } } while (0)
#else
#define STEP(k, body) do { const int k_ = (k); if (lo <= k_ && k_ < hi) { body; if (k_ + 1 < hi) GRID_SYNC(k_); } } while (0)
#endif
    STEP(0, { phase_mod(p, sm); phase_wprep(p, sm); });
#pragma unroll 1
    for (int l = 0; l < 2; ++l) {
        const int s0 = 1 + 13 * l;
        if (l == 0) STEP(s0 + 0, phase_u1prep(p, l, sm));
        STEP(s0 + 1, phase_inproj(p, l, smem_raw));
        STEP(s0 + 2, { phase_conv(p, l, sm); phase_vtrans(p, smem_raw); phase_gatescan(p, l, sm); });
        STEP(s0 + 3, { phase_mlstm(p, l, smem_raw); __syncthreads(); phase_na(p, l, smem_raw); phase_tabprep(p, l, smem_raw); });
        STEP(s0 + 4, phase_combine(p, l));
        STEP(s0 + 5, phase_outproj(p, l, smem_raw));
        STEP(s0 + 6, phase_ln1(p, l));
        STEP(s0 + 7, phase_peerq(p, l, smem_raw));
        STEP(s0 + 8, phase_topk(p, l, smem_raw));
        STEP(s0 + 9, phase_eslice<0>(p, l, smem_raw));
        STEP(s0 + 10, phase_ecoef(p, l));
        STEP(s0 + 11, phase_eslice<1>(p, l, smem_raw));
        STEP(s0 + 12, phase_eln(p, l, sm));
    }
#undef STEP
#ifdef PROBE_MASK
    if (timer_) { const unsigned long long te = __builtin_amdgcn_s_memrealtime(); while (__builtin_amdgcn_s_memrealtime() - te < 8ull * tacc_) __builtin_amdgcn_s_sleep(32); }
#endif
}

extern "C" void kernel_launch(void* const* d_in, const int* in_sizes, int n_in, void* d_out, int out_size, void* d_ws,
                              size_t ws_size, hipStream_t stream) {
    static int grid_blocks = 0;
    if (!grid_blocks) {
        int dev = 0, cus = 0, per_cu = 0;
        hipGetDevice(&dev);
        hipDeviceGetAttribute(&cus, hipDeviceAttributeMultiprocessorCount, dev);
        hipFuncSetAttribute((const void*)mega, hipFuncAttributeMaxDynamicSharedMemorySize, LDS_BYTES);
        hipOccupancyMaxActiveBlocksPerMultiprocessor(&per_cu, (const void*)mega, NT, LDS_BYTES);
        if (per_cu < 1) per_cu = 1;
        grid_blocks = cus * per_cu;
        if (ws_size < WS_END) fprintf(stderr, "kernel_launch: workspace too small: %zu < %zu\n", ws_size, (size_t)WS_END);
    }
    P p{};
    const float** pp = (const float**)&p;
    for (int i = 0; i < 20; ++i) pp[i] = (const float*)d_in[i];
    p.out = (float*)d_out;
    p.ws = (unsigned char*)d_ws;
    hipMemsetAsync((unsigned char*)d_ws + WS_BAR, 0, (WS_CNT - WS_BAR) + 8192, stream);
#if SINGLE_LAUNCH
    int lo = 0, hi = NSTEPS;
    void* args[] = {&p, &lo, &hi};
    hipError_t e = hipLaunchCooperativeKernel((const void*)mega, dim3(grid_blocks), dim3(NT), args, LDS_BYTES, stream);
    if (e != hipSuccess) fprintf(stderr, "cooperative launch failed: %s (grid %d)\n", hipGetErrorString(e), grid_blocks);
#else
    for (int s = 0; s < NSTEPS; ++s) {
        int lo = s, hi = s + 1;
        void* args[] = {&p, &lo, &hi};
        hipError_t e = hipLaunchCooperativeKernel((const void*)mega, dim3(grid_blocks), dim3(NT), args, LDS_BYTES, stream);
        if (e != hipSuccess) fprintf(stderr, "launch %d failed: %s (grid %d)\n", s, hipGetErrorString(e), grid_blocks);
    }
#endif
}
```

```cpp
#include <hip/hip_runtime.h>
#include <hip/hip_cooperative_groups.h>
#include <cstdio>
#include <cstdint>
namespace cg = cooperative_groups;

#ifndef SINGLE_LAUNCH
#define SINGLE_LAUNCH 1
#endif

typedef unsigned short bf16_t;

constexpr int NT = 512;
constexpr int NW = NT / 64;
constexpr int D = 1024, NB = 16, T = 2048, CT = 256;
constexpr int ML = NB * T, MC = NB * CT, M = ML + MC;
constexpr int D_IN = 3088;
constexpr float ALPHA = 1.4142135623730951f;
constexpr float LN_EPS = 1e-5f;
constexpr int NSTEPS = 27;

constexpr size_t SZ_HALF = (size_t)M * 512 * 2;
constexpr size_t WS_MOD   = 0;
constexpr size_t WS_BAR   = 0xE0000;
constexpr size_t WS_XCTX  = 1u << 20;
constexpr size_t WS_R1    = WS_XCTX + (size_t)MC * 1024 * 4;
constexpr size_t WS_QKRAW = WS_R1;
constexpr size_t WS_V     = WS_R1 + 1 * SZ_HALF;
constexpr size_t WS_O     = WS_R1 + 2 * SZ_HALF;
constexpr size_t WS_NQ    = WS_R1 + 3 * SZ_HALF;
constexpr size_t WS_NK    = WS_R1 + 4 * SZ_HALF;
constexpr size_t WS_NV    = WS_R1 + 5 * SZ_HALF;
constexpr size_t WS_Y     = WS_R1;
constexpr size_t WS_Q     = WS_R1 + 2 * SZ_HALF;
constexpr size_t WS_GATES = WS_R1 + 6 * SZ_HALF;
constexpr size_t WS_R3    = WS_GATES + (size_t)M * 16 * 4;
constexpr size_t WS_QKACT = WS_R3;
constexpr size_t WS_HDIR  = WS_R3 + SZ_HALF;
constexpr size_t WS_EIDX  = WS_R3;
constexpr size_t WS_EGATE = WS_R3 + (size_t)M * 128 * 4;
constexpr size_t WS_U2Q   = WS_R3 + SZ_HALF;
constexpr size_t WS_USC   = WS_GATES;
constexpr size_t WS_MIX   = WS_R3 + 3 * SZ_HALF;
constexpr size_t WS_U2    = WS_MIX;
constexpr size_t WS_U1    = WS_MIX;
constexpr size_t WS_WIN   = WS_MIX + 2 * SZ_HALF;
constexpr size_t WS_WOUT  = WS_WIN + (size_t)2 * 3072 * 1024 * 2;
constexpr size_t WS_WQ    = WS_WOUT + (size_t)2 * 1024 * 1024 * 2;
constexpr size_t WS_NVT   = WS_WQ + (size_t)2 * 2048 * 1024 * 2;
constexpr size_t WS_TUP   = WS_NVT + (size_t)128 * 64 * 2304 * 2;
constexpr size_t WS_TDN   = WS_TUP + (size_t)16384 * 1024;
constexpr size_t WS_TSC   = WS_TDN + (size_t)16384 * 1024;
constexpr size_t WS_GSC   = WS_TSC + (size_t)2 * 16384 * 4;
constexpr size_t WS_END   = WS_GSC + (size_t)3 * 128 * 2304 * 4 + (size_t)128 * 36 * 4;

constexpr int LDS_BYTES = 128 * 1024 + 16;

struct P {
    const float *x, *c, *ctx, *c_ctx, *ada_w, *ada_b, *w_in, *b_gate, *conv_w, *ml_norm_w, *na_rpb, *w_out,
                *ln1_w, *ln1_b, *peer_wq, *peer_keys, *peer_up, *peer_down, *ln2_w, *ln2_b;
    float* out;
    unsigned char* ws;
};

typedef short bf16x8 __attribute__((ext_vector_type(8)));
typedef float f32x16 __attribute__((ext_vector_type(16)));
__device__ __forceinline__ bf16_t f2bf(float f) {
    unsigned u = __float_as_uint(f);
    u += 0x7fffu + ((u >> 16) & 1u);
    return (bf16_t)(u >> 16);
}
__device__ __forceinline__ float bf2f(bf16_t h) { return __uint_as_float(((unsigned)h) << 16); }
typedef __bf16 bf16x2v_t __attribute__((ext_vector_type(2)));
typedef float f32x2v_t __attribute__((ext_vector_type(2)));
__device__ __forceinline__ unsigned pk_bf16(float lo, float hi) { const f32x2v_t f = {lo, hi}; return __builtin_bit_cast(unsigned, __builtin_convertvector(f, bf16x2v_t)); }
__device__ __forceinline__ int opaque_tid() { int v = threadIdx.x; asm volatile("" : "+v"(v)); return v; }
__device__ __forceinline__ float wave_sum(float v) {
#pragma unroll
    for (int o = 32; o; o >>= 1) v += __shfl_xor(v, o);
    return v;
}
__device__ __forceinline__ float wave_max(float v) {
#pragma unroll
    for (int o = 32; o; o >>= 1) v = fmaxf(v, __shfl_xor(v, o));
    return v;
}
__device__ __forceinline__ float siluf(float v) { return v / (1.f + expf(-v)); }
__device__ __forceinline__ float sigmoidf(float v) { return 1.f / (1.f + expf(-v)); }
__device__ __forceinline__ float logsigmoidf(float v) { return fminf(v, 0.f) - log1pf(expf(-fabsf(v))); }
__device__ __forceinline__ float gelu_tanh(float v) {
    const float k0 = 0.7978845608028654f;
    return 0.5f * v * (1.f + tanhf(k0 * (v + 0.044715f * v * v * v)));
}
__device__ __forceinline__ int mod_row(int r) { return r < ML ? (r >> 11) : 16; }
__device__ __forceinline__ const float* xrow(const P& p, int l, int r) {
    if (r < ML) return (l == 0 ? p.x : (const float*)p.out) + (size_t)r * D;
    return (l == 0 ? p.ctx : (const float*)(p.ws + WS_XCTX)) + (size_t)(r - ML) * D;
}
__device__ __forceinline__ float* xrow_w(const P& p, int r) {
    if (r < ML) return p.out + (size_t)r * D;
    return (float*)(p.ws + WS_XCTX) + (size_t)(r - ML) * D;
}
__device__ __forceinline__ const float* modp(const P& p, int l, int r) {
    return (const float*)(p.ws + WS_MOD) + (size_t)(l * 17 + mod_row(r)) * 6144;
}

__device__ __forceinline__ float wave_sum16(const float (&v)[16], int lane) {
    const bool b0 = lane & 1, b1 = lane & 2, b2 = lane & 4, b3 = lane & 8;
    float a8[8];
#pragma unroll
    for (int i = 0; i < 8; ++i) { const float lo_ = v[2 * i], hi_ = v[2 * i + 1]; const float keep = b0 ? hi_ : lo_, send = b0 ? lo_ : hi_; a8[i] = keep + __shfl_xor(send, 1); }
    float a4[4];
#pragma unroll
    for (int i = 0; i < 4; ++i) { const float lo_ = a8[2 * i], hi_ = a8[2 * i + 1]; const float keep = b1 ? hi_ : lo_, send = b1 ? lo_ : hi_; a4[i] = keep + __shfl_xor(send, 2); }
    float a2[2];
#pragma unroll
    for (int i = 0; i < 2; ++i) { const float lo_ = a4[2 * i], hi_ = a4[2 * i + 1]; const float keep = b2 ? hi_ : lo_, send = b2 ? lo_ : hi_; a2[i] = keep + __shfl_xor(send, 4); }
    float a1; { const float lo_ = a2[0], hi_ = a2[1]; const float keep = b3 ? hi_ : lo_, send = b3 ? lo_ : hi_; a1 = keep + __shfl_xor(send, 8); }
    a1 += __shfl_xor(a1, 16); a1 += __shfl_xor(a1, 32);
    return a1;
}

__device__ __forceinline__ void phase_mod(const P& p, float* sm) {
    float* mod = (float*)(p.ws + WS_MOD);
    const int tid = opaque_tid();
    {
        float cv[34];
#pragma unroll
        for (int q = 0; q < 34; ++q) { const int i = tid + NT * q; const int mr = i >> 10, k = i & 1023; cv[q] = mr < 16 ? p.c[mr * D + k] : p.c_ctx[k]; }
#pragma unroll
        for (int q = 0; q < 34; ++q) { const int i = tid + NT * q; const int mr = i >> 10, k = i & 1023; sm[mr * 1024 + ((k & 127) << 3) + (k >> 7)] = siluf(cv[q]); }
    }
    __syncthreads();
    const int total = 2 * 6144 * 8;
    for (int i = blockIdx.x * NT + tid; i < total; i += gridDim.x * NT) {
        const int kq = i & 7, col = (i >> 3) % 6144, l = (i >> 3) / 6144;
        const float* w = p.ada_w + (size_t)l * D * 6144 + (size_t)(kq * 128) * 6144 + col;
        float acc[17];
#pragma unroll
        for (int mr = 0; mr < 17; ++mr) acc[mr] = 0.f;
#pragma unroll 1
        for (int k0 = 0; k0 < 128; k0 += 16) {
            float wv[16];
#pragma unroll
            for (int kk = 0; kk < 16; ++kk) wv[kk] = w[(size_t)(k0 + kk) * 6144];
#pragma unroll
            for (int kk = 0; kk < 16; ++kk)
#pragma unroll
                for (int mr = 0; mr < 17; ++mr) acc[mr] += sm[mr * 1024 + (k0 + kk) * 8 + kq] * wv[kk];
        }
        const float bias = p.ada_b[l * 6144 + col];
#pragma unroll
        for (int mr = 0; mr < 17; ++mr) {
            float v = acc[mr];
            v += __shfl_xor(v, 1); v += __shfl_xor(v, 2); v += __shfl_xor(v, 4);
            if (kq == 0) mod[(size_t)(l * 17 + mr) * 6144 + col] = v + bias;
        }
    }
    __syncthreads();
}

namespace pg8 {
#define PG8_LAS __attribute__((address_space(3)))
typedef unsigned short bf16_t;
typedef short bf16x8 __attribute__((ext_vector_type(8)));
typedef float f32x4 __attribute__((ext_vector_type(4)));
typedef unsigned u32x4 __attribute__((ext_vector_type(4)));
constexpr int BM = 256, BK = 64, HALF = 128, HTB = HALF * BK * 2  , STAGE_BYTES = 8 * HTB, NXCD = 8, WGM = 8;

__host__ __device__ __forceinline__ int lds_byte(int r, int c) { const int st = (r >> 4) * 2 + (c >> 5), rr = r & 15, cc = c & 31, ob = rr * 64 + cc * 2; return st * 1024 + (ob ^ (((ob >> 9) & 1) << 5)); }
__host__ __device__ __forceinline__ void stage_rc(int b, int& R, int& C) { const int st = b / 1024, sb = b % 1024, swz = sb ^ (((sb >> 9) & 1) << 5); R = (st >> 1) * 16 + swz / 64; C = (st & 1) * 32 + (swz % 64) / 2; }
__host__ __device__ __forceinline__ int perm32(int rho) { const int n = rho >> 4, i = rho & 15; return 8 * (i >> 2) + 4 * n + (i & 3); }

struct Unit { int pm, pn; };
struct Gemm { const bf16_t* A; const bf16_t* Bt; int M, N, K; };

struct StaticOrder {
    int nM, nN, nwg, G, c;
    __host__ __device__ void init(int M, int N, int G_, int c_) { nM = M / BM; nN = N / BM; nwg = nM * nN; G = G_; c = c_; }
    __host__ __device__ bool next(int i, Unit& u) const {
        const long L = (long)i * G + c; if (L >= nwg) return false;
        int wgid = (int)L; { const int q = nwg / NXCD, r = nwg % NXCD, xcd = wgid % NXCD, off = wgid / NXCD; wgid = (xcd < r ? xcd * (q + 1) : r * (q + 1) + (xcd - r) * q) + off; }
        const int nig = WGM * nN, gid = wgid / nig, fm = gid * WGM, gsz = (nM - fm) < WGM ? (nM - fm) : WGM;
        u.pm = fm + ((wgid % nig) % gsz); u.pn = (wgid % nig) / gsz; return true;
    }
    __device__ __forceinline__ void a_ready(const Unit&) const {}
    __device__ __forceinline__ void done(const Unit&) const {}
};
__device__ __forceinline__ unsigned cvt_pk_bf16(float lo, float hi) { unsigned r; asm volatile("v_cvt_pk_bf16_f32 %0, %1, %2" : "=v"(r) : "v"(lo), "v"(hi)); return r; }
template <int ACT  > struct EpiBf16 {
    static constexpr bool PERM = true, AFTER_DRAIN = false;
    bf16_t* O; int ldc; const float* bias; int split_cols; size_t split_stride;
    __device__ __forceinline__ void operator()(const f32x4 (&acc)[2][2][4][2], const Unit& u, int wr, int wc, int fr, int fq) const {
        const int row0 = u.pm * BM + wr * 64 + fr; int colt = u.pn * BM; bf16_t* base = O;
        if (split_cols) { const int t = colt / split_cols; base += (size_t)t * split_stride; colt -= t * split_cols; }
        const int col0 = colt + wc * 32 + 8 * fq, bcol0 = u.pn * BM + wc * 32 + 8 * fq;
        f32x4 bv[2][2];
#pragma unroll
        for (int bj = 0; bj < 2; ++bj)
#pragma unroll
            for (int n = 0; n < 2; ++n) bv[bj][n] = bias ? *(const f32x4*)(bias + bcol0 + bj * HALF + 4 * n) : (f32x4){0.f, 0.f, 0.f, 0.f};
#pragma unroll
        for (int ai = 0; ai < 2; ++ai)
#pragma unroll
            for (int m = 0; m < 4; ++m) { bf16_t* rowp = base + (size_t)(row0 + ai * HALF + m * 16) * ldc + col0;
#pragma unroll
                for (int bj = 0; bj < 2; ++bj) { f32x4 v0 = acc[ai][bj][m][0] + bv[bj][0], v1 = acc[ai][bj][m][1] + bv[bj][1];
                    u32x4 w; w.x = cvt_pk_bf16(v0[0], v0[1]); w.y = cvt_pk_bf16(v0[2], v0[3]); w.z = cvt_pk_bf16(v1[0], v1[1]); w.w = cvt_pk_bf16(v1[2], v1[3]);
                    *(u32x4*)(rowp + bj * HALF) = w; } }
    }
};
template <class Epi, class Sched, bool STAMP = false>
__device__ __forceinline__ void gemm_phase(PG8_LAS unsigned char* lds, const Gemm g, const Sched& S, const Epi& E, unsigned long long* stamps) {
    const int tid = opaque_tid(), wid = __builtin_amdgcn_readfirstlane(tid >> 6), lane = tid & 63, wr = wid >> 2, wc = wid & 3, fr = lane & 15, fq = lane >> 4;
    const int K = g.K, nt = K / BK;
    int ts_lo = 0, ts_hi = 0, nts = 0; const unsigned long long rt_entry = STAMP ? (unsigned long long)wall_clock64() : 0ull;
#define PG8_STAMP() do { if (STAMP && wid == 0 && nts < 64) { const unsigned long long _c = (unsigned long long)clock64(); \
        ts_lo = (lane == nts) ? (int)(unsigned)_c : ts_lo; ts_hi = (lane == nts) ? (int)(unsigned)(_c >> 32) : ts_hi; ++nts; } } while (0)
    PG8_STAMP();
    unsigned voffA[2], voffB[2];
#pragma unroll
    for (int i = 0; i < 2; ++i) { int R, C; stage_rc(tid * 16 + i * 8192, R, C); const int Rb = Epi::PERM ? ((R & ~31) + perm32(R & 31)) : R;
        voffA[i] = (unsigned)(R * K + C) * 2u; voffB[i] = (unsigned)(Rb * K + C) * 2u; }
    const size_t kstep = (size_t)(BK * 2);
    const size_t hstep = (size_t)HALF * K * 2;
    const size_t tstep = 2 * hstep;
    const unsigned ldsw = (unsigned)wid * 1024u;
    const int aoff = lds_byte(wr * 64 + fr, fq * 8), boff = lds_byte(wc * 32 + fr, fq * 8);
#define PG8_SA(b, h) (((b) * 2 + (h)) * HTB)
#define PG8_SB(b, h) ((4 + (b) * 2 + (h)) * HTB)
#define PG8_STAGE(bufoff, gbase, voff) do { _Pragma("unroll") for (int _i = 0; _i < 2; ++_i) \
        __builtin_amdgcn_global_load_lds((const unsigned*)((const char*)(gbase) + (voff)[_i]), (PG8_LAS unsigned*)(lds + (bufoff) + ldsw + _i * 8192), 16, 0, 0); } while (0)
#define PG8_LDA(dst, b, h) do { _Pragma("unroll") for (int m = 0; m < 4; ++m) _Pragma("unroll") for (int k = 0; k < 2; ++k) dst[m][k] = *(const PG8_LAS bf16x8*)(lds + PG8_SA(b, h) + aoff + m * 2048 + k * 1024); } while (0)
#define PG8_LDB(dst, b, h) do { _Pragma("unroll") for (int n = 0; n < 2; ++n) _Pragma("unroll") for (int k = 0; k < 2; ++k) dst[n][k] = *(const PG8_LAS bf16x8*)(lds + PG8_SB(b, h) + boff + n * 2048 + k * 1024); } while (0)
#define PG8_MMA(ai, bj, At, Bt) do { __builtin_amdgcn_s_setprio(1); _Pragma("unroll") for (int m = 0; m < 4; ++m) _Pragma("unroll") for (int n = 0; n < 2; ++n) _Pragma("unroll") for (int k = 0; k < 2; ++k) \
        acc[ai][bj][m][n] = __builtin_amdgcn_mfma_f32_16x16x32_bf16(Bt[n][k], At[m][k], acc[ai][bj][m][n], 0, 0, 0); __builtin_amdgcn_s_setprio(0); } while (0)
#define PG8_WAIT_V(n) asm volatile("s_waitcnt vmcnt(" #n ")" ::: "memory")
#define PG8_WAIT_L(n) asm volatile("s_waitcnt lgkmcnt(" #n ")" ::: "memory")
#define PG8_BAR __builtin_amdgcn_s_barrier()
#define PG8_SCHED __builtin_amdgcn_sched_barrier(0)
    Unit cur, nxt; int ui = 0;
    if (!S.next(0, cur)) return;
    f32x4 acc[2][2][4][2];
#pragma unroll
    for (int a = 0; a < 2; ++a)
#pragma unroll
        for (int b = 0; b < 2; ++b)
#pragma unroll
            for (int m = 0; m < 4; ++m)
#pragma unroll
                for (int n = 0; n < 2; ++n) acc[a][b][m][n] = (f32x4){0.f, 0.f, 0.f, 0.f};
    bf16x8 At[4][2], B0[2][2], B1[2][2];
    const char* cA = (const char*)g.A + (size_t)cur.pm * tstep; const char* cB = (const char*)g.Bt + (size_t)cur.pn * tstep;
    S.a_ready(cur);
    PG8_STAGE(PG8_SB(0, 0), cB, voffB); PG8_STAGE(PG8_SA(0, 0), cA, voffA); PG8_STAGE(PG8_SB(0, 1), cB + hstep, voffB); PG8_STAGE(PG8_SA(0, 1), cA + hstep, voffA);
    if (wr == 1) PG8_BAR;
    PG8_WAIT_V(4); PG8_BAR;
    PG8_STAGE(PG8_SB(1, 0), cB + kstep, voffB); PG8_STAGE(PG8_SA(1, 0), cA + kstep, voffA); PG8_STAGE(PG8_SB(1, 1), cB + hstep + kstep, voffB);
    PG8_WAIT_V(6); PG8_BAR;
    PG8_STAMP();
    for (;;) {
        const bool has_next = S.next(ui + 1, nxt);
        const char* nA = has_next ? (const char*)g.A + (size_t)nxt.pm * tstep : cA; const char* nB = has_next ? (const char*)g.Bt + (size_t)nxt.pn * tstep : cB;
        for (int t = 0; t < nt; t += 2) {
            const bool last = (t == nt - 2);
            const char* a1 = cA + (size_t)(t + 1) * kstep;
            const char* a2 = last ? nA : cA + (size_t)(t + 2) * kstep; const char* b2 = last ? nB : cB + (size_t)(t + 2) * kstep;
            const char* a3 = a2 + kstep; const char* b3 = b2 + kstep;
            if (last && has_next) S.a_ready(nxt);
            PG8_LDB(B0, 0, 0); PG8_SCHED; PG8_LDA(At, 0, 0); PG8_STAGE(PG8_SA(1, 1), a1 + hstep, voffA);
            PG8_WAIT_L(8); PG8_BAR; PG8_WAIT_L(0); PG8_MMA(0, 0, At, B0); PG8_BAR; PG8_SCHED;
            PG8_LDB(B1, 0, 1); PG8_STAGE(PG8_SB(0, 0), b2, voffB);
            PG8_BAR; PG8_WAIT_L(0); PG8_MMA(0, 1, At, B1); PG8_BAR;
            PG8_LDA(At, 0, 1); PG8_STAGE(PG8_SA(0, 0), a2, voffA);
            PG8_BAR; PG8_WAIT_L(0); PG8_MMA(1, 0, At, B0); PG8_BAR; PG8_SCHED;
            PG8_STAGE(PG8_SB(0, 1), b2 + hstep, voffB);
            PG8_WAIT_V(6); PG8_BAR; PG8_MMA(1, 1, At, B1); PG8_BAR;
            PG8_LDB(B0, 1, 0); PG8_SCHED; PG8_LDA(At, 1, 0); PG8_STAGE(PG8_SA(0, 1), a2 + hstep, voffA);
            PG8_WAIT_L(8); PG8_BAR; PG8_WAIT_L(0); PG8_MMA(0, 0, At, B0); PG8_BAR; PG8_SCHED;
            PG8_LDB(B1, 1, 1); PG8_STAGE(PG8_SB(1, 0), b3, voffB);
            PG8_BAR; PG8_WAIT_L(0); PG8_MMA(0, 1, At, B1); PG8_BAR;
            PG8_LDA(At, 1, 1); PG8_STAGE(PG8_SA(1, 0), a3, voffA);
            PG8_BAR; PG8_WAIT_L(0); PG8_MMA(1, 0, At, B0); PG8_BAR; PG8_SCHED;
            PG8_STAGE(PG8_SB(1, 1), b3 + hstep, voffB);
            PG8_WAIT_V(6); PG8_BAR; PG8_MMA(1, 1, At, B1); PG8_BAR;
        }
        PG8_STAMP();
        if constexpr (!Epi::AFTER_DRAIN) { E(acc, cur, wr, wc, fr, fq); S.done(cur); }
        PG8_STAMP();
        if (!has_next) break;
#pragma unroll
        for (int a = 0; a < 2; ++a)
#pragma unroll
            for (int b = 0; b < 2; ++b)
#pragma unroll
                for (int m = 0; m < 4; ++m)
#pragma unroll
                    for (int n = 0; n < 2; ++n) acc[a][b][m][n] = (f32x4){0.f, 0.f, 0.f, 0.f};
        cur = nxt; cA = nA; cB = nB; ++ui;
    }
    PG8_WAIT_V(0);
    if (wr == 0) PG8_BAR;
    PG8_BAR;
    if constexpr (Epi::AFTER_DRAIN) { E.fused(acc, cur, wr, wc, fr, fq, lds, wid, lane); S.done(cur); }
    PG8_STAMP();
    if (STAMP && wid == 0) { stamps[lane] = lane < nts ? (((unsigned long long)(unsigned)ts_hi << 32) | (unsigned)ts_lo) : 0ull;
        if (lane == 62) stamps[62] = rt_entry; if (lane == 63) stamps[63] = (unsigned long long)wall_clock64(); }
#undef PG8_STAMP
#undef PG8_SA
#undef PG8_SB
#undef PG8_STAGE
#undef PG8_LDA
#undef PG8_LDB
#undef PG8_MMA
#undef PG8_WAIT_V
#undef PG8_WAIT_L
#undef PG8_BAR
#undef PG8_SCHED
}
}


__device__ __forceinline__ void phase_wprep(const P& p, float* sm) {
    const int tid = opaque_tid();
    float (*tl)[65] = (float (*)[65])sm;
    for (int tile = blockIdx.x; tile < 2 * 1536; tile += gridDim.x) {
        const int l = tile / 1536; int t = tile % 1536;
        const float* src; bf16_t* dst; int Nsrc, which;
        if (t < 768) { which = 0; src = p.w_in + (size_t)l * D * D_IN; Nsrc = D_IN; dst = (bf16_t*)(p.ws + WS_WIN) + (size_t)l * 3072 * 1024; }
        else if (t < 1024) { which = 1; t -= 768; src = p.w_out + (size_t)l * D * D; Nsrc = D; dst = (bf16_t*)(p.ws + WS_WOUT) + (size_t)l * 1024 * 1024; }
        else { which = 2; t -= 1024; src = p.peer_wq + (size_t)l * D * 2048; Nsrc = 2048; dst = (bf16_t*)(p.ws + WS_WQ) + (size_t)l * 2048 * 1024; }
        const int tn = t / 16, tk = t % 16;
        {
            const int nn = tid & 63; const int n = tn * 64 + nn;
            const int nsrc = (which == 0 && n >= 1536) ? n + 16 : n;
            const float sc = (which == 0 && n >= 1536 && n < 2048) ? 0.125f : 1.f;
            float v[8];
#pragma unroll
            for (int q = 0; q < 8; ++q) v[q] = src[(size_t)(tk * 64 + (tid >> 6) + 8 * q) * Nsrc + nsrc];
#pragma unroll
            for (int q = 0; q < 8; ++q) tl[(tid >> 6) + 8 * q][nn] = v[q] * sc;
        }
        __syncthreads();
        for (int i = tid; i < 4096; i += NT) {
            const int nn = i >> 6, kk = i & 63;
            dst[(size_t)(tn * 64 + nn) * 1024 + tk * 64 + kk] = f2bf(tl[kk][nn]);
        }
        __syncthreads();
    }
}

__device__ __forceinline__ void phase_u1prep(const P& p, int l, float* sm) {
    bf16_t* u1 = (bf16_t*)(p.ws + WS_U1);
    float* gates = (float*)(p.ws + WS_GATES);
    const int tid_ = opaque_tid(); const int lane = tid_ & 63, wave = tid_ >> 6;
    __syncthreads();
#pragma unroll 1
    for (int i0 = 0; i0 < 16 * 1024; i0 += 16 * NT) {
        float wv[16];
#pragma unroll
        for (int q = 0; q < 16; ++q) { const int i = i0 + tid_ + NT * q; wv[q] = p.w_in[(size_t)l * D * D_IN + (size_t)(i >> 4) * D_IN + 1536 + (i & 15)]; }
#pragma unroll
        for (int q = 0; q < 16; ++q) { const int i = i0 + tid_ + NT * q; sm[(i & 15) * 1024 + (i >> 4)] = wv[q]; }
    }
    __syncthreads();
    for (int r = blockIdx.x * NW + wave; r < M; r += gridDim.x * NW) {
        const float* xr = xrow(p, l, r); const float* mp = modp(p, l, r);
        float u[16];
#pragma unroll
        for (int i = 0; i < 4; ++i) {
            const int k0 = i * 256 + lane * 4;
            const float4 xv = *(const float4*)(xr + k0), sc = *(const float4*)(mp + 1024 + k0), sh = *(const float4*)(mp + k0);
            u[4 * i] = xv.x * (1.f + sc.x) + sh.x; u[4 * i + 1] = xv.y * (1.f + sc.y) + sh.y; u[4 * i + 2] = xv.z * (1.f + sc.z) + sh.z; u[4 * i + 3] = xv.w * (1.f + sc.w) + sh.w;
            uint2 pk; pk.x = pk_bf16(u[4 * i], u[4 * i + 1]); pk.y = pk_bf16(u[4 * i + 2], u[4 * i + 3]);
            *(uint2*)(u1 + (size_t)r * 1024 + k0) = pk;
        }
        float ga[16];
#pragma unroll
        for (int g = 0; g < 16; ++g) ga[g] = 0.f;
#pragma unroll 1
        for (int i = 0; i < 4; ++i) {
            const int k0 = i * 256 + lane * 4;
            const float u0 = i == 0 ? u[0] : i == 1 ? u[4] : i == 2 ? u[8] : u[12], u1v = i == 0 ? u[1] : i == 1 ? u[5] : i == 2 ? u[9] : u[13];
            const float u2v = i == 0 ? u[2] : i == 1 ? u[6] : i == 2 ? u[10] : u[14], u3v = i == 0 ? u[3] : i == 1 ? u[7] : i == 2 ? u[11] : u[15];
#pragma unroll
            for (int g = 0; g < 16; ++g) {
                const float4 w = *(const float4*)(sm + g * 1024 + k0);
                ga[g] += u0 * w.x + u1v * w.y + u2v * w.z + u3v * w.w;
            }
        }
        const float mine = wave_sum16(ga, lane);
        if (lane < 16) gates[(size_t)r * 16 + lane] = mine + p.b_gate[l * 16 + lane];
    }
    __syncthreads();
}

__device__ __forceinline__ size_t nk_frag_off(int bh, int row, int a, int w, int ks, int key4, int fq) {
    return (size_t)(bh * 32 + row) * 4096 + a * 512 + w * 256 + ks * 128 + key4 * 32 + fq * 8;
}
struct EpiInproj {
    static constexpr bool PERM = true, AFTER_DRAIN = false;
    pg8::bf16_t* O; size_t split_stride;
    __device__ __forceinline__ void operator()(const pg8::f32x4 (&acc)[2][2][4][2], const pg8::Unit& u, int wr, int wc, int fr, int fq) const {
        const int row0 = u.pm * pg8::BM + wr * 64 + fr; const int colt0 = u.pn * pg8::BM;
        const int t = colt0 / 512; pg8::bf16_t* base = O + (size_t)t * split_stride; const int colt = colt0 - t * 512;
        const int col0 = colt + wc * 32 + 8 * fq;
        const bool frag = (t == 4) && (u.pm < ML / 256);
#pragma unroll
        for (int ai = 0; ai < 2; ++ai)
#pragma unroll
            for (int m = 0; m < 4; ++m) {
                const int row = row0 + ai * pg8::HALF + m * 16;
#pragma unroll
                for (int bj = 0; bj < 2; ++bj) {
                    const pg8::f32x4 v0 = acc[ai][bj][m][0], v1 = acc[ai][bj][m][1];
                    pg8::u32x4 w; w.x = pg8::cvt_pk_bf16(v0[0], v0[1]); w.y = pg8::cvt_pk_bf16(v0[2], v0[3]); w.z = pg8::cvt_pk_bf16(v1[0], v1[1]); w.w = pg8::cvt_pk_bf16(v1[2], v1[3]);
                    const int c = col0 + bj * pg8::HALF;
                    if (frag) {
                        const int b = row >> 11, tb = row & 2047, h = c >> 6, d = c & 63;
                        const int grow = tb >> 6, gcol = tb & 63;
                        *(pg8::u32x4*)(base + nk_frag_off(b * 8 + h, grow, gcol >> 3, (gcol >> 2) & 1, d >> 5, gcol & 3, (d >> 3) & 3)) = w;
                    } else {
                        *(pg8::u32x4*)(base + (size_t)row * 512 + c) = w;
                    }
                }
            }
    }
};
__device__ __forceinline__ void phase_inproj(const P& p, int l, unsigned char* smraw) {
    pg8::Gemm g{(const pg8::bf16_t*)(p.ws + WS_U1), (const pg8::bf16_t*)(p.ws + WS_WIN) + (size_t)l * 3072 * 1024, M, 3072, 1024};
    pg8::StaticOrder S; S.init(M, 3072, (int)gridDim.x, (int)blockIdx.x);
    EpiInproj E{(pg8::bf16_t*)(p.ws + WS_QKRAW), (size_t)M * 512};
    pg8::gemm_phase<EpiInproj, pg8::StaticOrder, false>((PG8_LAS unsigned char*)smraw, g, S, E, nullptr);
}

__device__ __forceinline__ void phase_conv(const P& p, int l, float* sm) {
    const bf16_t* qkraw = (const bf16_t*)(p.ws + WS_QKRAW);
    bf16_t* qkact = (bf16_t*)(p.ws + WS_QKACT);
    const int tid = opaque_tid();
    float* cw_s = sm;
    float* cs_s = sm + 2560;
    float* sn_s = sm + 2560 + 1024;
    __syncthreads();
    for (int i = tid; i < 2560; i += NT) cw_s[i] = p.conv_w[l * 2560 + i];
    for (int i = tid; i < 1024; i += NT) { const int pos = i >> 4, f = i & 15; const float ang = (float)pos * powf(10000.f, -(float)f / 16.f); cs_s[i] = cosf(ang); sn_s[i] = sinf(ang); }
    __syncthreads();
    const int total = M * 32;
    for (int it = blockIdx.x * NT + tid; it < total; it += gridDim.x * NT) {
        const int r = it >> 5, hq = (it >> 2) & 7, jg = it & 3;
        const int c1 = hq * 64 + jg * 8;
        int base, t, Ts;
        if (r < ML) { base = r & ~2047; t = r & 2047; Ts = T; } else { const int rc = r - ML; base = ML + (rc & ~255); t = rc & 255; Ts = CT; }
        float y1[8], y2[8];
#pragma unroll
        for (int i = 0; i < 8; ++i) { y1[i] = 0.f; y2[i] = 0.f; }
#pragma unroll
        for (int jj = 0; jj < 5; ++jj) {
            const int tt = t + jj - 2;
            if (tt >= 0 && tt < Ts) {
                const bf16_t* rp = qkraw + (size_t)(base + tt) * 512 + c1;
                const uint4 a = *(const uint4*)rp, b = *(const uint4*)(rp + 32);
                const unsigned aw[4] = {a.x, a.y, a.z, a.w}, bw[4] = {b.x, b.y, b.z, b.w};
                const float* w1 = cw_s + jj * 512 + c1; const float* w2 = w1 + 32;
#pragma unroll
                for (int i = 0; i < 4; ++i) {
                    y1[2 * i] += __uint_as_float(aw[i] << 16) * w1[2 * i]; y1[2 * i + 1] += __uint_as_float(aw[i] & 0xffff0000u) * w1[2 * i + 1];
                    y2[2 * i] += __uint_as_float(bw[i] << 16) * w2[2 * i]; y2[2 * i + 1] += __uint_as_float(bw[i] & 0xffff0000u) * w2[2 * i + 1];
                }
            }
        }
        const float ks = hq >= 4 ? 0.125f : 1.f;
        const bool lat = r < ML;
        const int pos = (jg < 2) ? (t >> 6) : (t & 63);
        float o1[8], o2[8];
#pragma unroll
        for (int i = 0; i < 8; ++i) {
            const float a = siluf(y1[i]) * ks, b = siluf(y2[i]) * ks;
            if (lat) { const float cs = cs_s[pos * 16 + ((jg & 1) * 8 + i)], sn = sn_s[pos * 16 + ((jg & 1) * 8 + i)]; o1[i] = a * cs - b * sn; o2[i] = a * sn + b * cs; }
            else { o1[i] = a; o2[i] = b; }
        }
        bf16_t* op = qkact + (size_t)r * 512 + c1;
        *(uint4*)op = make_uint4(pk_bf16(o1[0], o1[1]), pk_bf16(o1[2], o1[3]), pk_bf16(o1[4], o1[5]), pk_bf16(o1[6], o1[7]));
        *(uint4*)(op + 32) = make_uint4(pk_bf16(o2[0], o2[1]), pk_bf16(o2[2], o2[3]), pk_bf16(o2[4], o2[5]), pk_bf16(o2[6], o2[7]));
    }
    __syncthreads();
}

typedef short bf16x4s __attribute__((ext_vector_type(4)));
constexpr int ML_RS = 144;
constexpr int ML_K = 0, ML_WKT = 9216, ML_Q = 18432, ML_VT = 27648, ML_OUT = 46080, ML_ARR = 63488;
__device__ __forceinline__ bf16x8 cvt8(const f32x16& x, int o) {
    union { unsigned u[4]; bf16x8 v; } r;
    r.u[0] = pk_bf16(x[o], x[o + 1]); r.u[1] = pk_bf16(x[o + 2], x[o + 3]); r.u[2] = pk_bf16(x[o + 4], x[o + 5]); r.u[3] = pk_bf16(x[o + 6], x[o + 7]);
    return r.v;
}
__device__ __forceinline__ bf16x8 ld2x4(const unsigned char* p) {
    union { bf16x4s h[2]; bf16x8 v; } r; r.h[0] = *(const bf16x4s*)p; r.h[1] = *(const bf16x4s*)(p + 16); return r.v;
}
__device__ __forceinline__ void lds_barrier() { asm volatile("s_waitcnt lgkmcnt(0)" ::: "memory"); __builtin_amdgcn_s_barrier(); asm volatile("" ::: "memory"); }
__device__ __forceinline__ void phase_gatescan(const P& p, int l, float* sm) {
    const float* gates = (const float*)(p.ws + WS_GATES);
    float* Gs = (float*)(p.ws + WS_GSC); float* PMs = Gs + 128 * 2304; float* Bs = PMs + 128 * 2304; float* MINs = Bs + 128 * 2304;
    const int tid = opaque_tid(); const int lane = tid & 63, wave = tid >> 6;
    float* b63 = sm; float* pm63 = sm + 64;
    for (int item = blockIdx.x; item < NB * 4 * 2; item += gridDim.x) {
        const int dir = item & 1, h = (item >> 1) & 3, b = item >> 3;
        __syncthreads();
        for (int ci = wave; ci < 36; ci += NW) {
            const bool isctx = ci < 4; const int base = isctx ? ML + b * CT : b * T; const int Ts = isctx ? CT : T; const int cl = isctx ? ci : ci - 4;
            const int pos = cl * 64 + lane; const int t = dir ? Ts - 1 - pos : pos;
            const float* gp = gates + (size_t)(base + t) * 16;
            const float li = gp[(2 * dir) * 4 + h], lfx = gp[(2 * dir + 1) * 4 + h];
            float bsum = fminf(lfx, 0.f) - __logf(1.f + __expf(-fabsf(lfx)));
#pragma unroll
            for (int d = 1; d < 64; d <<= 1) { const float tt = __shfl_up(bsum, d); if (lane >= d) bsum += tt; }
            const float g = li - bsum;
            float pm = g;
#pragma unroll
            for (int d = 1; d < 64; d <<= 1) { const float tt = __shfl_up(pm, d); if (lane >= d) pm = fmaxf(pm, tt); }
            const size_t idx = (size_t)item * 2304 + ci * 64 + lane;
            Gs[idx] = g; PMs[idx] = pm; Bs[idx] = bsum;
            if (lane == 63) { b63[ci] = bsum; pm63[ci] = pm; }
        }
        __syncthreads();
        if (tid == 0) {
            float m = 0.f;
            for (int ci = 0; ci < 36; ++ci) { MINs[item * 36 + ci] = m; m = b63[ci] + fmaxf(m, pm63[ci]); }
        }
    }
    __syncthreads();
}

__device__ __forceinline__ bf16x8 ld2x4x(const unsigned char* row, int s, int x) {
    union { bf16x4s h[2]; bf16x8 v; } r; r.h[0] = *(const bf16x4s*)(row + ((s ^ x) * 2)); r.h[1] = *(const bf16x4s*)(row + (((s + 8) ^ x) * 2)); return r.v;
}
__device__ __forceinline__ void phase_mlstm(const P& p, int l, unsigned char* sm) {
    const bool need_ctx = (l == 0);
    const bf16_t* qkact = (const bf16_t*)(p.ws + WS_QKACT);
    const bf16_t* vb = (const bf16_t*)(p.ws + WS_V);
    const float* Gs = (const float*)(p.ws + WS_GSC); const float* PMs = Gs + 128 * 2304; const float* Bs = PMs + 128 * 2304; const float* MINs = Bs + 128 * 2304;
    bf16_t* hdir = (bf16_t*)(p.ws + WS_HDIR);
    const int tid = opaque_tid(); const int lane = tid & 63, wave = tid >> 6, r = lane & 31, hh = lane >> 5;
    const int c = wave & 1, vt = wave >> 1, j = c * 32 + r;
    float* a_g = (float*)(sm + ML_ARR); float* a_M = a_g + 64; float* a_inter = a_M + 64; float* a_edn = a_inter + 64; float* a_n = a_edn + 64;
    const int srow = tid >> 3, part = tid & 7;
    for (int item = blockIdx.x; item < NB * 4 * 2; item += gridDim.x) {
        const int dir = item & 1, h = (item >> 1) & 3, b = item >> 3;
        f32x16 X0, X1;
#pragma unroll
        for (int i = 0; i < 16; ++i) { X0[i] = 0.f; X1[i] = 0.f; }
        __syncthreads();
        if (tid < 128) a_n[tid] = 0.f;
        uint4 pq, pk, pv0, pv1; float pg = 0.f, pgj = 0.f, ppm = 0.f, pb = 0.f, pmin = 0.f, ppm63 = 0.f;
        auto issue = [&](int ci) {
            const bool isctx = ci < 4; const int base = isctx ? ML + b * CT : b * T; const int Ts = isctx ? CT : T; const int cl = isctx ? ci : ci - 4;
            const int pos = cl * 64 + srow; const int t = dir ? Ts - 1 - pos : pos; const size_t ro = (size_t)(base + t) * 512;
            pq = *(const uint4*)(qkact + ro + h * 64 + part * 8); pk = *(const uint4*)(qkact + ro + 256 + h * 64 + part * 8);
            pv0 = *(const uint4*)(vb + ro + h * 128 + part * 16); pv1 = *(const uint4*)(vb + ro + h * 128 + part * 16 + 8);
            const size_t gi = (size_t)item * 2304 + ci * 64;
            pg = Gs[gi + srow]; pmin = MINs[item * 36 + ci]; ppm63 = PMs[gi + 63];
            if (tid < 64) { pgj = Gs[gi + tid]; ppm = PMs[gi + tid]; pb = Bs[gi + tid]; }
        };
        issue(0);
#pragma unroll 1
        for (int ci = 0; ci < 36; ++ci) {
            const bool isctx = ci < 4; const int base = isctx ? ML + b * CT : b * T; const int Ts = isctx ? CT : T; const int cl = isctx ? ci : ci - 4;
            const bool do_out = (!isctx) || need_ctx;
            const int nb = (ci & 1) * 64;
            const float m_in = pmin, M63 = fmaxf(pmin, ppm63);
            const float so = __expf(m_in - M63);
            const float wrow = __expf(pg - M63);
            *(uint4*)(sm + ML_Q + srow * ML_RS + part * 16) = pq;
            *(uint4*)(sm + ML_K + srow * ML_RS + part * 16) = pk;
            {
                const unsigned kw[4] = {pk.x, pk.y, pk.z, pk.w};
                const unsigned w[8] = {pv0.x, pv0.y, pv0.z, pv0.w, pv1.x, pv1.y, pv1.z, pv1.w};
#pragma unroll
                for (int i = 0; i < 4; ++i) {
                    *(bf16_t*)(sm + ML_WKT + (part * 8 + 2 * i) * ML_RS + (srow ^ (8 * part)) * 2) = f2bf(wrow * __uint_as_float(kw[i] << 16));
                    *(bf16_t*)(sm + ML_WKT + (part * 8 + 2 * i + 1) * ML_RS + (srow ^ (8 * part)) * 2) = f2bf(wrow * __uint_as_float(kw[i] & 0xffff0000u));
                }
#pragma unroll
                for (int i = 0; i < 8; ++i) {
                    *(bf16_t*)(sm + ML_VT + (part * 16 + 2 * i) * ML_RS + (srow ^ (8 * part)) * 2) = (bf16_t)(w[i] & 0xffffu);
                    *(bf16_t*)(sm + ML_VT + (part * 16 + 2 * i + 1) * ML_RS + (srow ^ (8 * part)) * 2) = (bf16_t)(w[i] >> 16);
                }
            }
            if (tid < 64) { const float Mv = fmaxf(m_in, ppm); a_g[tid] = pgj; a_M[tid] = Mv; a_inter[tid] = __expf(m_in - Mv); a_edn[tid] = __expf(-(pb + Mv)); }
            if (ci + 1 < 36) issue(ci + 1);
            lds_barrier();
            {
                const float Mjv = a_M[j], interj = a_inter[j];
                float nq;
                {
                    float acc = 0.f;
                    const unsigned char* qr = sm + ML_Q + j * ML_RS + hh * 64;
#pragma unroll
                    for (int k8 = 0; k8 < 4; ++k8) {
                        const uint4 w = *(const uint4*)(qr + k8 * 16);
                        const float4 n0 = *(const float4*)(a_n + nb + hh * 32 + k8 * 8), n1 = *(const float4*)(a_n + nb + hh * 32 + k8 * 8 + 4);
                        acc += n0.x * __uint_as_float(w.x << 16) + n0.y * __uint_as_float(w.x & 0xffff0000u) + n0.z * __uint_as_float(w.y << 16) + n0.w * __uint_as_float(w.y & 0xffff0000u);
                        acc += n1.x * __uint_as_float(w.z << 16) + n1.y * __uint_as_float(w.z & 0xffff0000u) + n1.z * __uint_as_float(w.w << 16) + n1.w * __uint_as_float(w.w & 0xffff0000u);
                    }
                    nq = acc + __shfl_xor(acc, 32);
                }
                {
                    const int k = wave * 8 + (lane >> 3), pc = lane & 7;
                    const uint4 w = *(const uint4*)(sm + ML_WKT + k * ML_RS + pc * 16);
                    float sacc = (__uint_as_float(w.x << 16) + __uint_as_float(w.x & 0xffff0000u)) + (__uint_as_float(w.y << 16) + __uint_as_float(w.y & 0xffff0000u))
                               + (__uint_as_float(w.z << 16) + __uint_as_float(w.z & 0xffff0000u)) + (__uint_as_float(w.w << 16) + __uint_as_float(w.w & 0xffff0000u));
                    sacc += __shfl_xor(sacc, 1); sacc += __shfl_xor(sacc, 2); sacc += __shfl_xor(sacc, 4);
                    if (pc == 0) a_n[(nb ^ 64) + k] = so * a_n[nb + k] + sacc;
                }
                f32x16 st0, st1, n2;
#pragma unroll
                for (int i = 0; i < 16; ++i) { st0[i] = 0.f; st1[i] = 0.f; n2[i] = 0.f; }
                float gs[2][16];
                if (do_out) {
#pragma unroll
                    for (int a = 0; a < 2; ++a)
#pragma unroll
                        for (int i = 0; i < 16; ++i) gs[a][i] = a_g[a * 32 + (i & 3) + 8 * (i >> 2) + 4 * hh];
#pragma unroll
                    for (int ks = 0; ks < 4; ++ks) {
                        const bf16x8 B = *(const bf16x8*)(sm + ML_Q + j * ML_RS + ks * 32 + hh * 16);
                        const bf16x8 A0 = *(const bf16x8*)(sm + ML_K + r * ML_RS + ks * 32 + hh * 16);
                        st0 = __builtin_amdgcn_mfma_f32_32x32x16_bf16(A0, B, st0, 0, 0, 0);
                        if (c == 1) {
                            const bf16x8 A1 = *(const bf16x8*)(sm + ML_K + (32 + r) * ML_RS + ks * 32 + hh * 16);
                            st1 = __builtin_amdgcn_mfma_f32_32x32x16_bf16(A1, B, st1, 0, 0, 0);
                        }
                    }
#pragma unroll
                    for (int s2 = 0; s2 < 2; ++s2) {
                        const bf16x8 B0 = ld2x4(sm + ML_Q + j * ML_RS + (16 * s2 + 4 * hh) * 2);
                        n2 = __builtin_amdgcn_mfma_f32_32x32x16_bf16(cvt8(X0, 8 * s2), B0, n2, 0, 0, 0);
                        const bf16x8 B1 = ld2x4(sm + ML_Q + j * ML_RS + (32 + 16 * s2 + 4 * hh) * 2);
                        n2 = __builtin_amdgcn_mfma_f32_32x32x16_bf16(cvt8(X1, 8 * s2), B1, n2, 0, 0, 0);
                    }
                }
#pragma unroll
                for (int i = 0; i < 16; ++i) { X0[i] *= so; X1[i] *= so; }
#pragma unroll
                for (int ks = 0; ks < 4; ++ks) {
                    const bf16x8 Bv = *(const bf16x8*)(sm + ML_VT + (vt * 32 + r) * ML_RS + (((ks * 16 + hh * 8) ^ (8 * ((2 * vt + (r >> 4)) & 7))) * 2));
                    const bf16x8 A0 = *(const bf16x8*)(sm + ML_WKT + r * ML_RS + (((ks * 16 + hh * 8) ^ (8 * ((r >> 3) & 7))) * 2));
                    X0 = __builtin_amdgcn_mfma_f32_32x32x16_bf16(A0, Bv, X0, 0, 0, 0);
                    const bf16x8 A1 = *(const bf16x8*)(sm + ML_WKT + (32 + r) * ML_RS + (((ks * 16 + hh * 8) ^ (8 * ((4 + (r >> 3)) & 7))) * 2));
                    X1 = __builtin_amdgcn_mfma_f32_32x32x16_bf16(A1, Bv, X1, 0, 0, 0);
                }
                if (do_out) {
                    float dsum = 0.f;
                    bf16x8 pf[2][2];
#pragma unroll
                    for (int i = 0; i < 16; ++i) {
                        const int s = (i & 3) + 8 * (i >> 2) + 4 * hh;
                        const float v = (s <= j) ? st0[i] * __expf(fminf(gs[0][i] - Mjv, 0.f)) : 0.f;
                        st0[i] = v; dsum += v;
                    }
                    pf[0][0] = cvt8(st0, 0); pf[0][1] = cvt8(st0, 8);
                    if (c == 1) {
#pragma unroll
                        for (int i = 0; i < 16; ++i) {
                            const int s = 32 + (i & 3) + 8 * (i >> 2) + 4 * hh;
                            const float v = (s <= j) ? st1[i] * __expf(fminf(gs[1][i] - Mjv, 0.f)) : 0.f;
                            st1[i] = v; dsum += v;
                        }
                        pf[1][0] = cvt8(st1, 0); pf[1][1] = cvt8(st1, 8);
                    }
                    f32x16 n1;
#pragma unroll
                    for (int i = 0; i < 16; ++i) n1[i] = 0.f;
#pragma unroll
                    for (int s2 = 0; s2 < 2; ++s2) {
                        const bf16x8 A = ld2x4x(sm + ML_VT + (vt * 32 + r) * ML_RS, 16 * s2 + 4 * hh, 8 * ((2 * vt + (r >> 4)) & 7));
                        n1 = __builtin_amdgcn_mfma_f32_32x32x16_bf16(A, pf[0][s2], n1, 0, 0, 0);
                    }
                    if (c == 1) {
#pragma unroll
                        for (int s2 = 0; s2 < 2; ++s2) {
                            const bf16x8 A = ld2x4x(sm + ML_VT + (vt * 32 + r) * ML_RS, 32 + 16 * s2 + 4 * hh, 8 * ((2 * vt + (r >> 4)) & 7));
                            n1 = __builtin_amdgcn_mfma_f32_32x32x16_bf16(A, pf[1][s2], n1, 0, 0, 0);
                        }
                    }
                    dsum += __shfl_xor(dsum, 32);
                    const float den = dsum + interj * nq;
                    const float rd = 1.f / fmaxf(fabsf(den), a_edn[j]);
#pragma unroll
                    for (int g4 = 0; g4 < 4; ++g4) {
                        uint2 w;
                        w.x = pk_bf16((n1[4 * g4] + interj * n2[4 * g4]) * rd, (n1[4 * g4 + 1] + interj * n2[4 * g4 + 1]) * rd);
                        w.y = pk_bf16((n1[4 * g4 + 2] + interj * n2[4 * g4 + 2]) * rd, (n1[4 * g4 + 3] + interj * n2[4 * g4 + 3]) * rd);
                        *(uint2*)(sm + ML_OUT + j * 272 + (vt * 32 + 8 * g4 + 4 * hh) * 2) = w;
                    }
                }
            }
            lds_barrier();
            if (do_out) {
                const int pos = cl * 64 + srow; const int t = dir ? Ts - 1 - pos : pos;
                bf16_t* dst = hdir + ((size_t)dir * M + base + t) * 512 + h * 128 + part * 16;
                *(uint4*)dst = *(const uint4*)(sm + ML_OUT + srow * 272 + part * 32);
                *(uint4*)(dst + 8) = *(const uint4*)(sm + ML_OUT + srow * 272 + part * 32 + 16);
            }
        }
    }
}

constexpr size_t NVT_CTX = (size_t)128 * 32 * 4096;
__device__ __forceinline__ void phase_vtrans(const P& p, unsigned char* sm) {
    const bf16_t* nv = (const bf16_t*)(p.ws + WS_NV);
    bf16_t* nvT = (bf16_t*)(p.ws + WS_NVT);
    const int tid = opaque_tid();
    for (int it = blockIdx.x; it < 128 * 36; it += gridDim.x) {
        const int bh = it / 36, tt = it % 36, b = bh >> 3, h = bh & 7;
        const int row0 = tt < 32 ? b * T + tt * 64 : ML + b * CT + (tt - 32) * 64;
        __syncthreads();
        {
            const int tk = tid >> 3, pc = tid & 7;
            const uint4 v = *(const uint4*)(nv + (size_t)(row0 + tk) * 512 + h * 64 + pc * 8);
            const unsigned w[4] = {v.x, v.y, v.z, v.w};
#pragma unroll
            for (int i = 0; i < 4; ++i) {
                *(bf16_t*)(sm + (pc * 8 + 2 * i) * 144 + tk * 2) = (bf16_t)(w[i] & 0xffffu);
                *(bf16_t*)(sm + (pc * 8 + 2 * i + 1) * 144 + tk * 2) = (bf16_t)(w[i] >> 16);
            }
        }
        __syncthreads();
        {
            const int d = tid >> 3, pc = tid & 7;
            const uint4 v8 = *(const uint4*)(sm + d * 144 + pc * 16);
            if (tt < 32) *(uint4*)(nvT + ((size_t)(bh * 32 + tt) * 8 + pc) * 512 + d * 8) = v8;
            else *(uint4*)(nvT + NVT_CTX + ((size_t)bh * 64 + d) * 256 + (tt - 32) * 64 + pc * 8) = v8;
        }
    }
    __syncthreads();
}

typedef float f32x4v __attribute__((ext_vector_type(4)));
constexpr int NA_KC = 0, NA_VC = 36864, NA_RPB = 36864 + 33792, NA_CTL = NA_RPB + 14880;
constexpr size_t WS_CNT = 0xE4000;
__device__ __forceinline__ void phase_na(const P& p, int l, unsigned char* sm) {
    const bool need_ctx = (l == 0);
    const bf16_t* nq = (const bf16_t*)(p.ws + WS_NQ); const bf16_t* nk = (const bf16_t*)(p.ws + WS_NK);
    const bf16_t* nvT = (const bf16_t*)(p.ws + WS_NVT);
    bf16_t* mix = (bf16_t*)(p.ws + WS_MIX);
    unsigned* counter = (unsigned*)(p.ws + WS_CNT) + 16 * l;
    const int tid = opaque_tid(); const int lane = tid & 63, wave = tid >> 6;
    float* rpb_s = (float*)(sm + NA_RPB);
    volatile int* ctl = (volatile int*)(sm + NA_CTL);
    __syncthreads();
    {
        float rv[8];
#pragma unroll
        for (int q = 0; q < 8; ++q) { const int i = tid + NT * q; rv[q] = i < 8 * 465 ? p.na_rpb[(size_t)l * 8 * 465 + i] : 0.f; }
#pragma unroll
        for (int q = 0; q < 8; ++q) { const int i = tid + NT * q; if (i < 8 * 465) rpb_s[i] = rv[q]; }
    }
    for (;;) {
        __syncthreads();
        if (tid == 0) ctl[0] = (int)atomicAdd(counter, 1u);
        __syncthreads();
        const int item = ctl[0];
        const int nitems = need_ctx ? 640 : 512;
        if (item >= nitems) break;
        const bool cq_item = item >= 512;
        const int bh = cq_item ? (item - 512) : (item >> 2), quarter = item & 3, b = bh >> 3, h = bh & 7;
        {
            uint4 kv[4], vv[4];
#pragma unroll
            for (int i = 0; i < 4; ++i) { const int id = tid + NT * i;
                kv[i] = *(const uint4*)(nk + (size_t)(ML + b * CT + (id >> 3)) * 512 + h * 64 + (id & 7) * 8);
                vv[i] = *(const uint4*)(nvT + NVT_CTX + ((size_t)bh * 64 + (id >> 5)) * 256 + (id & 31) * 8); }
#pragma unroll
            for (int i = 0; i < 4; ++i) { const int id = tid + NT * i;
                *(uint4*)(sm + NA_KC + (id >> 3) * 144 + (id & 7) * 16) = kv[i];
                *(uint4*)(sm + NA_VC + (id >> 5) * 528 + (id & 31) * 16) = vv[i]; }
        }
        __syncthreads();
        const int nun = cq_item ? 16 : 32;
        for (int un = wave; un < nun; un += NW) {
            int lane_o = lane; asm volatile("" : "+v"(lane_o));
            const int fr = lane_o & 15, fq = lane_o >> 4, krow_off = 8 * (fr >> 2) + (fr & 3);
            const bool lat = !cq_item;
            int qtok0, r = 0, cb = 0;
            if (lat) { r = quarter * 8 + (un >> 2); cb = un & 3; qtok0 = b * T + r * 64 + cb * 16; }
            else qtok0 = ML + b * CT + un * 16;
            const int r0 = min(max(r - 4, 0), 24);
            const int c0 = min(max(cb * 16 - 8, 0), 32);
            const int qc = cb * 16 + fr;
            const int wl = min(max(qc - 8, 0), 48);
            const bf16_t* qp = nq + (size_t)(qtok0 + fr) * 512 + h * 64 + 8 * fq;
            const bf16x8 qf0 = *(const bf16x8*)qp, qf1 = *(const bf16x8*)(qp + 32);
            float mrun = -1e30f, sum = 0.f;
            f32x4v o[4];
#pragma unroll
            for (int m = 0; m < 4; ++m) o[m] = (f32x4v){0.f, 0.f, 0.f, 0.f};
#define NA_GROUP(S0, S1, VF0, VF1, VF2, VF3) do { \
                float gm_ = fmaxf(fmaxf(fmaxf(S0[0], S0[1]), fmaxf(S0[2], S0[3])), fmaxf(fmaxf(S1[0], S1[1]), fmaxf(S1[2], S1[3]))); \
                gm_ = fmaxf(gm_, __shfl_xor(gm_, 16)); gm_ = fmaxf(gm_, __shfl_xor(gm_, 32)); \
                const float mn_ = fmaxf(mrun, gm_); const float al_ = __expf(mrun - mn_); mrun = mn_; \
                float ps_ = 0.f; \
                _Pragma("unroll") for (int j_ = 0; j_ < 4; ++j_) { S0[j_] = __expf(S0[j_] - mn_); S1[j_] = __expf(S1[j_] - mn_); ps_ += S0[j_] + S1[j_]; } \
                sum = sum * al_ + ps_; \
                _Pragma("unroll") for (int m_ = 0; m_ < 4; ++m_) { o[m_][0] *= al_; o[m_][1] *= al_; o[m_][2] *= al_; o[m_][3] *= al_; } \
                union { unsigned u[4]; bf16x8 v; } pf_; \
                pf_.u[0] = pk_bf16(S0[0], S0[1]); pf_.u[1] = pk_bf16(S0[2], S0[3]); pf_.u[2] = pk_bf16(S1[0], S1[1]); pf_.u[3] = pk_bf16(S1[2], S1[3]); \
                o[0] = __builtin_amdgcn_mfma_f32_16x16x32_bf16(VF0, pf_.v, o[0], 0, 0, 0); o[1] = __builtin_amdgcn_mfma_f32_16x16x32_bf16(VF1, pf_.v, o[1], 0, 0, 0); \
                o[2] = __builtin_amdgcn_mfma_f32_16x16x32_bf16(VF2, pf_.v, o[2], 0, 0, 0); o[3] = __builtin_amdgcn_mfma_f32_16x16x32_bf16(VF3, pf_.v, o[3], 0, 0, 0); } while (0)
            if (lat) {
                const float* rp = rpb_s + h * 465;
                const bf16_t* vbase = nvT + (size_t)(bh * 32 + r0) * 4096 + ((c0 >> 3) + fq) * 512 + fr * 8;
                const bf16_t* kbase = nk + nk_frag_off(bh, r0, (c0 >> 3) + (fr >> 2), 0, 0, fr & 3, fq);
                int dcv[8]; bool okv[8];
#pragma unroll
                for (int j = 0; j < 8; ++j) { const int kc = c0 + 8 * fq + j; okv[j] = (kc >= wl) && (kc < wl + 16); dcv[j] = min(max(kc - qc + 15, 0), 30); }
#define NA_LOADG(K, V, i) do { \
                    const bf16_t* kp_ = kbase + (size_t)(i) * 4096; \
                    K[0] = *(const bf16x8*)kp_; K[1] = *(const bf16x8*)(kp_ + 128); K[2] = *(const bf16x8*)(kp_ + 256); K[3] = *(const bf16x8*)(kp_ + 384); \
                    const bf16_t* vp_ = vbase + (size_t)(i) * 4096; \
                    V[0] = *(const bf16x8*)vp_; V[1] = *(const bf16x8*)(vp_ + 128); V[2] = *(const bf16x8*)(vp_ + 256); V[3] = *(const bf16x8*)(vp_ + 384); \
                    } while (0)
#define NA_COMPG(K, V, i) do { \
                    float BB[8]; const float* rr_ = rp + (r0 + (i) - r + 7) * 31; \
                    _Pragma("unroll") for (int j_ = 0; j_ < 8; ++j_) BB[j_] = rr_[dcv[j_]]; \
                    f32x4v a0_ = {0.f, 0.f, 0.f, 0.f}, a1_ = {0.f, 0.f, 0.f, 0.f}; \
                    a0_ = __builtin_amdgcn_mfma_f32_16x16x32_bf16(K[0], qf0, a0_, 0, 0, 0); a0_ = __builtin_amdgcn_mfma_f32_16x16x32_bf16(K[1], qf1, a0_, 0, 0, 0); \
                    a1_ = __builtin_amdgcn_mfma_f32_16x16x32_bf16(K[2], qf0, a1_, 0, 0, 0); a1_ = __builtin_amdgcn_mfma_f32_16x16x32_bf16(K[3], qf1, a1_, 0, 0, 0); \
                    _Pragma("unroll") for (int j_ = 0; j_ < 4; ++j_) { a0_[j_] = okv[j_] ? a0_[j_] + BB[j_] : -1e30f; a1_[j_] = okv[4 + j_] ? a1_[j_] + BB[4 + j_] : -1e30f; } \
                    NA_GROUP(a0_, a1_, V[0], V[1], V[2], V[3]); } while (0)
                bf16x8 KA[4], VA[4], KB[4], VB[4];
                NA_LOADG(KA, VA, 0);
                NA_LOADG(KB, VB, 1); NA_COMPG(KA, VA, 0);
                NA_LOADG(KA, VA, 2); NA_COMPG(KB, VB, 1);
                NA_LOADG(KB, VB, 3); NA_COMPG(KA, VA, 2);
                NA_LOADG(KA, VA, 4); NA_COMPG(KB, VB, 3);
                NA_LOADG(KB, VB, 5); NA_COMPG(KA, VA, 4);
                NA_LOADG(KA, VA, 6); NA_COMPG(KB, VB, 5);
                NA_LOADG(KB, VB, 7); NA_COMPG(KA, VA, 6);
                NA_COMPG(KB, VB, 7);
#undef NA_LOADG
#undef NA_COMPG
            }
#pragma unroll
            for (int pg = 0; pg < 8; ++pg) {
                const unsigned char* kp = sm + NA_KC + (32 * pg + krow_off) * 144 + 16 * fq;
                const bf16x8 k00 = *(const bf16x8*)kp, k01 = *(const bf16x8*)(kp + 64);
                const bf16x8 k10 = *(const bf16x8*)(kp + 4 * 144), k11 = *(const bf16x8*)(kp + 4 * 144 + 64);
                const unsigned char* vp = sm + NA_VC + fr * 528 + (32 * pg + 8 * fq) * 2;
                const bf16x8 vf0 = *(const bf16x8*)vp, vf1 = *(const bf16x8*)(vp + 16 * 528), vf2 = *(const bf16x8*)(vp + 32 * 528), vf3 = *(const bf16x8*)(vp + 48 * 528);
                f32x4v a0 = {0.f, 0.f, 0.f, 0.f}, a1 = {0.f, 0.f, 0.f, 0.f};
                a0 = __builtin_amdgcn_mfma_f32_16x16x32_bf16(k00, qf0, a0, 0, 0, 0); a0 = __builtin_amdgcn_mfma_f32_16x16x32_bf16(k01, qf1, a0, 0, 0, 0);
                a1 = __builtin_amdgcn_mfma_f32_16x16x32_bf16(k10, qf0, a1, 0, 0, 0); a1 = __builtin_amdgcn_mfma_f32_16x16x32_bf16(k11, qf1, a1, 0, 0, 0);
                NA_GROUP(a0, a1, vf0, vf1, vf2, vf3);
            }
#undef NA_GROUP
            sum += __shfl_xor(sum, 16); sum += __shfl_xor(sum, 32);
            const float rs = 1.f / sum;
            bf16_t* op = mix + (size_t)(qtok0 + fr) * 1024 + 512 + h * 64 + 4 * fq;
#pragma unroll
            for (int m = 0; m < 4; ++m) {
                uint2 w; w.x = pk_bf16(o[m][0] * rs, o[m][1] * rs); w.y = pk_bf16(o[m][2] * rs, o[m][3] * rs);
                *(uint2*)(op + m * 16) = w;
            }
        }
    }
}

__device__ __forceinline__ void phase_combine(const P& p, int l) {
    const bool need_ctx = (l == 0);
    const bf16_t* hdir = (const bf16_t*)(p.ws + WS_HDIR); const bf16_t* ob = (const bf16_t*)(p.ws + WS_O);
    bf16_t* mix = (bf16_t*)(p.ws + WS_MIX);
    const int tid_ = opaque_tid(); const int lane = tid_ & 63, wave = tid_ >> 6;
    const float4 nw0 = *(const float4*)(p.ml_norm_w + l * 512 + lane * 8), nw1 = *(const float4*)(p.ml_norm_w + l * 512 + lane * 8 + 4);
    const float nw[8] = {nw0.x, nw0.y, nw0.z, nw0.w, nw1.x, nw1.y, nw1.z, nw1.w};
    const int rows = need_ctx ? M : ML;
    for (int r = blockIdx.x * NW + wave; r < rows; r += gridDim.x * NW) {
        const size_t o0 = (size_t)r * 512 + lane * 8;
        const uint4 a = *(const uint4*)(hdir + o0), b = *(const uint4*)(hdir + (size_t)M * 512 + o0), og = *(const uint4*)(ob + o0);
        const unsigned aw[4] = {a.x, a.y, a.z, a.w}, bw[4] = {b.x, b.y, b.z, b.w}, gw[4] = {og.x, og.y, og.z, og.w};
        float v[8]; float s = 0.f;
#pragma unroll
        for (int i = 0; i < 4; ++i) {
            v[2 * i] = __uint_as_float(aw[i] << 16) + __uint_as_float(bw[i] << 16);
            v[2 * i + 1] = __uint_as_float(aw[i] & 0xffff0000u) + __uint_as_float(bw[i] & 0xffff0000u);
            s += v[2 * i] + v[2 * i + 1];
        }
        s += __shfl_xor(s, 8); s += __shfl_xor(s, 4); s += __shfl_xor(s, 2); s += __shfl_xor(s, 1);
        const float mu = s * (1.f / 128.f);
        float q = 0.f;
#pragma unroll
        for (int i = 0; i < 8; ++i) { v[i] -= mu; q += v[i] * v[i]; }
        q += __shfl_xor(q, 8); q += __shfl_xor(q, 4); q += __shfl_xor(q, 2); q += __shfl_xor(q, 1);
        const float rstd = rsqrtf(q * (1.f / 128.f) + LN_EPS);
        float o[8];
#pragma unroll
        for (int i = 0; i < 4; ++i) {
            o[2 * i] = v[2 * i] * rstd * nw[2 * i] * sigmoidf(__uint_as_float(gw[i] << 16));
            o[2 * i + 1] = v[2 * i + 1] * rstd * nw[2 * i + 1] * sigmoidf(__uint_as_float(gw[i] & 0xffff0000u));
        }
        *(uint4*)(mix + (size_t)r * 1024 + lane * 8) = make_uint4(pk_bf16(o[0], o[1]), pk_bf16(o[2], o[3]), pk_bf16(o[4], o[5]), pk_bf16(o[6], o[7]));
    }
}

__device__ __forceinline__ void phase_outproj(const P& p, int l, unsigned char* smraw) {
    const int rows = (l == 0) ? M : ML;
    pg8::Gemm g{(const pg8::bf16_t*)(p.ws + WS_MIX), (const pg8::bf16_t*)(p.ws + WS_WOUT) + (size_t)l * 1024 * 1024, rows, 1024, 1024};
    pg8::StaticOrder S; S.init(rows, 1024, (int)gridDim.x, (int)blockIdx.x);
    pg8::EpiBf16<0> E{(pg8::bf16_t*)(p.ws + WS_Y), 1024, nullptr, 0, 0};
    pg8::gemm_phase<pg8::EpiBf16<0>, pg8::StaticOrder, false>((PG8_LAS unsigned char*)smraw, g, S, E, nullptr);
}

__device__ __forceinline__ void phase_ln1(const P& p, int l) {
    const bf16_t* y = (const bf16_t*)(p.ws + WS_Y);
    bf16_t* u2 = (bf16_t*)(p.ws + WS_U2);
    const float* lw = p.ln1_w + l * D; const float* lb = p.ln1_b + l * D;
    const int tid_ = opaque_tid(); const int lane = tid_ & 63, wave = tid_ >> 6;
    const int rows = (l == 0) ? M : ML;
    const int k0 = lane * 16;
    for (int rp = blockIdx.x * NW + wave; rp < rows / 2; rp += gridDim.x * NW) {
        float z[2][16]; float s[2] = {0.f, 0.f};
#pragma unroll
        for (int h = 0; h < 2; ++h) {
            const int r = 2 * rp + h;
            const float* xr = xrow(p, l, r); const float* mp = modp(p, l, r);
            const uint4 ya = *(const uint4*)(y + (size_t)r * 1024 + k0), yb = *(const uint4*)(y + (size_t)r * 1024 + k0 + 8);
            const unsigned yw[8] = {ya.x, ya.y, ya.z, ya.w, yb.x, yb.y, yb.z, yb.w};
#pragma unroll
            for (int v4 = 0; v4 < 4; ++v4) {
                const float4 xv = *(const float4*)(xr + k0 + v4 * 4), g1 = *(const float4*)(mp + 2048 + k0 + v4 * 4);
                z[h][v4 * 4 + 0] = ALPHA * xv.x + g1.x * __uint_as_float(yw[v4 * 2] << 16);
                z[h][v4 * 4 + 1] = ALPHA * xv.y + g1.y * __uint_as_float(yw[v4 * 2] & 0xffff0000u);
                z[h][v4 * 4 + 2] = ALPHA * xv.z + g1.z * __uint_as_float(yw[v4 * 2 + 1] << 16);
                z[h][v4 * 4 + 3] = ALPHA * xv.w + g1.w * __uint_as_float(yw[v4 * 2 + 1] & 0xffff0000u);
                s[h] += (z[h][v4 * 4] + z[h][v4 * 4 + 1]) + (z[h][v4 * 4 + 2] + z[h][v4 * 4 + 3]);
            }
        }
        float mu[2], rstd[2];
#pragma unroll
        for (int h = 0; h < 2; ++h) mu[h] = wave_sum(s[h]) * (1.f / 1024.f);
#pragma unroll
        for (int h = 0; h < 2; ++h) {
            float q = 0.f;
#pragma unroll
            for (int i = 0; i < 16; ++i) { const float d = z[h][i] - mu[h]; q += d * d; }
            rstd[h] = rsqrtf(wave_sum(q) * (1.f / 1024.f) + LN_EPS);
        }
#pragma unroll
        for (int h = 0; h < 2; ++h) {
            const int r = 2 * rp + h;
            const float* mp = modp(p, l, r);
            float* xo = xrow_w(p, r);
            float uo[16]; float am = 0.f;
#pragma unroll
            for (int v4 = 0; v4 < 4; ++v4) {
                const int k = k0 + v4 * 4;
                const float4 w4 = *(const float4*)(lw + k), b4 = *(const float4*)(lb + k), sc = *(const float4*)(mp + 4096 + k), sh = *(const float4*)(mp + 3072 + k);
                float4 o;
                o.x = (z[h][v4 * 4] - mu[h]) * rstd[h] * w4.x + b4.x; o.y = (z[h][v4 * 4 + 1] - mu[h]) * rstd[h] * w4.y + b4.y;
                o.z = (z[h][v4 * 4 + 2] - mu[h]) * rstd[h] * w4.z + b4.z; o.w = (z[h][v4 * 4 + 3] - mu[h]) * rstd[h] * w4.w + b4.w;
                *(float4*)(xo + k) = o;
                uo[v4 * 4] = o.x * (1.f + sc.x) + sh.x; uo[v4 * 4 + 1] = o.y * (1.f + sc.y) + sh.y; uo[v4 * 4 + 2] = o.z * (1.f + sc.z) + sh.z; uo[v4 * 4 + 3] = o.w * (1.f + sc.w) + sh.w;
            }
            bf16_t* up_ = u2 + (size_t)r * 1024 + k0;
            *(uint4*)up_ = make_uint4(pk_bf16(uo[0], uo[1]), pk_bf16(uo[2], uo[3]), pk_bf16(uo[4], uo[5]), pk_bf16(uo[6], uo[7]));
            *(uint4*)(up_ + 8) = make_uint4(pk_bf16(uo[8], uo[9]), pk_bf16(uo[10], uo[11]), pk_bf16(uo[12], uo[13]), pk_bf16(uo[14], uo[15]));
#pragma unroll
            for (int i = 0; i < 16; ++i) am = fmaxf(am, fabsf(uo[i]));
            am = wave_max(am);
            const float inv = am > 0.f ? 127.f / am : 0.f;
            unsigned w[4];
#pragma unroll
            for (int d = 0; d < 4; ++d) {
                unsigned x = 0;
#pragma unroll
                for (int i = 0; i < 4; ++i) x |= (unsigned)(min(max((int)rintf(uo[d * 4 + i] * inv), -127), 127) & 0xff) << (8 * i);
                w[d] = x;
            }
            *(uint4*)(p.ws + WS_U2Q + (size_t)r * 1024 + k0) = make_uint4(w[0], w[1], w[2], w[3]);
            if (lane == 0) ((float*)(p.ws + WS_USC))[r] = am > 0.f ? am / 127.f : 0.f;
        }
    }
}

__device__ __forceinline__ void phase_peerq(const P& p, int l, unsigned char* smraw) {
    const int rows = (l == 0) ? M : ML;
    pg8::Gemm g{(const pg8::bf16_t*)(p.ws + WS_U2), (const pg8::bf16_t*)(p.ws + WS_WQ) + (size_t)l * 2048 * 1024, rows, 2048, 1024};
    pg8::StaticOrder S; S.init(rows, 2048, (int)gridDim.x, (int)blockIdx.x);
    pg8::EpiBf16<0> E{(pg8::bf16_t*)(p.ws + WS_Q), 2048, nullptr, 0, 0};
    pg8::gemm_phase<pg8::EpiBf16<0>, pg8::StaticOrder, false>((PG8_LAS unsigned char*)smraw, g, S, E, nullptr);
}

__device__ __forceinline__ unsigned f2key(float f) { const unsigned u = __float_as_uint(f); return (u & 0x80000000u) ? ~u : (u | 0x80000000u); }
__device__ __forceinline__ float key2f(unsigned k) { const unsigned u = (k & 0x80000000u) ? (k & 0x7fffffffu) : ~k; return __uint_as_float(u); }
__device__ __forceinline__ void ce_desc(unsigned& a, unsigned& b) { const unsigned mx = a > b ? a : b, mn = a > b ? b : a; a = mx; b = mn; }
__device__ __forceinline__ void sort16_desc(unsigned (&a)[16]) {
#pragma unroll
    for (int k = 2; k <= 16; k <<= 1)
#pragma unroll
        for (int j = k >> 1; j > 0; j >>= 1)
#pragma unroll
            for (int i = 0; i < 16; ++i) { const int l = i ^ j; if (l > i) { if ((i & k) == 0) ce_desc(a[i], a[l]); else ce_desc(a[l], a[i]); } }
}
__device__ __forceinline__ void merge16_desc(unsigned (&a)[16], const unsigned (&b)[16]) {
#pragma unroll
    for (int i = 0; i < 16; ++i) a[i] = a[i] > b[15 - i] ? a[i] : b[15 - i];
#pragma unroll
    for (int j = 8; j > 0; j >>= 1)
#pragma unroll
        for (int i = 0; i < 16; ++i) { const int l = i ^ j; if (l > i) ce_desc(a[i], a[l]); }
}
__device__ __forceinline__ void top16_of_acc(const f32x16 (&acc)[4], int hh, unsigned (&out)[16]) {
    unsigned g1[16], g2[16], g3[16];
#pragma unroll
    for (int r = 0; r < 16; ++r) {
        const int nb = (r & 3) + 8 * (r >> 2);
        out[r] = (f2key(acc[0][r]) & ~127u) | (unsigned)(127 - (nb + 4 * hh));
        g1[r]  = (f2key(acc[1][r]) & ~127u) | (unsigned)(127 - (32 + nb + 4 * hh));
        g2[r]  = (f2key(acc[2][r]) & ~127u) | (unsigned)(127 - (64 + nb + 4 * hh));
        g3[r]  = (f2key(acc[3][r]) & ~127u) | (unsigned)(127 - (96 + nb + 4 * hh));
    }
    sort16_desc(out); sort16_desc(g1); sort16_desc(g2); sort16_desc(g3);
    merge16_desc(out, g1); merge16_desc(g2, g3); merge16_desc(out, g2);
#pragma unroll
    for (int i = 0; i < 16; ++i) g1[i] = (unsigned)__shfl_xor((int)out[i], 32);
    merge16_desc(out, g1);
}
constexpr int TK_KEYS_BYTES = 256 * 272;
__device__ __forceinline__ void phase_topk(const P& p, int l, unsigned char* smraw) {
    const bf16_t* q = (const bf16_t*)(p.ws + WS_Q);
    int* eidx = (int*)(p.ws + WS_EIDX); float* egate = (float*)(p.ws + WS_EGATE);
    const int tid = opaque_tid(); const int lane = tid & 63, wave = tid >> 6, tl = lane & 31, hh = lane >> 5;
    unsigned char* keys_lds = smraw;
    unsigned char* slot = smraw + TK_KEYS_BYTES + wave * 2048 + lane * 32;
    const int rows = (l == 0) ? M : ML;
    const int nchunks = rows / 256;
    int cur_h = -1;
    for (int it = blockIdx.x; it < 8 * nchunks; it += gridDim.x) {
        const int h = it & 7, chunk = it >> 3;
        if (h != cur_h) {
            __syncthreads();
            const float* kb = p.peer_keys + (size_t)(l * 8 + h) * 2 * 128 * 128;
            {
                float4 f0[8], f1[8];
#pragma unroll
                for (int q = 0; q < 8; ++q) { const int i = tid + NT * q; const int row = i >> 4, c8 = i & 15;
                    f0[q] = *(const float4*)(kb + (size_t)row * 128 + c8 * 8); f1[q] = *(const float4*)(kb + (size_t)row * 128 + c8 * 8 + 4); }
#pragma unroll
                for (int q = 0; q < 8; ++q) { const int i = tid + NT * q; const int row = i >> 4, c8 = i & 15;
                    uint4 w; w.x = pk_bf16(f0[q].x, f0[q].y); w.y = pk_bf16(f0[q].z, f0[q].w); w.z = pk_bf16(f1[q].x, f1[q].y); w.w = pk_bf16(f1[q].z, f1[q].w);
                    *(uint4*)(keys_lds + row * 272 + c8 * 16) = w; }
            }
            __syncthreads();
            cur_h = h;
        }
        const int t0 = (chunk * 8 + wave) * 32;
        const bf16_t* qrow = q + (size_t)(t0 + tl) * 2048 + h * 256 + 8 * hh;
        unsigned T1[16], T2[16];
#pragma unroll
        for (int half = 0; half < 2; ++half) {
            bf16x8 bq[8];
#pragma unroll
            for (int ks = 0; ks < 8; ++ks) bq[ks] = *(const bf16x8*)(qrow + half * 128 + ks * 16);
            f32x16 acc[4];
#pragma unroll
            for (int mt = 0; mt < 4; ++mt)
#pragma unroll
                for (int r = 0; r < 16; ++r) acc[mt][r] = 0.f;
#pragma unroll
            for (int ks = 0; ks < 8; ++ks)
#pragma unroll
                for (int mt = 0; mt < 4; ++mt) {
                    const bf16x8 a = *(const bf16x8*)(keys_lds + (half * 128 + mt * 32 + tl) * 272 + ks * 32 + 16 * hh);
                    acc[mt] = __builtin_amdgcn_mfma_f32_32x32x16_bf16(a, bq[ks], acc[mt], 0, 0, 0);
                }
            if (half == 0) top16_of_acc(acc, hh, T1); else top16_of_acc(acc, hh, T2);
        }
        {
            uint4 w1, w2;
#define PK4(T, o) ((127u - (T[o] & 127u)) | ((127u - (T[o + 1] & 127u)) << 8) | ((127u - (T[o + 2] & 127u)) << 16) | ((127u - (T[o + 3] & 127u)) << 24))
            w1.x = PK4(T1, 0); w1.y = PK4(T1, 4); w1.z = PK4(T1, 8); w1.w = PK4(T1, 12);
            w2.x = PK4(T2, 0); w2.y = PK4(T2, 4); w2.z = PK4(T2, 8); w2.w = PK4(T2, 12);
#undef PK4
            *(uint4*)slot = w1; *(uint4*)(slot + 16) = w2;
        }
        float v1[16], v2[16];
#pragma unroll
        for (int i = 0; i < 16; ++i) { v1[i] = key2f(T1[i] & ~127u); v2[i] = key2f(T2[i] & ~127u); }
        unsigned cg0[16], cg1[16], cg2[16], cg3[16];
        cg0[0] = (f2key(v1[0] + v2[0]) & ~255u) | 255u;
        cg0[1] = (f2key(v1[0] + v2[1]) & ~255u) | 254u;
        cg0[2] = (f2key(v1[0] + v2[2]) & ~255u) | 253u;
        cg0[3] = (f2key(v1[0] + v2[3]) & ~255u) | 252u;
        cg0[4] = (f2key(v1[0] + v2[4]) & ~255u) | 251u;
        cg0[5] = (f2key(v1[0] + v2[5]) & ~255u) | 250u;
        cg0[6] = (f2key(v1[0] + v2[6]) & ~255u) | 249u;
        cg0[7] = (f2key(v1[0] + v2[7]) & ~255u) | 248u;
        cg0[8] = (f2key(v1[0] + v2[8]) & ~255u) | 247u;
        cg0[9] = (f2key(v1[0] + v2[9]) & ~255u) | 246u;
        cg0[10] = (f2key(v1[0] + v2[10]) & ~255u) | 245u;
        cg0[11] = (f2key(v1[0] + v2[11]) & ~255u) | 244u;
        cg0[12] = (f2key(v1[0] + v2[12]) & ~255u) | 243u;
        cg0[13] = (f2key(v1[0] + v2[13]) & ~255u) | 242u;
        cg0[14] = (f2key(v1[0] + v2[14]) & ~255u) | 241u;
        cg0[15] = (f2key(v1[0] + v2[15]) & ~255u) | 240u;
        cg1[0] = (f2key(v1[1] + v2[0]) & ~255u) | 239u;
        cg1[1] = (f2key(v1[1] + v2[1]) & ~255u) | 238u;
        cg1[2] = (f2key(v1[1] + v2[2]) & ~255u) | 237u;
        cg1[3] = (f2key(v1[1] + v2[3]) & ~255u) | 236u;
        cg1[4] = (f2key(v1[1] + v2[4]) & ~255u) | 235u;
        cg1[5] = (f2key(v1[1] + v2[5]) & ~255u) | 234u;
        cg1[6] = (f2key(v1[1] + v2[6]) & ~255u) | 233u;
        cg1[7] = (f2key(v1[1] + v2[7]) & ~255u) | 232u;
        cg1[8] = (f2key(v1[2] + v2[0]) & ~255u) | 223u;
        cg1[9] = (f2key(v1[2] + v2[1]) & ~255u) | 222u;
        cg1[10] = (f2key(v1[2] + v2[2]) & ~255u) | 221u;
        cg1[11] = (f2key(v1[2] + v2[3]) & ~255u) | 220u;
        cg1[12] = (f2key(v1[2] + v2[4]) & ~255u) | 219u;
        cg1[13] = (f2key(v1[3] + v2[0]) & ~255u) | 207u;
        cg1[14] = (f2key(v1[3] + v2[1]) & ~255u) | 206u;
        cg1[15] = (f2key(v1[3] + v2[2]) & ~255u) | 205u;
        cg2[0] = (f2key(v1[3] + v2[3]) & ~255u) | 204u;
        cg2[1] = (f2key(v1[4] + v2[0]) & ~255u) | 191u;
        cg2[2] = (f2key(v1[4] + v2[1]) & ~255u) | 190u;
        cg2[3] = (f2key(v1[4] + v2[2]) & ~255u) | 189u;
        cg2[4] = (f2key(v1[5] + v2[0]) & ~255u) | 175u;
        cg2[5] = (f2key(v1[5] + v2[1]) & ~255u) | 174u;
        cg2[6] = (f2key(v1[6] + v2[0]) & ~255u) | 159u;
        cg2[7] = (f2key(v1[6] + v2[1]) & ~255u) | 158u;
        cg2[8] = (f2key(v1[7] + v2[0]) & ~255u) | 143u;
        cg2[9] = (f2key(v1[7] + v2[1]) & ~255u) | 142u;
        cg2[10] = (f2key(v1[8] + v2[0]) & ~255u) | 127u;
        cg2[11] = (f2key(v1[9] + v2[0]) & ~255u) | 111u;
        cg2[12] = (f2key(v1[10] + v2[0]) & ~255u) | 95u;
        cg2[13] = (f2key(v1[11] + v2[0]) & ~255u) | 79u;
        cg2[14] = (f2key(v1[12] + v2[0]) & ~255u) | 63u;
        cg2[15] = (f2key(v1[13] + v2[0]) & ~255u) | 47u;
        cg3[0] = (f2key(v1[14] + v2[0]) & ~255u) | 31u;
        cg3[1] = (f2key(v1[15] + v2[0]) & ~255u) | 15u;
        cg3[2] = 0u;
        cg3[3] = 0u;
        cg3[4] = 0u;
        cg3[5] = 0u;
        cg3[6] = 0u;
        cg3[7] = 0u;
        cg3[8] = 0u;
        cg3[9] = 0u;
        cg3[10] = 0u;
        cg3[11] = 0u;
        cg3[12] = 0u;
        cg3[13] = 0u;
        cg3[14] = 0u;
        cg3[15] = 0u;
        sort16_desc(cg0); sort16_desc(cg1); sort16_desc(cg2); sort16_desc(cg3);
        merge16_desc(cg0, cg1); merge16_desc(cg2, cg3); merge16_desc(cg0, cg2);
        const float top0 = key2f(cg0[0] & ~255u);
        float ev[16]; float es = 0.f;
#pragma unroll
        for (int j = 0; j < 16; ++j) { ev[j] = expf(key2f(cg0[j] & ~255u) - top0); es += ev[j]; }
        const float rs = 1.f / es;
        __builtin_amdgcn_wave_barrier();
        int eo[8]; float go[8];
#pragma unroll
        for (int jj = 0; jj < 8; ++jj) {
            const unsigned wlo_ = cg0[jj], whi_ = cg0[jj + 8]; const unsigned w = hh ? whi_ : wlo_;
            const unsigned cid = 255u - (w & 255u);
            const int i1 = slot[cid >> 4], i2 = slot[16 + (cid & 15u)];
            eo[jj] = i1 * 128 + i2;
            const float elo_ = ev[jj], ehi_ = ev[jj + 8]; go[jj] = (hh ? ehi_ : elo_) * rs;
        }
        int* ep = eidx + (size_t)(t0 + tl) * 128 + h * 16 + 8 * hh;
        float* gp = egate + (size_t)(t0 + tl) * 128 + h * 16 + 8 * hh;
        *(int4*)ep = make_int4(eo[0], eo[1], eo[2], eo[3]); *(int4*)(ep + 4) = make_int4(eo[4], eo[5], eo[6], eo[7]);
        *(float4*)gp = make_float4(go[0], go[1], go[2], go[3]); *(float4*)(gp + 4) = make_float4(go[4], go[5], go[6], go[7]);
        __builtin_amdgcn_wave_barrier();
    }
}

__device__ __forceinline__ void phase_tabprep(const P& p, int l, unsigned char* sm) {
    const int tid_ = opaque_tid(); const int lane = tid_ & 63, wave = tid_ >> 6;
    float* sc = (float*)(p.ws + WS_TSC);
    unsigned* counter = (unsigned*)(p.ws + WS_CNT) + 16 * (2 + l);
    volatile int* ctl = (volatile int*)sm;
    for (;;) {
        __syncthreads();
        if (tid_ == 0) ctl[0] = (int)atomicAdd(counter, 1u);
        __syncthreads();
        const int chunk = ctl[0];
        if (chunk >= 512) break;
      for (int jj = 0; jj < 8; ++jj) {
        const int job = chunk * 64 + jj * 8 + wave;
        const int tbl = job >> 14, e = job & 16383;
        const float* src = (tbl ? p.peer_down : p.peer_up) + ((size_t)l * 16384 + e) * 1024 + lane * 16;
        const float4 v0 = *(const float4*)src, v1 = *(const float4*)(src + 4), v2 = *(const float4*)(src + 8), v3 = *(const float4*)(src + 12);
        const float f[16] = {v0.x, v0.y, v0.z, v0.w, v1.x, v1.y, v1.z, v1.w, v2.x, v2.y, v2.z, v2.w, v3.x, v3.y, v3.z, v3.w};
        float am = 0.f;
#pragma unroll
        for (int i = 0; i < 16; ++i) am = fmaxf(am, fabsf(f[i]));
        am = wave_max(am);
        const float inv = am > 0.f ? 127.f / am : 0.f;
        unsigned w[4];
#pragma unroll
        for (int d = 0; d < 4; ++d) {
            unsigned x = 0;
#pragma unroll
            for (int i = 0; i < 4; ++i) { const int q = min(max((int)rintf(f[d * 4 + i] * inv), -127), 127); x |= (unsigned)(q & 0xff) << (8 * i); }
            w[d] = x;
        }
        *(uint4*)(p.ws + (tbl ? WS_TDN : WS_TUP) + (size_t)(lane >> 3) * (16384 * 128) + (size_t)e * 128 + (lane & 7) * 16) = make_uint4(w[0], w[1], w[2], w[3]);
        if (lane == 0) sc[job] = am > 0.f ? am / 127.f : 0.f;
      }
    }
    __syncthreads();
}

constexpr size_t WS_PD = WS_Q;
__device__ __forceinline__ float readlane_f(float v, int l) { return __int_as_float(__builtin_amdgcn_readlane(__float_as_int(v), l)); }
__device__ __forceinline__ float dot16u8(const uint4& w, const float* u, float acc) {
    const unsigned ww[4] = {w.x, w.y, w.z, w.w};
#pragma unroll
    for (int d = 0; d < 4; ++d)
#pragma unroll
        for (int i = 0; i < 4; ++i) acc += u[d * 4 + i] * (float)((ww[d] >> (8 * i)) & 0xffu);
    return acc;
}
__device__ __forceinline__ void fma16u8(float* y, const uint4& w, float a) {
    const unsigned ww[4] = {w.x, w.y, w.z, w.w};
#pragma unroll
    for (int d = 0; d < 4; ++d)
#pragma unroll
        for (int i = 0; i < 4; ++i) y[d * 4 + i] += a * (float)((ww[d] >> (8 * i)) & 0xffu);
}
__device__ __forceinline__ int idot16(const uint4& w, const uint4& u) {
    int a = __builtin_amdgcn_sdot4((int)w.x, (int)u.x, 0, false); a = __builtin_amdgcn_sdot4((int)w.y, (int)u.y, a, false);
    a = __builtin_amdgcn_sdot4((int)w.z, (int)u.z, a, false); return __builtin_amdgcn_sdot4((int)w.w, (int)u.w, a, false);
}
__device__ __forceinline__ void tdot4x4(int* y, const uint4& w0, const uint4& w1, const uint4& w2, const uint4& w3, unsigned cq) {
    const unsigned a0[4] = {w0.x, w0.y, w0.z, w0.w}, a1[4] = {w1.x, w1.y, w1.z, w1.w}, a2[4] = {w2.x, w2.y, w2.z, w2.w}, a3[4] = {w3.x, w3.y, w3.z, w3.w};
#pragma unroll
    for (int r = 0; r < 4; ++r) {
        const unsigned lo01 = __builtin_amdgcn_perm(a1[r], a0[r], 0x05010400u), hi01 = __builtin_amdgcn_perm(a1[r], a0[r], 0x07030602u);
        const unsigned lo23 = __builtin_amdgcn_perm(a3[r], a2[r], 0x05010400u), hi23 = __builtin_amdgcn_perm(a3[r], a2[r], 0x07030602u);
        const unsigned c0 = __builtin_amdgcn_perm(lo23, lo01, 0x05040100u), c1 = __builtin_amdgcn_perm(lo23, lo01, 0x07060302u);
        const unsigned c2 = __builtin_amdgcn_perm(hi23, hi01, 0x05040100u), c3 = __builtin_amdgcn_perm(hi23, hi01, 0x07060302u);
        y[4 * r + 0] = __builtin_amdgcn_sdot4((int)c0, (int)cq, y[4 * r + 0], false);
        y[4 * r + 1] = __builtin_amdgcn_sdot4((int)c1, (int)cq, y[4 * r + 1], false);
        y[4 * r + 2] = __builtin_amdgcn_sdot4((int)c2, (int)cq, y[4 * r + 2], false);
        y[4 * r + 3] = __builtin_amdgcn_sdot4((int)c3, (int)cq, y[4 * r + 3], false);
    }
}
__device__ __forceinline__ unsigned my_xcc() { return (unsigned)__builtin_amdgcn_s_getreg((3 << 11) | 20) & 7u; }

template <int PH>
__device__ __forceinline__ void phase_eslice(const P& p, int l, unsigned char* sm) {
    const bf16_t* u2 = (const bf16_t*)(p.ws + WS_U2);
    const int* eidx = (const int*)(p.ws + WS_EIDX); const float* coefp = (const float*)(p.ws + WS_EGATE);
    const unsigned char* tab = p.ws + (PH == 0 ? WS_TUP : WS_TDN);
    float* pd = (float*)(p.ws + WS_PD);
    unsigned* cnts = (unsigned*)(p.ws + WS_CNT + 256) + (size_t)((l * 2 + PH) * 8) * 16;
    const int tid = opaque_tid(); const int lane = tid & 63, wave = tid >> 6;
    volatile int* ctl = (volatile int*)sm;
    const int rows = (l == 0) ? M : ML;
    const int nchunks = rows / 128;
    const unsigned xcc = my_xcc();
    for (int att = 0; att < 8; ++att) {
        const int slice = (int)((xcc + (unsigned)att) & 7u);
        for (;;) {
            __syncthreads();
            if (tid == 0) ctl[0] = (int)atomicAdd(cnts + slice * 16, 1u);
            __syncthreads();
            const int chunk = ctl[0];
            if (chunk >= nchunks) break;
            int lane_o = lane; asm volatile("" : "+v"(lane_o));
            const int sub = lane_o & 7, g = lane_o >> 3;
            const int t0 = chunk * 128 + wave * 16;
            const unsigned char* tsl = tab + (size_t)slice * (16384 * 128) + sub * 16;
#define LD_EV(dst, tok) do { const int4* ep_ = (const int4*)(eidx + (size_t)(tok) * 128 + 16 * g); dst[0] = ep_[0]; dst[1] = ep_[1]; dst[2] = ep_[2]; dst[3] = ep_[3]; } while (0)
#define GATHER(dst, ev) do { _Pragma("unroll") for (int q_ = 0; q_ < 4; ++q_) { \
            dst[4 * q_ + 0] = *(const uint4*)(tsl + (size_t)ev[q_].x * 128); dst[4 * q_ + 1] = *(const uint4*)(tsl + (size_t)ev[q_].y * 128); \
            dst[4 * q_ + 2] = *(const uint4*)(tsl + (size_t)ev[q_].z * 128); dst[4 * q_ + 3] = *(const uint4*)(tsl + (size_t)ev[q_].w * 128); } } while (0)
#define LD_SMALL(dst, tok) do { if (PH == 0) { dst[0] = *(const uint4*)(p.ws + WS_U2Q + (size_t)(tok) * 1024 + slice * 128 + sub * 16); } \
            else { const unsigned char* rb_ = (const unsigned char*)(coefp + (size_t)(tok) * 128); dst[0] = *(const uint4*)(rb_ + 16 * g); dst[1].x = *(const unsigned*)(rb_ + 128); \
                   const float2 xq_ = *(const float2*)(xrow_w(p, (tok)) + ocol), gq_ = *(const float2*)(modp(p, l, (tok)) + 5120 + ocol); \
                   dst[2].x = __float_as_uint(xq_.x); dst[2].y = __float_as_uint(xq_.y); dst[2].z = __float_as_uint(gq_.x); dst[2].w = __float_as_uint(gq_.y); } } while (0)
            const int ocol = slice * 128 + sub * 16 + ((lane_o & 32) ? 8 : 0) + ((lane_o & 16) ? 4 : 0) + ((lane_o & 8) ? 2 : 0);
            auto compute = [&](const uint4 (&W)[16], const uint4 (&smx)[3], const int t) {
                if (PH == 0) {
                    float acc[16];
#pragma unroll
                    for (int b = 0; b < 16; ++b) acc[b] = (float)idot16(W[b], smx[0]);
                    const bool s4 = sub & 4, s2 = sub & 2, s1 = sub & 1;
                    float d8[8];
#pragma unroll
                    for (int i = 0; i < 8; ++i) { const float lo_ = acc[i], hi_ = acc[i + 8]; const float keep = s4 ? hi_ : lo_, send = s4 ? lo_ : hi_; d8[i] = keep + __shfl_xor(send, 4); }
                    float d4[4];
#pragma unroll
                    for (int i = 0; i < 4; ++i) { const float lo_ = d8[i], hi_ = d8[i + 4]; const float keep = s2 ? hi_ : lo_, send = s2 ? lo_ : hi_; d4[i] = keep + __shfl_xor(send, 2); }
                    float d2[2];
#pragma unroll
                    for (int i = 0; i < 2; ++i) { const float lo_ = d4[i], hi_ = d4[i + 2]; const float keep = s1 ? hi_ : lo_, send = s1 ? lo_ : hi_; d2[i] = keep + __shfl_xor(send, 1); }
                    const int b0 = (s4 ? 8 : 0) + (s2 ? 4 : 0) + (s1 ? 2 : 0);
                    *(float2*)(pd + ((size_t)slice * rows + t) * 128 + 16 * g + b0) = make_float2(d2[0], d2[1]);
                } else {
                    int yi[16];
#pragma unroll
                    for (int i = 0; i < 16; ++i) yi[i] = 0;
                    const unsigned cq[4] = {smx[0].x, smx[0].y, smx[0].z, smx[0].w};
                    const float csc = __uint_as_float(smx[1].x);
                    tdot4x4(yi, W[0], W[1], W[2], W[3], cq[0]); tdot4x4(yi, W[4], W[5], W[6], W[7], cq[1]);
                    tdot4x4(yi, W[8], W[9], W[10], W[11], cq[2]); tdot4x4(yi, W[12], W[13], W[14], W[15], cq[3]);
                    const bool h32 = lane_o & 32, h16 = lane_o & 16, h8 = lane_o & 8;
                    int y8[8];
#pragma unroll
                    for (int i = 0; i < 8; ++i) { const int lo_ = yi[i], hi_ = yi[i + 8]; const int keep = h32 ? hi_ : lo_, send = h32 ? lo_ : hi_; y8[i] = keep + __shfl_xor(send, 32); }
                    int y4[4];
#pragma unroll
                    for (int i = 0; i < 4; ++i) { const int lo_ = y8[i], hi_ = y8[i + 4]; const int keep = h16 ? hi_ : lo_, send = h16 ? lo_ : hi_; y4[i] = keep + __shfl_xor(send, 16); }
                    int y2[2];
#pragma unroll
                    for (int i = 0; i < 2; ++i) { const int lo_ = y4[i], hi_ = y4[i + 2]; const int keep = h8 ? hi_ : lo_, send = h8 ? lo_ : hi_; y2[i] = keep + __shfl_xor(send, 8); }
                    float2 z; z.x = ALPHA * __uint_as_float(smx[2].x) + __uint_as_float(smx[2].z) * ((float)y2[0] * csc); z.y = ALPHA * __uint_as_float(smx[2].y) + __uint_as_float(smx[2].w) * ((float)y2[1] * csc);
                    *(float2*)(xrow_w(p, t) + ocol) = z;
                }
            };
            int4 ev0[4], ev1[4];
            uint4 WA[16], WB[16];
            uint4 sm0[3], sm1[3];
            sm0[1] = make_uint4(0, 0, 0, 0); sm1[1] = make_uint4(0, 0, 0, 0); sm0[2] = make_uint4(0, 0, 0, 0); sm1[2] = make_uint4(0, 0, 0, 0);
            LD_EV(ev0, t0); LD_EV(ev1, t0 + 1);
            LD_SMALL(sm0, t0); LD_SMALL(sm1, t0 + 1);
            GATHER(WA, ev0);
            LD_EV(ev0, t0 + 2);
#pragma unroll 1
            for (int tk = 0; tk < 16; tk += 2) {
                const int t = t0 + tk;
                GATHER(WB, ev1);
                if (tk + 3 < 16) LD_EV(ev1, t + 3);
                compute(WA, sm0, t);
                if (tk + 2 < 16) { LD_SMALL(sm0, t + 2); GATHER(WA, ev0); }
                if (tk + 4 < 16) LD_EV(ev0, t + 4);
                compute(WB, sm1, t + 1);
                if (tk + 3 < 16) LD_SMALL(sm1, t + 3);
            }
#undef LD_EV
#undef GATHER
#undef LD_SMALL
        }
    }
    __syncthreads();
}

__device__ __forceinline__ void phase_ecoef(const P& p, int l) {
    const int* eidx = (const int*)(p.ws + WS_EIDX); float* egate = (float*)(p.ws + WS_EGATE);
    const float* pd = (const float*)(p.ws + WS_PD);
    const float* scu = (const float*)(p.ws + WS_TSC); const float* scd = scu + 16384;
    const int tid_ = opaque_tid(); const int lane = tid_ & 63, wave = tid_ >> 6, hl = lane & 31;
    const int rows = (l == 0) ? M : ML;
    for (int rp = blockIdx.x * NW + wave; rp < rows / 2; rp += gridDim.x * NW) {
        const int r = 2 * rp + (lane >> 5);
        const float usc = ((const float*)(p.ws + WS_USC))[r];
        float4 d = {0.f, 0.f, 0.f, 0.f};
#pragma unroll
        for (int x = 0; x < 8; ++x) { const float4 v = *(const float4*)(pd + ((size_t)x * rows + r) * 128 + 4 * hl); d.x += v.x; d.y += v.y; d.z += v.z; d.w += v.w; }
        const int4 e = *(const int4*)(eidx + (size_t)r * 128 + 4 * hl);
        const float4 g = *(const float4*)(egate + (size_t)r * 128 + 4 * hl);
        float cf[4];
        cf[0] = g.x * scd[e.x] * gelu_tanh(scu[e.x] * usc * d.x); cf[1] = g.y * scd[e.y] * gelu_tanh(scu[e.y] * usc * d.y);
        cf[2] = g.z * scd[e.z] * gelu_tanh(scu[e.z] * usc * d.z); cf[3] = g.w * scd[e.w] * gelu_tanh(scu[e.w] * usc * d.w);
        float am = fmaxf(fmaxf(fabsf(cf[0]), fabsf(cf[1])), fmaxf(fabsf(cf[2]), fabsf(cf[3])));
        am = fmaxf(am, __shfl_xor(am, 16)); am = fmaxf(am, __shfl_xor(am, 8)); am = fmaxf(am, __shfl_xor(am, 4)); am = fmaxf(am, __shfl_xor(am, 2)); am = fmaxf(am, __shfl_xor(am, 1));
        const float inv = am > 0.f ? 127.f / am : 0.f;
        unsigned w = 0;
#pragma unroll
        for (int i = 0; i < 4; ++i) w |= (unsigned)(min(max((int)rintf(cf[i] * inv), -127), 127) & 0xff) << (8 * i);
        unsigned char* rowb = (unsigned char*)(egate + (size_t)r * 128);
        __builtin_amdgcn_wave_barrier();
        *(unsigned*)(rowb + 4 * hl) = w;
        if (hl == 0) *(float*)(rowb + 128) = am > 0.f ? am / 127.f : 0.f;
    }
}

__device__ __forceinline__ void phase_eln(const P& p, int l, float* sm) {
    const float* lw = p.ln2_w + l * D; const float* lb = p.ln2_b + l * D;
    const int tid_ = opaque_tid(); const int lane = tid_ & 63, wave = tid_ >> 6;
    const int rows = (l == 0) ? M : ML;
    const bool nxt = (l == 0);
    bf16_t* u1 = (bf16_t*)(p.ws + WS_U1);
    float* gates = (float*)(p.ws + WS_GATES);
    if (nxt) {
        __syncthreads();
#pragma unroll 1
        for (int i0 = 0; i0 < 16 * 1024; i0 += 16 * NT) {
            float wv[16];
#pragma unroll
            for (int q = 0; q < 16; ++q) { const int i = i0 + tid_ + NT * q; wv[q] = p.w_in[(size_t)(l + 1) * D * D_IN + (size_t)(i >> 4) * D_IN + 1536 + (i & 15)]; }
#pragma unroll
            for (int q = 0; q < 16; ++q) { const int i = i0 + tid_ + NT * q; sm[(i & 15) * 1024 + (i >> 4)] = wv[q]; }
        }
        __syncthreads();
    }
    for (int r = blockIdx.x * NW + wave; r < rows; r += gridDim.x * NW) {
        float* xo = xrow_w(p, r);
        const int k0 = lane * 16;
        float z[16]; float s = 0.f;
#pragma unroll
        for (int v4 = 0; v4 < 4; ++v4) {
            const float4 v = *(const float4*)(xo + k0 + v4 * 4);
            z[v4 * 4] = v.x; z[v4 * 4 + 1] = v.y; z[v4 * 4 + 2] = v.z; z[v4 * 4 + 3] = v.w;
            s += (v.x + v.y) + (v.z + v.w);
        }
        const float mu = wave_sum(s) * (1.f / 1024.f);
        float q = 0.f;
#pragma unroll
        for (int i = 0; i < 16; ++i) { const float d = z[i] - mu; q += d * d; }
        const float rstd = rsqrtf(wave_sum(q) * (1.f / 1024.f) + LN_EPS);
#pragma unroll
        for (int v4 = 0; v4 < 4; ++v4) {
            const int k = k0 + v4 * 4;
            const float4 w4 = *(const float4*)(lw + k), b4 = *(const float4*)(lb + k);
            float4 o;
            o.x = (z[v4 * 4] - mu) * rstd * w4.x + b4.x; o.y = (z[v4 * 4 + 1] - mu) * rstd * w4.y + b4.y;
            o.z = (z[v4 * 4 + 2] - mu) * rstd * w4.z + b4.z; o.w = (z[v4 * 4 + 3] - mu) * rstd * w4.w + b4.w;
            *(float4*)(xo + k) = o;
            z[v4 * 4] = o.x; z[v4 * 4 + 1] = o.y; z[v4 * 4 + 2] = o.z; z[v4 * 4 + 3] = o.w;
        }
        if (nxt) {
            const float* mp = modp(p, l + 1, r);
            float u[16];
#pragma unroll
            for (int v4 = 0; v4 < 4; ++v4) {
                const int k = k0 + v4 * 4;
                const float4 sc = *(const float4*)(mp + 1024 + k), sh = *(const float4*)(mp + k);
                u[v4 * 4] = z[v4 * 4] * (1.f + sc.x) + sh.x; u[v4 * 4 + 1] = z[v4 * 4 + 1] * (1.f + sc.y) + sh.y;
                u[v4 * 4 + 2] = z[v4 * 4 + 2] * (1.f + sc.z) + sh.z; u[v4 * 4 + 3] = z[v4 * 4 + 3] * (1.f + sc.w) + sh.w;
                uint2 pk; pk.x = pk_bf16(u[v4 * 4], u[v4 * 4 + 1]); pk.y = pk_bf16(u[v4 * 4 + 2], u[v4 * 4 + 3]);
                *(uint2*)(u1 + (size_t)r * 1024 + k) = pk;
            }
            float ga[16];
#pragma unroll
            for (int g = 0; g < 16; ++g) ga[g] = 0.f;
#pragma unroll 1
            for (int v4 = 0; v4 < 4; ++v4) {
                const int k = k0 + v4 * 4;
                const float u0 = v4 == 0 ? u[0] : v4 == 1 ? u[4] : v4 == 2 ? u[8] : u[12], u1v = v4 == 0 ? u[1] : v4 == 1 ? u[5] : v4 == 2 ? u[9] : u[13];
                const float u2v = v4 == 0 ? u[2] : v4 == 1 ? u[6] : v4 == 2 ? u[10] : u[14], u3v = v4 == 0 ? u[3] : v4 == 1 ? u[7] : v4 == 2 ? u[11] : u[15];
#pragma unroll
                for (int g = 0; g < 16; ++g) {
                    const float4 w = *(const float4*)(sm + g * 1024 + k);
                    ga[g] += u0 * w.x + u1v * w.y + u2v * w.z + u3v * w.w;
                }
            }
            const float mine = wave_sum16(ga, lane);
            if (lane < 16) gates[(size_t)r * 16 + lane] = mine + p.b_gate[(l + 1) * 16 + lane];
        }
    }
    __syncthreads();
}

#define XB_TMO      128
#define XB_XCNT(j)  (256  + 64 * (j))
#define XB_XSUB(j)  (1280 + 64 * (j))
#define XB_XGEN(j)  (2304 + 64 * (j))
#define XB_TOP      3328
#define XB_TOPGEN   3392
#define XCD_BAR_WORDS 3456
#define XB_SPIN_CAP (1u << 18)
#define LAS __attribute__((address_space(3)))

__device__ __forceinline__ unsigned xb_ld(unsigned* p)              { return __hip_atomic_load(p, __ATOMIC_RELAXED, __HIP_MEMORY_SCOPE_AGENT); }
__device__ __forceinline__ unsigned xb_add(unsigned* p, unsigned v) { return __hip_atomic_fetch_add(p, v, __ATOMIC_RELAXED, __HIP_MEMORY_SCOPE_AGENT); }
__device__ __forceinline__ unsigned xb_xcc_id() { return (unsigned)__builtin_amdgcn_s_getreg((3 << 11) | 20) & 0xFu; }
#define XB_SPIN(cond, bar) do { unsigned _sp = 0; while (cond) { __builtin_amdgcn_s_sleep(1); \
    if ((++_sp & 255u) == 0u) { if (xb_ld(&(bar)[XB_TMO])) break; if (_sp > XB_SPIN_CAP) { atomicAdd(&(bar)[XB_TMO], 1u); break; } } } } while (0)

struct XcdBarrier {
    unsigned* bar; unsigned x;
    volatile LAS unsigned* st;
};

__device__ __forceinline__ XcdBarrier xcd_barrier_post(unsigned* bar, volatile LAS unsigned* st) {
    XcdBarrier b; b.bar = bar; b.x = xb_xcc_id(); b.st = st;
    if (threadIdx.x == 0) (void)xb_add(&bar[XB_XCNT(b.x)], 1u);
    return b;
}
__device__ __forceinline__ void xcd_barrier_complete(unsigned* bar, unsigned x, unsigned& nloc, unsigned& nx) {
    const unsigned G = gridDim.x * gridDim.y * gridDim.z;
    unsigned sum, cnt, mine, sp = 0u;
    for (;;) {
        sum = 0u; cnt = 0u; mine = 0u;
#pragma unroll
        for (unsigned j = 0; j < 16; ++j) { const unsigned c = xb_ld(&bar[XB_XCNT(j)]); sum += c; cnt += (c > 0u) ? 1u : 0u; mine = (j == x) ? c : mine; }
        if (sum == G) break;
        __builtin_amdgcn_s_sleep(1);
        if ((++sp & 255u) == 0u) { if (xb_ld(&bar[XB_TMO])) break; if (sp > XB_SPIN_CAP) { atomicAdd(&bar[XB_TMO], 1u); break; } }
    }
    nloc = mine > 0u ? mine : 1u; nx = cnt > 0u ? cnt : 1u;
}

__device__ __forceinline__ void xcd_barrier(const XcdBarrier& b) {
    asm volatile("s_waitcnt vmcnt(0)" ::: "memory");
    __syncthreads();
    if (threadIdx.x == 0) {
        unsigned* bar = b.bar;
        __builtin_amdgcn_s_waitcnt(0);
        unsigned nloc = b.st[0], nx = b.st[1];
        if (nloc == 0u) { xcd_barrier_complete(bar, b.x, nloc, nx); b.st[0] = nloc; b.st[1] = nx; }
        const unsigned old = xb_add(&bar[XB_XSUB(b.x)], 1u);
        const unsigned gen = old / nloc;
        if (old + 1u == (gen + 1u) * nloc) {
            __builtin_amdgcn_fence(__ATOMIC_RELEASE, "agent");
            asm volatile("s_waitcnt vmcnt(0)" ::: "memory");
            const unsigned og = xb_add(&bar[XB_TOP], 1u);
            const unsigned tg = og / nx;
            if (og + 1u == (tg + 1u) * nx) xb_add(&bar[XB_TOPGEN], 1u);
            else XB_SPIN(xb_ld(&bar[XB_TOPGEN]) == tg, bar);
            __builtin_amdgcn_fence(__ATOMIC_ACQUIRE, "agent");
            xb_add(&bar[XB_XGEN(b.x)], 1u);
            asm volatile("s_waitcnt vmcnt(0)" ::: "memory");
        } else {
            XB_SPIN(xb_ld(&bar[XB_XGEN(b.x)]) == gen, bar);
            __builtin_amdgcn_fence(__ATOMIC_ACQUIRE, "agent");
            asm volatile("s_waitcnt vmcnt(0)" ::: "memory");
        }
    }
    __syncthreads();
}

__global__ void __launch_bounds__(NT, 2) mega(P p, int lo, int hi) {
    extern __shared__ __attribute__((aligned(16))) unsigned char smem_raw[];
    float* sm = (float*)smem_raw;
    cg::grid_group grid = cg::this_grid();
    volatile LAS unsigned* xb_st = (volatile LAS unsigned*)(smem_raw + 128 * 1024);
    if (threadIdx.x < 4) xb_st[threadIdx.x] = 0u;
    __syncthreads();
    const XcdBarrier xbar = xcd_barrier_post((unsigned*)(p.ws + WS_BAR), xb_st);
#define GRID_SYNC(k) do { if ((k) == 0) grid.sync(); else xcd_barrier(xbar); } while (0)
#ifdef PROBE_MASK
    unsigned tacc_ = 0, t0_ = 0;
    const bool timer_ = (blockIdx.x == 0);
#define STEP(k, body) do { const int k_ = (k); if (lo <= k_ && k_ < hi) { if (timer_) t0_ = (unsigned)__builtin_amdgcn_s_memrealtime(); body; if (k_ + 1 < hi) GRID_SYNC(k_); \
        if (timer_ && ((PROBE_MASK >> (k_ == 0 ? 0 : 1 + (k_ - 1) % 13)) & 1)) tacc_ += (unsigned)__builtin_amdgcn_s_memrealtime() - t0_; } } while (0)
#else
#define STEP(k, body) do { const int k_ = (k); if (lo <= k_ && k_ < hi) { body; if (k_ + 1 < hi) GRID_SYNC(k_); } } while (0)
#endif
    STEP(0, { phase_mod(p, sm); phase_wprep(p, sm); });
#pragma unroll 1
    for (int l = 0; l < 2; ++l) {
        const int s0 = 1 + 13 * l;
        if (l == 0) STEP(s0 + 0, phase_u1prep(p, l, sm));
        STEP(s0 + 1, phase_inproj(p, l, smem_raw));
        STEP(s0 + 2, { phase_conv(p, l, sm); phase_vtrans(p, smem_raw); phase_gatescan(p, l, sm); });
        STEP(s0 + 3, { phase_mlstm(p, l, smem_raw); __syncthreads(); phase_na(p, l, smem_raw); phase_tabprep(p, l, smem_raw); });
        STEP(s0 + 4, phase_combine(p, l));
        STEP(s0 + 5, phase_outproj(p, l, smem_raw));
        STEP(s0 + 6, phase_ln1(p, l));
        STEP(s0 + 7, phase_peerq(p, l, smem_raw));
        STEP(s0 + 8, phase_topk(p, l, smem_raw));
        STEP(s0 + 9, phase_eslice<0>(p, l, smem_raw));
        STEP(s0 + 10, phase_ecoef(p, l));
        STEP(s0 + 11, phase_eslice<1>(p, l, smem_raw));
        STEP(s0 + 12, phase_eln(p, l, sm));
    }
#undef STEP
#ifdef PROBE_MASK
    if (timer_) { const unsigned te = (unsigned)__builtin_amdgcn_s_memrealtime(); while ((unsigned)__builtin_amdgcn_s_memrealtime() - te < 8u * tacc_) __builtin_amdgcn_s_sleep(32); }
#endif
}

extern "C" void kernel_launch(void* const* d_in, const int* in_sizes, int n_in, void* d_out, int out_size, void* d_ws,
                              size_t ws_size, hipStream_t stream) {
    static int grid_blocks = 0;
    if (!grid_blocks) {
        int dev = 0, cus = 0, per_cu = 0;
        hipGetDevice(&dev);
        hipDeviceGetAttribute(&cus, hipDeviceAttributeMultiprocessorCount, dev);
        hipFuncSetAttribute((const void*)mega, hipFuncAttributeMaxDynamicSharedMemorySize, LDS_BYTES);
        hipOccupancyMaxActiveBlocksPerMultiprocessor(&per_cu, (const void*)mega, NT, LDS_BYTES);
        if (per_cu < 1) per_cu = 1;
        grid_blocks = cus * per_cu;
        if (ws_size < WS_END) fprintf(stderr, "kernel_launch: workspace too small: %zu < %zu\n", ws_size, (size_t)WS_END);
    }
    P p{};
    const float** pp = (const float**)&p;
    for (int i = 0; i < 20; ++i) pp[i] = (const float*)d_in[i];
    p.out = (float*)d_out;
    p.ws = (unsigned char*)d_ws;
    hipMemsetAsync((unsigned char*)d_ws + WS_BAR, 0, (WS_CNT - WS_BAR) + 8192, stream);
#if SINGLE_LAUNCH
    int lo = 0, hi = NSTEPS;
    void* args[] = {&p, &lo, &hi};
    hipError_t e = hipLaunchCooperativeKernel((const void*)mega, dim3(grid_blocks), dim3(NT), args, LDS_BYTES, stream);
    if (e != hipSuccess) fprintf(stderr, "cooperative launch failed: %s (grid %d)\n", hipGetErrorString(e), grid_blocks);
#else
    for (int s = 0; s < NSTEPS; ++s) {
        int lo = s, hi = s + 1;
        void* args[] = {&p, &lo, &hi};
        hipError_t e = hipLaunchCooperativeKernel((const void*)mega, dim3(grid_blocks), dim3(NT), args, LDS_BYTES, stream);
        if (e != hipSuccess) fprintf(stderr, "launch %d failed: %s (grid %d)\n", s, hipGetErrorString(e), grid_blocks);
    }
#endif
}
```

```cpp
#include <hip/hip_runtime.h>
#include <hip/hip_cooperative_groups.h>
#include <cstdio>
#include <cstdint>
namespace cg = cooperative_groups;

#ifndef SINGLE_LAUNCH
#define SINGLE_LAUNCH 1
#endif

typedef unsigned short bf16_t;

constexpr int NT = 512;
constexpr int NW = NT / 64;
constexpr int D = 1024, NB = 16, T = 2048, CT = 256;
constexpr int ML = NB * T, MC = NB * CT, M = ML + MC;
constexpr int D_IN = 3088;
constexpr float ALPHA = 1.4142135623730951f;
constexpr float LN_EPS = 1e-5f;
constexpr int NSTEPS = 27;

constexpr size_t SZ_HALF = (size_t)M * 512 * 2;
constexpr size_t WS_MOD   = 0;
constexpr size_t WS_BAR   = 0xE0000;
constexpr size_t WS_XCTX  = 1u << 20;
constexpr size_t WS_R1    = WS_XCTX + (size_t)MC * 1024 * 4;
constexpr size_t WS_QKRAW = WS_R1;
constexpr size_t WS_V     = WS_R1 + 1 * SZ_HALF;
constexpr size_t WS_O     = WS_R1 + 2 * SZ_HALF;
constexpr size_t WS_NQ    = WS_R1 + 3 * SZ_HALF;
constexpr size_t WS_NK    = WS_R1 + 4 * SZ_HALF;
constexpr size_t WS_NV    = WS_R1 + 5 * SZ_HALF;
constexpr size_t WS_Y     = WS_R1;
constexpr size_t WS_Q     = WS_R1 + 2 * SZ_HALF;
constexpr size_t WS_GATES = WS_R1 + 6 * SZ_HALF;
constexpr size_t WS_R3    = WS_GATES + (size_t)M * 16 * 4;
constexpr size_t WS_QKACT = WS_R3;
constexpr size_t WS_HDIR  = WS_R3 + SZ_HALF;
constexpr size_t WS_EIDX  = WS_R3;
constexpr size_t WS_EGATE = WS_R3 + (size_t)M * 128 * 4;
constexpr size_t WS_U2Q   = WS_R3 + SZ_HALF;
constexpr size_t WS_USC   = WS_GATES;
constexpr size_t WS_MIX   = WS_R3 + 3 * SZ_HALF;
constexpr size_t WS_U2    = WS_MIX;
constexpr size_t WS_U1    = WS_MIX;
constexpr size_t WS_WIN   = WS_MIX + 2 * SZ_HALF;
constexpr size_t WS_WOUT  = WS_WIN + (size_t)2 * 3072 * 1024 * 2;
constexpr size_t WS_WQ    = WS_WOUT + (size_t)2 * 1024 * 1024 * 2;
constexpr size_t WS_NVT   = WS_WQ + (size_t)2 * 2048 * 1024 * 2;
constexpr size_t WS_TUP   = WS_NVT + (size_t)128 * 64 * 2304 * 2;
constexpr size_t WS_TDN   = WS_TUP + (size_t)16384 * 1024;
constexpr size_t WS_TSC   = WS_TDN + (size_t)16384 * 1024;
constexpr size_t WS_GSC   = WS_TSC + (size_t)2 * 16384 * 4;
constexpr size_t WS_END   = WS_GSC + (size_t)3 * 128 * 2304 * 4 + (size_t)128 * 36 * 4;

constexpr int LDS_BYTES = 128 * 1024 + 16;

struct P {
    const float *x, *c, *ctx, *c_ctx, *ada_w, *ada_b, *w_in, *b_gate, *conv_w, *ml_norm_w, *na_rpb, *w_out,
                *ln1_w, *ln1_b, *peer_wq, *peer_keys, *peer_up, *peer_down, *ln2_w, *ln2_b;
    float* out;
    unsigned char* ws;
};

typedef short bf16x8 __attribute__((ext_vector_type(8)));
typedef float f32x16 __attribute__((ext_vector_type(16)));
__device__ __forceinline__ bf16_t f2bf(float f) {
    unsigned u = __float_as_uint(f);
    u += 0x7fffu + ((u >> 16) & 1u);
    return (bf16_t)(u >> 16);
}
__device__ __forceinline__ float bf2f(bf16_t h) { return __uint_as_float(((unsigned)h) << 16); }
typedef __bf16 bf16x2v_t __attribute__((ext_vector_type(2)));
typedef float f32x2v_t __attribute__((ext_vector_type(2)));
__device__ __forceinline__ unsigned pk_bf16(float lo, float hi) { const f32x2v_t f = {lo, hi}; return __builtin_bit_cast(unsigned, __builtin_convertvector(f, bf16x2v_t)); }
__device__ __forceinline__ int opaque_tid() { int v = threadIdx.x; asm volatile("" : "+v"(v)); return v; }
__device__ __forceinline__ float wave_sum(float v) {
#pragma unroll
    for (int o = 32; o; o >>= 1) v += __shfl_xor(v, o);
    return v;
}
__device__ __forceinline__ float wave_max(float v) {
#pragma unroll
    for (int o = 32; o; o >>= 1) v = fmaxf(v, __shfl_xor(v, o));
    return v;
}
__device__ __forceinline__ float siluf(float v) { return v / (1.f + expf(-v)); }
__device__ __forceinline__ float sigmoidf(float v) { return 1.f / (1.f + expf(-v)); }
__device__ __forceinline__ float logsigmoidf(float v) { return fminf(v, 0.f) - log1pf(expf(-fabsf(v))); }
__device__ __forceinline__ float gelu_tanh(float v) {
    const float k0 = 0.7978845608028654f;
    return 0.5f * v * (1.f + tanhf(k0 * (v + 0.044715f * v * v * v)));
}
__device__ __forceinline__ int mod_row(int r) { return r < ML ? (r >> 11) : 16; }
__device__ __forceinline__ const float* xrow(const P& p, int l, int r) {
    if (r < ML) return (l == 0 ? p.x : (const float*)p.out) + (size_t)r * D;
    return (l == 0 ? p.ctx : (const float*)(p.ws + WS_XCTX)) + (size_t)(r - ML) * D;
}
__device__ __forceinline__ float* xrow_w(const P& p, int r) {
    if (r < ML) return p.out + (size_t)r * D;
    return (float*)(p.ws + WS_XCTX) + (size_t)(r - ML) * D;
}
__device__ __forceinline__ const float* modp(const P& p, int l, int r) {
    return (const float*)(p.ws + WS_MOD) + (size_t)(l * 17 + mod_row(r)) * 6144;
}

__device__ __forceinline__ float wave_sum16(const float (&v)[16], int lane) {
    const bool b0 = lane & 1, b1 = lane & 2, b2 = lane & 4, b3 = lane & 8;
    float a8[8];
#pragma unroll
    for (int i = 0; i < 8; ++i) { const float lo_ = v[2 * i], hi_ = v[2 * i + 1]; const float keep = b0 ? hi_ : lo_, send = b0 ? lo_ : hi_; a8[i] = keep + __shfl_xor(send, 1); }
    float a4[4];
#pragma unroll
    for (int i = 0; i < 4; ++i) { const float lo_ = a8[2 * i], hi_ = a8[2 * i + 1]; const float keep = b1 ? hi_ : lo_, send = b1 ? lo_ : hi_; a4[i] = keep + __shfl_xor(send, 2); }
    float a2[2];
#pragma unroll
    for (int i = 0; i < 2; ++i) { const float lo_ = a4[2 * i], hi_ = a4[2 * i + 1]; const float keep = b2 ? hi_ : lo_, send = b2 ? lo_ : hi_; a2[i] = keep + __shfl_xor(send, 4); }
    float a1; { const float lo_ = a2[0], hi_ = a2[1]; const float keep = b3 ? hi_ : lo_, send = b3 ? lo_ : hi_; a1 = keep + __shfl_xor(send, 8); }
    a1 += __shfl_xor(a1, 16); a1 += __shfl_xor(a1, 32);
    return a1;
}

__device__ __forceinline__ void phase_mod(const P& p, float* sm) {
    float* mod = (float*)(p.ws + WS_MOD);
    const int tid = opaque_tid();
    {
        float cv[34];
#pragma unroll
        for (int q = 0; q < 34; ++q) { const int i = tid + NT * q; const int mr = i >> 10, k = i & 1023; cv[q] = mr < 16 ? p.c[mr * D + k] : p.c_ctx[k]; }
#pragma unroll
        for (int q = 0; q < 34; ++q) { const int i = tid + NT * q; const int mr = i >> 10, k = i & 1023; sm[mr * 1024 + ((k & 127) << 3) + (k >> 7)] = siluf(cv[q]); }
    }
    __syncthreads();
    const int total = 2 * 6144 * 8;
    for (int i = blockIdx.x * NT + tid; i < total; i += gridDim.x * NT) {
        const int kq = i & 7, col = (i >> 3) % 6144, l = (i >> 3) / 6144;
        const float* w = p.ada_w + (size_t)l * D * 6144 + (size_t)(kq * 128) * 6144 + col;
        float acc[17];
#pragma unroll
        for (int mr = 0; mr < 17; ++mr) acc[mr] = 0.f;
#pragma unroll 1
        for (int k0 = 0; k0 < 128; k0 += 16) {
            float wv[16];
#pragma unroll
            for (int kk = 0; kk < 16; ++kk) wv[kk] = w[(size_t)(k0 + kk) * 6144];
#pragma unroll
            for (int kk = 0; kk < 16; ++kk)
#pragma unroll
                for (int mr = 0; mr < 17; ++mr) acc[mr] += sm[mr * 1024 + (k0 + kk) * 8 + kq] * wv[kk];
        }
        const float bias = p.ada_b[l * 6144 + col];
#pragma unroll
        for (int mr = 0; mr < 17; ++mr) {
            float v = acc[mr];
            v += __shfl_xor(v, 1); v += __shfl_xor(v, 2); v += __shfl_xor(v, 4);
            if (kq == 0) mod[(size_t)(l * 17 + mr) * 6144 + col] = v + bias;
        }
    }
    __syncthreads();
}

namespace pg8 {
#define PG8_LAS __attribute__((address_space(3)))
typedef unsigned short bf16_t;
typedef short bf16x8 __attribute__((ext_vector_type(8)));
typedef float f32x4 __attribute__((ext_vector_type(4)));
typedef unsigned u32x4 __attribute__((ext_vector_type(4)));
constexpr int BM = 256, BK = 64, HALF = 128, HTB = HALF * BK * 2  , STAGE_BYTES = 8 * HTB, NXCD = 8, WGM = 8;

__host__ __device__ __forceinline__ int lds_byte(int r, int c) { const int st = (r >> 4) * 2 + (c >> 5), rr = r & 15, cc = c & 31, ob = rr * 64 + cc * 2; return st * 1024 + (ob ^ (((ob >> 9) & 1) << 5)); }
__host__ __device__ __forceinline__ void stage_rc(int b, int& R, int& C) { const int st = b / 1024, sb = b % 1024, swz = sb ^ (((sb >> 9) & 1) << 5); R = (st >> 1) * 16 + swz / 64; C = (st & 1) * 32 + (swz % 64) / 2; }
__host__ __device__ __forceinline__ int perm32(int rho) { const int n = rho >> 4, i = rho & 15; return 8 * (i >> 2) + 4 * n + (i & 3); }

struct Unit { int pm, pn; };
struct Gemm { const bf16_t* A; const bf16_t* Bt; int M, N, K; };

struct StaticOrder {
    int nM, nN, nwg, G, c;
    __host__ __device__ void init(int M, int N, int G_, int c_) { nM = M / BM; nN = N / BM; nwg = nM * nN; G = G_; c = c_; }
    __host__ __device__ bool next(int i, Unit& u) const {
        const long L = (long)i * G + c; if (L >= nwg) return false;
        int wgid = (int)L; { const int q = nwg / NXCD, r = nwg % NXCD, xcd = wgid % NXCD, off = wgid / NXCD; wgid = (xcd < r ? xcd * (q + 1) : r * (q + 1) + (xcd - r) * q) + off; }
        const int nig = WGM * nN, gid = wgid / nig, fm = gid * WGM, gsz = (nM - fm) < WGM ? (nM - fm) : WGM;
        u.pm = fm + ((wgid % nig) % gsz); u.pn = (wgid % nig) / gsz; return true;
    }
    __device__ __forceinline__ void a_ready(const Unit&) const {}
    __device__ __forceinline__ void done(const Unit&) const {}
};
__device__ __forceinline__ unsigned cvt_pk_bf16(float lo, float hi) { unsigned r; asm volatile("v_cvt_pk_bf16_f32 %0, %1, %2" : "=v"(r) : "v"(lo), "v"(hi)); return r; }
template <int ACT  > struct EpiBf16 {
    static constexpr bool PERM = true, AFTER_DRAIN = false;
    bf16_t* O; int ldc; const float* bias; int split_cols; size_t split_stride;
    __device__ __forceinline__ void operator()(const f32x4 (&acc)[2][2][4][2], const Unit& u, int wr, int wc, int fr, int fq) const {
        const int row0 = u.pm * BM + wr * 64 + fr; int colt = u.pn * BM; bf16_t* base = O;
        if (split_cols) { const int t = colt / split_cols; base += (size_t)t * split_stride; colt -= t * split_cols; }
        const int col0 = colt + wc * 32 + 8 * fq, bcol0 = u.pn * BM + wc * 32 + 8 * fq;
        f32x4 bv[2][2];
#pragma unroll
        for (int bj = 0; bj < 2; ++bj)
#pragma unroll
            for (int n = 0; n < 2; ++n) bv[bj][n] = bias ? *(const f32x4*)(bias + bcol0 + bj * HALF + 4 * n) : (f32x4){0.f, 0.f, 0.f, 0.f};
#pragma unroll
        for (int ai = 0; ai < 2; ++ai)
#pragma unroll
            for (int m = 0; m < 4; ++m) { bf16_t* rowp = base + (size_t)(row0 + ai * HALF + m * 16) * ldc + col0;
#pragma unroll
                for (int bj = 0; bj < 2; ++bj) { f32x4 v0 = acc[ai][bj][m][0] + bv[bj][0], v1 = acc[ai][bj][m][1] + bv[bj][1];
                    u32x4 w; w.x = cvt_pk_bf16(v0[0], v0[1]); w.y = cvt_pk_bf16(v0[2], v0[3]); w.z = cvt_pk_bf16(v1[0], v1[1]); w.w = cvt_pk_bf16(v1[2], v1[3]);
                    *(u32x4*)(rowp + bj * HALF) = w; } }
    }
};
template <class Epi, class Sched, bool STAMP = false>
__device__ __forceinline__ void gemm_phase(PG8_LAS unsigned char* lds, const Gemm g, const Sched& S, const Epi& E, unsigned long long* stamps) {
    const int tid = opaque_tid(), wid = __builtin_amdgcn_readfirstlane(tid >> 6), lane = tid & 63, wr = wid >> 2, wc = wid & 3, fr = lane & 15, fq = lane >> 4;
    const int K = g.K, nt = K / BK;
    int ts_lo = 0, ts_hi = 0, nts = 0; const unsigned long long rt_entry = STAMP ? (unsigned long long)wall_clock64() : 0ull;
#define PG8_STAMP() do { if (STAMP && wid == 0 && nts < 64) { const unsigned long long _c = (unsigned long long)clock64(); \
        ts_lo = (lane == nts) ? (int)(unsigned)_c : ts_lo; ts_hi = (lane == nts) ? (int)(unsigned)(_c >> 32) : ts_hi; ++nts; } } while (0)
    PG8_STAMP();
    unsigned voffA[2], voffB[2];
#pragma unroll
    for (int i = 0; i < 2; ++i) { int R, C; stage_rc(tid * 16 + i * 8192, R, C); const int Rb = Epi::PERM ? ((R & ~31) + perm32(R & 31)) : R;
        voffA[i] = (unsigned)(R * K + C) * 2u; voffB[i] = (unsigned)(Rb * K + C) * 2u; }
    const size_t kstep = (size_t)(BK * 2);
    const size_t hstep = (size_t)HALF * K * 2;
    const size_t tstep = 2 * hstep;
    const unsigned ldsw = (unsigned)wid * 1024u;
    const int aoff = lds_byte(wr * 64 + fr, fq * 8), boff = lds_byte(wc * 32 + fr, fq * 8);
#define PG8_SA(b, h) (((b) * 2 + (h)) * HTB)
#define PG8_SB(b, h) ((4 + (b) * 2 + (h)) * HTB)
#define PG8_STAGE(bufoff, gbase, voff) do { _Pragma("unroll") for (int _i = 0; _i < 2; ++_i) \
        __builtin_amdgcn_global_load_lds((const unsigned*)((const char*)(gbase) + (voff)[_i]), (PG8_LAS unsigned*)(lds + (bufoff) + ldsw + _i * 8192), 16, 0, 0); } while (0)
#define PG8_LDA(dst, b, h) do { _Pragma("unroll") for (int m = 0; m < 4; ++m) _Pragma("unroll") for (int k = 0; k < 2; ++k) dst[m][k] = *(const PG8_LAS bf16x8*)(lds + PG8_SA(b, h) + aoff + m * 2048 + k * 1024); } while (0)
#define PG8_LDB(dst, b, h) do { _Pragma("unroll") for (int n = 0; n < 2; ++n) _Pragma("unroll") for (int k = 0; k < 2; ++k) dst[n][k] = *(const PG8_LAS bf16x8*)(lds + PG8_SB(b, h) + boff + n * 2048 + k * 1024); } while (0)
#define PG8_MMA(ai, bj, At, Bt) do { __builtin_amdgcn_s_setprio(1); _Pragma("unroll") for (int m = 0; m < 4; ++m) _Pragma("unroll") for (int n = 0; n < 2; ++n) _Pragma("unroll") for (int k = 0; k < 2; ++k) \
        acc[ai][bj][m][n] = __builtin_amdgcn_mfma_f32_16x16x32_bf16(Bt[n][k], At[m][k], acc[ai][bj][m][n], 0, 0, 0); __builtin_amdgcn_s_setprio(0); } while (0)
#define PG8_WAIT_V(n) asm volatile("s_waitcnt vmcnt(" #n ")" ::: "memory")
#define PG8_WAIT_L(n) asm volatile("s_waitcnt lgkmcnt(" #n ")" ::: "memory")
#define PG8_BAR __builtin_amdgcn_s_barrier()
#define PG8_SCHED __builtin_amdgcn_sched_barrier(0)
    Unit cur, nxt; int ui = 0;
    if (!S.next(0, cur)) return;
    f32x4 acc[2][2][4][2];
#pragma unroll
    for (int a = 0; a < 2; ++a)
#pragma unroll
        for (int b = 0; b < 2; ++b)
#pragma unroll
            for (int m = 0; m < 4; ++m)
#pragma unroll
                for (int n = 0; n < 2; ++n) acc[a][b][m][n] = (f32x4){0.f, 0.f, 0.f, 0.f};
    bf16x8 At[4][2], B0[2][2], B1[2][2];
    const char* cA = (const char*)g.A + (size_t)cur.pm * tstep; const char* cB = (const char*)g.Bt + (size_t)cur.pn * tstep;
    S.a_ready(cur);
    PG8_STAGE(PG8_SB(0, 0), cB, voffB); PG8_STAGE(PG8_SA(0, 0), cA, voffA); PG8_STAGE(PG8_SB(0, 1), cB + hstep, voffB); PG8_STAGE(PG8_SA(0, 1), cA + hstep, voffA);
    if (wr == 1) PG8_BAR;
    PG8_WAIT_V(4); PG8_BAR;
    PG8_STAGE(PG8_SB(1, 0), cB + kstep, voffB); PG8_STAGE(PG8_SA(1, 0), cA + kstep, voffA); PG8_STAGE(PG8_SB(1, 1), cB + hstep + kstep, voffB);
    PG8_WAIT_V(6); PG8_BAR;
    PG8_STAMP();
    for (;;) {
        const bool has_next = S.next(ui + 1, nxt);
        const char* nA = has_next ? (const char*)g.A + (size_t)nxt.pm * tstep : cA; const char* nB = has_next ? (const char*)g.Bt + (size_t)nxt.pn * tstep : cB;
        for (int t = 0; t < nt; t += 2) {
            const bool last = (t == nt - 2);
            const char* a1 = cA + (size_t)(t + 1) * kstep;
            const char* a2 = last ? nA : cA + (size_t)(t + 2) * kstep; const char* b2 = last ? nB : cB + (size_t)(t + 2) * kstep;
            const char* a3 = a2 + kstep; const char* b3 = b2 + kstep;
            if (last && has_next) S.a_ready(nxt);
            PG8_LDB(B0, 0, 0); PG8_SCHED; PG8_LDA(At, 0, 0); PG8_STAGE(PG8_SA(1, 1), a1 + hstep, voffA);
            PG8_WAIT_L(8); PG8_BAR; PG8_WAIT_L(0); PG8_MMA(0, 0, At, B0); PG8_BAR; PG8_SCHED;
            PG8_LDB(B1, 0, 1); PG8_STAGE(PG8_SB(0, 0), b2, voffB);
            PG8_BAR; PG8_WAIT_L(0); PG8_MMA(0, 1, At, B1); PG8_BAR;
            PG8_LDA(At, 0, 1); PG8_STAGE(PG8_SA(0, 0), a2, voffA);
            PG8_BAR; PG8_WAIT_L(0); PG8_MMA(1, 0, At, B0); PG8_BAR; PG8_SCHED;
            PG8_STAGE(PG8_SB(0, 1), b2 + hstep, voffB);
            PG8_WAIT_V(6); PG8_BAR; PG8_MMA(1, 1, At, B1); PG8_BAR;
            PG8_LDB(B0, 1, 0); PG8_SCHED; PG8_LDA(At, 1, 0); PG8_STAGE(PG8_SA(0, 1), a2 + hstep, voffA);
            PG8_WAIT_L(8); PG8_BAR; PG8_WAIT_L(0); PG8_MMA(0, 0, At, B0); PG8_BAR; PG8_SCHED;
            PG8_LDB(B1, 1, 1); PG8_STAGE(PG8_SB(1, 0), b3, voffB);
            PG8_BAR; PG8_WAIT_L(0); PG8_MMA(0, 1, At, B1); PG8_BAR;
            PG8_LDA(At, 1, 1); PG8_STAGE(PG8_SA(1, 0), a3, voffA);
            PG8_BAR; PG8_WAIT_L(0); PG8_MMA(1, 0, At, B0); PG8_BAR; PG8_SCHED;
            PG8_STAGE(PG8_SB(1, 1), b3 + hstep, voffB);
            PG8_WAIT_V(6); PG8_BAR; PG8_MMA(1, 1, At, B1); PG8_BAR;
        }
        PG8_STAMP();
        if constexpr (!Epi::AFTER_DRAIN) { E(acc, cur, wr, wc, fr, fq); S.done(cur); }
        PG8_STAMP();
        if (!has_next) break;
#pragma unroll
        for (int a = 0; a < 2; ++a)
#pragma unroll
            for (int b = 0; b < 2; ++b)
#pragma unroll
                for (int m = 0; m < 4; ++m)
#pragma unroll
                    for (int n = 0; n < 2; ++n) acc[a][b][m][n] = (f32x4){0.f, 0.f, 0.f, 0.f};
        cur = nxt; cA = nA; cB = nB; ++ui;
    }
    PG8_WAIT_V(0);
    if (wr == 0) PG8_BAR;
    PG8_BAR;
    if constexpr (Epi::AFTER_DRAIN) { E.fused(acc, cur, wr, wc, fr, fq, lds, wid, lane); S.done(cur); }
    PG8_STAMP();
    if (STAMP && wid == 0) { stamps[lane] = lane < nts ? (((unsigned long long)(unsigned)ts_hi << 32) | (unsigned)ts_lo) : 0ull;
        if (lane == 62) stamps[62] = rt_entry; if (lane == 63) stamps[63] = (unsigned long long)wall_clock64(); }
#undef PG8_STAMP
#undef PG8_SA
#undef PG8_SB
#undef PG8_STAGE
#undef PG8_LDA
#undef PG8_LDB
#undef PG8_MMA
#undef PG8_WAIT_V
#undef PG8_WAIT_L
#undef PG8_BAR
#undef PG8_SCHED
}
}


__device__ __forceinline__ void phase_wprep(const P& p, float* sm) {
    const int tid = opaque_tid();
    float (*tl)[65] = (float (*)[65])sm;
    for (int tile = blockIdx.x; tile < 2 * 1536; tile += gridDim.x) {
        const int l = tile / 1536; int t = tile % 1536;
        const float* src; bf16_t* dst; int Nsrc, which;
        if (t < 768) { which = 0; src = p.w_in + (size_t)l * D * D_IN; Nsrc = D_IN; dst = (bf16_t*)(p.ws + WS_WIN) + (size_t)l * 3072 * 1024; }
        else if (t < 1024) { which = 1; t -= 768; src = p.w_out + (size_t)l * D * D; Nsrc = D; dst = (bf16_t*)(p.ws + WS_WOUT) + (size_t)l * 1024 * 1024; }
        else { which = 2; t -= 1024; src = p.peer_wq + (size_t)l * D * 2048; Nsrc = 2048; dst = (bf16_t*)(p.ws + WS_WQ) + (size_t)l * 2048 * 1024; }
        const int tn = t / 16, tk = t % 16;
        {
            const int nn = tid & 63; const int n = tn * 64 + nn;
            const int nsrc = (which == 0 && n >= 1536) ? n + 16 : n;
            const float sc = (which == 0 && n >= 1536 && n < 2048) ? 0.125f : 1.f;
            float v[8];
#pragma unroll
            for (int q = 0; q < 8; ++q) v[q] = src[(size_t)(tk * 64 + (tid >> 6) + 8 * q) * Nsrc + nsrc];
#pragma unroll
            for (int q = 0; q < 8; ++q) tl[(tid >> 6) + 8 * q][nn] = v[q] * sc;
        }
        __syncthreads();
        for (int i = tid; i < 4096; i += NT) {
            const int nn = i >> 6, kk = i & 63;
            dst[(size_t)(tn * 64 + nn) * 1024 + tk * 64 + kk] = f2bf(tl[kk][nn]);
        }
        __syncthreads();
    }
}

__device__ __forceinline__ void phase_u1prep(const P& p, int l, float* sm) {
    bf16_t* u1 = (bf16_t*)(p.ws + WS_U1);
    float* gates = (float*)(p.ws + WS_GATES);
    const int tid_ = opaque_tid(); const int lane = tid_ & 63, wave = tid_ >> 6;
    __syncthreads();
#pragma unroll 1
    for (int i0 = 0; i0 < 16 * 1024; i0 += 16 * NT) {
        float wv[16];
#pragma unroll
        for (int q = 0; q < 16; ++q) { const int i = i0 + tid_ + NT * q; wv[q] = p.w_in[(size_t)l * D * D_IN + (size_t)(i >> 4) * D_IN + 1536 + (i & 15)]; }
#pragma unroll
        for (int q = 0; q < 16; ++q) { const int i = i0 + tid_ + NT * q; sm[(i & 15) * 1024 + (i >> 4)] = wv[q]; }
    }
    __syncthreads();
    for (int r = blockIdx.x * NW + wave; r < M; r += gridDim.x * NW) {
        const float* xr = xrow(p, l, r); const float* mp = modp(p, l, r);
        float u[16];
#pragma unroll
        for (int i = 0; i < 4; ++i) {
            const int k0 = i * 256 + lane * 4;
            const float4 xv = *(const float4*)(xr + k0), sc = *(const float4*)(mp + 1024 + k0), sh = *(const float4*)(mp + k0);
            u[4 * i] = xv.x * (1.f + sc.x) + sh.x; u[4 * i + 1] = xv.y * (1.f + sc.y) + sh.y; u[4 * i + 2] = xv.z * (1.f + sc.z) + sh.z; u[4 * i + 3] = xv.w * (1.f + sc.w) + sh.w;
            uint2 pk; pk.x = pk_bf16(u[4 * i], u[4 * i + 1]); pk.y = pk_bf16(u[4 * i + 2], u[4 * i + 3]);
            *(uint2*)(u1 + (size_t)r * 1024 + k0) = pk;
        }
        float ga[16];
#pragma unroll
        for (int g = 0; g < 16; ++g) ga[g] = 0.f;
#pragma unroll 1
        for (int i = 0; i < 4; ++i) {
            const int k0 = i * 256 + lane * 4;
            const float u0 = i == 0 ? u[0] : i == 1 ? u[4] : i == 2 ? u[8] : u[12], u1v = i == 0 ? u[1] : i == 1 ? u[5] : i == 2 ? u[9] : u[13];
            const float u2v = i == 0 ? u[2] : i == 1 ? u[6] : i == 2 ? u[10] : u[14], u3v = i == 0 ? u[3] : i == 1 ? u[7] : i == 2 ? u[11] : u[15];
#pragma unroll
            for (int g = 0; g < 16; ++g) {
                const float4 w = *(const float4*)(sm + g * 1024 + k0);
                ga[g] += u0 * w.x + u1v * w.y + u2v * w.z + u3v * w.w;
            }
        }
        const float mine = wave_sum16(ga, lane);
        if (lane < 16) gates[(size_t)r * 16 + lane] = mine + p.b_gate[l * 16 + lane];
    }
    __syncthreads();
}

__device__ __forceinline__ size_t nk_frag_off(int bh, int row, int a, int w, int ks, int key4, int fq) {
    return (size_t)(bh * 32 + row) * 4096 + a * 512 + w * 256 + ks * 128 + key4 * 32 + fq * 8;
}
struct EpiInproj {
    static constexpr bool PERM = true, AFTER_DRAIN = false;
    pg8::bf16_t* O; size_t split_stride;
    __device__ __forceinline__ void operator()(const pg8::f32x4 (&acc)[2][2][4][2], const pg8::Unit& u, int wr, int wc, int fr, int fq) const {
        const int row0 = u.pm * pg8::BM + wr * 64 + fr; const int colt0 = u.pn * pg8::BM;
        const int t = colt0 / 512; pg8::bf16_t* base = O + (size_t)t * split_stride; const int colt = colt0 - t * 512;
        const int col0 = colt + wc * 32 + 8 * fq;
        const bool frag = (t == 4) && (u.pm < ML / 256);
#pragma unroll
        for (int ai = 0; ai < 2; ++ai)
#pragma unroll
            for (int m = 0; m < 4; ++m) {
                const int row = row0 + ai * pg8::HALF + m * 16;
#pragma unroll
                for (int bj = 0; bj < 2; ++bj) {
                    const pg8::f32x4 v0 = acc[ai][bj][m][0], v1 = acc[ai][bj][m][1];
                    pg8::u32x4 w; w.x = pg8::cvt_pk_bf16(v0[0], v0[1]); w.y = pg8::cvt_pk_bf16(v0[2], v0[3]); w.z = pg8::cvt_pk_bf16(v1[0], v1[1]); w.w = pg8::cvt_pk_bf16(v1[2], v1[3]);
                    const int c = col0 + bj * pg8::HALF;
                    if (frag) {
                        const int b = row >> 11, tb = row & 2047, h = c >> 6, d = c & 63;
                        const int grow = tb >> 6, gcol = tb & 63;
                        *(pg8::u32x4*)(base + nk_frag_off(b * 8 + h, grow, gcol >> 3, (gcol >> 2) & 1, d >> 5, gcol & 3, (d >> 3) & 3)) = w;
                    } else {
                        *(pg8::u32x4*)(base + (size_t)row * 512 + c) = w;
                    }
                }
            }
    }
};
__device__ __forceinline__ void phase_inproj(const P& p, int l, unsigned char* smraw) {
    pg8::Gemm g{(const pg8::bf16_t*)(p.ws + WS_U1), (const pg8::bf16_t*)(p.ws + WS_WIN) + (size_t)l * 3072 * 1024, M, 3072, 1024};
    pg8::StaticOrder S; S.init(M, 3072, (int)gridDim.x, (int)blockIdx.x);
    EpiInproj E{(pg8::bf16_t*)(p.ws + WS_QKRAW), (size_t)M * 512};
    pg8::gemm_phase<EpiInproj, pg8::StaticOrder, false>((PG8_LAS unsigned char*)smraw, g, S, E, nullptr);
}

__device__ __forceinline__ void phase_conv(const P& p, int l, float* sm) {
    const bf16_t* qkraw = (const bf16_t*)(p.ws + WS_QKRAW);
    bf16_t* qkact = (bf16_t*)(p.ws + WS_QKACT);
    const int tid = opaque_tid();
    float* cw_s = sm;
    float* cs_s = sm + 2560;
    float* sn_s = sm + 2560 + 1024;
    __syncthreads();
    for (int i = tid; i < 2560; i += NT) cw_s[i] = p.conv_w[l * 2560 + i];
    for (int i = tid; i < 1024; i += NT) { const int pos = i >> 4, f = i & 15; const float ang = (float)pos * powf(10000.f, -(float)f / 16.f); cs_s[i] = cosf(ang); sn_s[i] = sinf(ang); }
    __syncthreads();
    const int total = M * 32;
    for (int it = blockIdx.x * NT + tid; it < total; it += gridDim.x * NT) {
        const int r = it >> 5, hq = (it >> 2) & 7, jg = it & 3;
        const int c1 = hq * 64 + jg * 8;
        int base, t, Ts;
        if (r < ML) { base = r & ~2047; t = r & 2047; Ts = T; } else { const int rc = r - ML; base = ML + (rc & ~255); t = rc & 255; Ts = CT; }
        float y1[8], y2[8];
#pragma unroll
        for (int i = 0; i < 8; ++i) { y1[i] = 0.f; y2[i] = 0.f; }
#pragma unroll
        for (int jj = 0; jj < 5; ++jj) {
            const int tt = t + jj - 2;
            if (tt >= 0 && tt < Ts) {
                const bf16_t* rp = qkraw + (size_t)(base + tt) * 512 + c1;
                const uint4 a = *(const uint4*)rp, b = *(const uint4*)(rp + 32);
                const unsigned aw[4] = {a.x, a.y, a.z, a.w}, bw[4] = {b.x, b.y, b.z, b.w};
                const float* w1 = cw_s + jj * 512 + c1; const float* w2 = w1 + 32;
#pragma unroll
                for (int i = 0; i < 4; ++i) {
                    y1[2 * i] += __uint_as_float(aw[i] << 16) * w1[2 * i]; y1[2 * i + 1] += __uint_as_float(aw[i] & 0xffff0000u) * w1[2 * i + 1];
                    y2[2 * i] += __uint_as_float(bw[i] << 16) * w2[2 * i]; y2[2 * i + 1] += __uint_as_float(bw[i] & 0xffff0000u) * w2[2 * i + 1];
                }
            }
        }
        const float ks = hq >= 4 ? 0.125f : 1.f;
        const bool lat = r < ML;
        const int pos = (jg < 2) ? (t >> 6) : (t & 63);
        float o1[8], o2[8];
#pragma unroll
        for (int i = 0; i < 8; ++i) {
            const float a = siluf(y1[i]) * ks, b = siluf(y2[i]) * ks;
            if (lat) { const float cs = cs_s[pos * 16 + ((jg & 1) * 8 + i)], sn = sn_s[pos * 16 + ((jg & 1) * 8 + i)]; o1[i] = a * cs - b * sn; o2[i] = a * sn + b * cs; }
            else { o1[i] = a; o2[i] = b; }
        }
        bf16_t* op = qkact + (size_t)r * 512 + c1;
        *(uint4*)op = make_uint4(pk_bf16(o1[0], o1[1]), pk_bf16(o1[2], o1[3]), pk_bf16(o1[4], o1[5]), pk_bf16(o1[6], o1[7]));
        *(uint4*)(op + 32) = make_uint4(pk_bf16(o2[0], o2[1]), pk_bf16(o2[2], o2[3]), pk_bf16(o2[4], o2[5]), pk_bf16(o2[6], o2[7]));
    }
    __syncthreads();
}

typedef short bf16x4s __attribute__((ext_vector_type(4)));
constexpr int ML_RS = 144;
constexpr int ML_K = 0, ML_WKT = 9216, ML_Q = 18432, ML_VT = 27648, ML_OUT = 46080, ML_ARR = 63488;
__device__ __forceinline__ bf16x8 cvt8(const f32x16& x, int o) {
    union { unsigned u[4]; bf16x8 v; } r;
    r.u[0] = pk_bf16(x[o], x[o + 1]); r.u[1] = pk_bf16(x[o + 2], x[o + 3]); r.u[2] = pk_bf16(x[o + 4], x[o + 5]); r.u[3] = pk_bf16(x[o + 6], x[o + 7]);
    return r.v;
}
__device__ __forceinline__ bf16x8 ld2x4(const unsigned char* p) {
    union { bf16x4s h[2]; bf16x8 v; } r; r.h[0] = *(const bf16x4s*)p; r.h[1] = *(const bf16x4s*)(p + 16); return r.v;
}
__device__ __forceinline__ void lds_barrier() { asm volatile("s_waitcnt lgkmcnt(0)" ::: "memory"); __builtin_amdgcn_s_barrier(); asm volatile("" ::: "memory"); }
__device__ __forceinline__ void phase_gatescan(const P& p, int l, float* sm) {
    const float* gates = (const float*)(p.ws + WS_GATES);
    float* Gs = (float*)(p.ws + WS_GSC); float* PMs = Gs + 128 * 2304; float* Bs = PMs + 128 * 2304; float* MINs = Bs + 128 * 2304;
    const int tid = opaque_tid(); const int lane = tid & 63, wave = tid >> 6;
    float* b63 = sm; float* pm63 = sm + 64;
    for (int item = blockIdx.x; item < NB * 4 * 2; item += gridDim.x) {
        const int dir = item & 1, h = (item >> 1) & 3, b = item >> 3;
        __syncthreads();
        for (int ci = wave; ci < 36; ci += NW) {
            const bool isctx = ci < 4; const int base = isctx ? ML + b * CT : b * T; const int Ts = isctx ? CT : T; const int cl = isctx ? ci : ci - 4;
            const int pos = cl * 64 + lane; const int t = dir ? Ts - 1 - pos : pos;
            const float* gp = gates + (size_t)(base + t) * 16;
            const float li = gp[(2 * dir) * 4 + h], lfx = gp[(2 * dir + 1) * 4 + h];
            float bsum = fminf(lfx, 0.f) - __logf(1.f + __expf(-fabsf(lfx)));
#pragma unroll
            for (int d = 1; d < 64; d <<= 1) { const float tt = __shfl_up(bsum, d); if (lane >= d) bsum += tt; }
            const float g = li - bsum;
            float pm = g;
#pragma unroll
            for (int d = 1; d < 64; d <<= 1) { const float tt = __shfl_up(pm, d); if (lane >= d) pm = fmaxf(pm, tt); }
            const size_t idx = (size_t)item * 2304 + ci * 64 + lane;
            Gs[idx] = g; PMs[idx] = pm; Bs[idx] = bsum;
            if (lane == 63) { b63[ci] = bsum; pm63[ci] = pm; }
        }
        __syncthreads();
        if (tid == 0) {
            float m = 0.f;
            for (int ci = 0; ci < 36; ++ci) { MINs[item * 36 + ci] = m; m = b63[ci] + fmaxf(m, pm63[ci]); }
        }
    }
    __syncthreads();
}

__device__ __forceinline__ bf16x8 ld2x4x(const unsigned char* row, int s, int x) {
    union { bf16x4s h[2]; bf16x8 v; } r; r.h[0] = *(const bf16x4s*)(row + ((s ^ x) * 2)); r.h[1] = *(const bf16x4s*)(row + (((s + 8) ^ x) * 2)); return r.v;
}
__device__ __forceinline__ void phase_mlstm(const P& p, int l, unsigned char* sm) {
    const bool need_ctx = (l == 0);
    const bf16_t* qkact = (const bf16_t*)(p.ws + WS_QKACT);
    const bf16_t* vb = (const bf16_t*)(p.ws + WS_V);
    const float* Gs = (const float*)(p.ws + WS_GSC); const float* PMs = Gs + 128 * 2304; const float* Bs = PMs + 128 * 2304; const float* MINs = Bs + 128 * 2304;
    bf16_t* hdir = (bf16_t*)(p.ws + WS_HDIR);
    const int tid = opaque_tid(); const int lane = tid & 63, wave = tid >> 6, r = lane & 31, hh = lane >> 5;
    const int c = wave & 1, vt = wave >> 1, j = c * 32 + r;
    float* a_g = (float*)(sm + ML_ARR); float* a_M = a_g + 64; float* a_inter = a_M + 64; float* a_edn = a_inter + 64; float* a_n = a_edn + 64;
    const int srow = tid >> 3, part = tid & 7;
    for (int item = blockIdx.x; item < NB * 4 * 2; item += gridDim.x) {
        const int dir = item & 1, h = (item >> 1) & 3, b = item >> 3;
        f32x16 X0, X1;
#pragma unroll
        for (int i = 0; i < 16; ++i) { X0[i] = 0.f; X1[i] = 0.f; }
        __syncthreads();
        if (tid < 128) a_n[tid] = 0.f;
        uint4 pq, pk, pv0, pv1; float pg = 0.f, pgj = 0.f, ppm = 0.f, pb = 0.f, pmin = 0.f, ppm63 = 0.f;
        auto issue = [&](int ci) {
            const bool isctx = ci < 4; const int base = isctx ? ML + b * CT : b * T; const int Ts = isctx ? CT : T; const int cl = isctx ? ci : ci - 4;
            const int pos = cl * 64 + srow; const int t = dir ? Ts - 1 - pos : pos; const size_t ro = (size_t)(base + t) * 512;
            pq = *(const uint4*)(qkact + ro + h * 64 + part * 8); pk = *(const uint4*)(qkact + ro + 256 + h * 64 + part * 8);
            pv0 = *(const uint4*)(vb + ro + h * 128 + part * 16); pv1 = *(const uint4*)(vb + ro + h * 128 + part * 16 + 8);
            const size_t gi = (size_t)item * 2304 + ci * 64;
            pg = Gs[gi + srow]; pmin = MINs[item * 36 + ci]; ppm63 = PMs[gi + 63];
            if (tid < 64) { pgj = Gs[gi + tid]; ppm = PMs[gi + tid]; pb = Bs[gi + tid]; }
        };
        issue(0);
#pragma unroll 1
        for (int ci = 0; ci < 36; ++ci) {
            const bool isctx = ci < 4; const int base = isctx ? ML + b * CT : b * T; const int Ts = isctx ? CT : T; const int cl = isctx ? ci : ci - 4;
            const bool do_out = (!isctx) || need_ctx;
            const int nb = (ci & 1) * 64;
            const float m_in = pmin, M63 = fmaxf(pmin, ppm63);
            const float so = __expf(m_in - M63);
            const float wrow = __expf(pg - M63);
            *(uint4*)(sm + ML_Q + srow * ML_RS + part * 16) = pq;
            *(uint4*)(sm + ML_K + srow * ML_RS + part * 16) = pk;
            {
                const unsigned kw[4] = {pk.x, pk.y, pk.z, pk.w};
                const unsigned w[8] = {pv0.x, pv0.y, pv0.z, pv0.w, pv1.x, pv1.y, pv1.z, pv1.w};
#pragma unroll
                for (int i = 0; i < 4; ++i) {
                    *(bf16_t*)(sm + ML_WKT + (part * 8 + 2 * i) * ML_RS + (srow ^ (8 * part)) * 2) = f2bf(wrow * __uint_as_float(kw[i] << 16));
                    *(bf16_t*)(sm + ML_WKT + (part * 8 + 2 * i + 1) * ML_RS + (srow ^ (8 * part)) * 2) = f2bf(wrow * __uint_as_float(kw[i] & 0xffff0000u));
                }
#pragma unroll
                for (int i = 0; i < 8; ++i) {
                    *(bf16_t*)(sm + ML_VT + (part * 16 + 2 * i) * ML_RS + (srow ^ (8 * part)) * 2) = (bf16_t)(w[i] & 0xffffu);
                    *(bf16_t*)(sm + ML_VT + (part * 16 + 2 * i + 1) * ML_RS + (srow ^ (8 * part)) * 2) = (bf16_t)(w[i] >> 16);
                }
            }
            if (tid < 64) { const float Mv = fmaxf(m_in, ppm); a_g[tid] = pgj; a_M[tid] = Mv; a_inter[tid] = __expf(m_in - Mv); a_edn[tid] = __expf(-(pb + Mv)); }
            if (ci + 1 < 36) issue(ci + 1);
            lds_barrier();
            {
                const float Mjv = a_M[j], interj = a_inter[j];
                float nq;
                {
                    float acc = 0.f;
                    const unsigned char* qr = sm + ML_Q + j * ML_RS + hh * 64;
#pragma unroll
                    for (int k8 = 0; k8 < 4; ++k8) {
                        const uint4 w = *(const uint4*)(qr + k8 * 16);
                        const float4 n0 = *(const float4*)(a_n + nb + hh * 32 + k8 * 8), n1 = *(const float4*)(a_n + nb + hh * 32 + k8 * 8 + 4);
                        acc += n0.x * __uint_as_float(w.x << 16) + n0.y * __uint_as_float(w.x & 0xffff0000u) + n0.z * __uint_as_float(w.y << 16) + n0.w * __uint_as_float(w.y & 0xffff0000u);
                        acc += n1.x * __uint_as_float(w.z << 16) + n1.y * __uint_as_float(w.z & 0xffff0000u) + n1.z * __uint_as_float(w.w << 16) + n1.w * __uint_as_float(w.w & 0xffff0000u);
                    }
                    nq = acc + __shfl_xor(acc, 32);
                }
                {
                    const int k = wave * 8 + (lane >> 3), pc = lane & 7;
                    const uint4 w = *(const uint4*)(sm + ML_WKT + k * ML_RS + pc * 16);
                    float sacc = (__uint_as_float(w.x << 16) + __uint_as_float(w.x & 0xffff0000u)) + (__uint_as_float(w.y << 16) + __uint_as_float(w.y & 0xffff0000u))
                               + (__uint_as_float(w.z << 16) + __uint_as_float(w.z & 0xffff0000u)) + (__uint_as_float(w.w << 16) + __uint_as_float(w.w & 0xffff0000u));
                    sacc += __shfl_xor(sacc, 1); sacc += __shfl_xor(sacc, 2); sacc += __shfl_xor(sacc, 4);
                    if (pc == 0) a_n[(nb ^ 64) + k] = so * a_n[nb + k] + sacc;
                }
                f32x16 st0, st1, n2;
#pragma unroll
                for (int i = 0; i < 16; ++i) { st0[i] = 0.f; st1[i] = 0.f; n2[i] = 0.f; }
                float gs[2][16];
                if (do_out) {
#pragma unroll
                    for (int a = 0; a < 2; ++a)
#pragma unroll
                        for (int i = 0; i < 16; ++i) gs[a][i] = a_g[a * 32 + (i & 3) + 8 * (i >> 2) + 4 * hh];
#pragma unroll
                    for (int ks = 0; ks < 4; ++ks) {
                        const bf16x8 B = *(const bf16x8*)(sm + ML_Q + j * ML_RS + ks * 32 + hh * 16);
                        const bf16x8 A0 = *(const bf16x8*)(sm + ML_K + r * ML_RS + ks * 32 + hh * 16);
                        st0 = __builtin_amdgcn_mfma_f32_32x32x16_bf16(A0, B, st0, 0, 0, 0);
                        if (c == 1) {
                            const bf16x8 A1 = *(const bf16x8*)(sm + ML_K + (32 + r) * ML_RS + ks * 32 + hh * 16);
                            st1 = __builtin_amdgcn_mfma_f32_32x32x16_bf16(A1, B, st1, 0, 0, 0);
                        }
                    }
#pragma unroll
                    for (int s2 = 0; s2 < 2; ++s2) {
                        const bf16x8 B0 = ld2x4(sm + ML_Q + j * ML_RS + (16 * s2 + 4 * hh) * 2);
                        n2 = __builtin_amdgcn_mfma_f32_32x32x16_bf16(cvt8(X0, 8 * s2), B0, n2, 0, 0, 0);
                        const bf16x8 B1 = ld2x4(sm + ML_Q + j * ML_RS + (32 + 16 * s2 + 4 * hh) * 2);
                        n2 = __builtin_amdgcn_mfma_f32_32x32x16_bf16(cvt8(X1, 8 * s2), B1, n2, 0, 0, 0);
                    }
                }
#pragma unroll
                for (int i = 0; i < 16; ++i) { X0[i] *= so; X1[i] *= so; }
#pragma unroll
                for (int ks = 0; ks < 4; ++ks) {
                    const bf16x8 Bv = *(const bf16x8*)(sm + ML_VT + (vt * 32 + r) * ML_RS + (((ks * 16 + hh * 8) ^ (8 * ((2 * vt + (r >> 4)) & 7))) * 2));
                    const bf16x8 A0 = *(const bf16x8*)(sm + ML_WKT + r * ML_RS + (((ks * 16 + hh * 8) ^ (8 * ((r >> 3) & 7))) * 2));
                    X0 = __builtin_amdgcn_mfma_f32_32x32x16_bf16(A0, Bv, X0, 0, 0, 0);
                    const bf16x8 A1 = *(const bf16x8*)(sm + ML_WKT + (32 + r) * ML_RS + (((ks * 16 + hh * 8) ^ (8 * ((4 + (r >> 3)) & 7))) * 2));
                    X1 = __builtin_amdgcn_mfma_f32_32x32x16_bf16(A1, Bv, X1, 0, 0, 0);
                }
                if (do_out) {
                    float dsum = 0.f;
                    bf16x8 pf[2][2];
#pragma unroll
                    for (int i = 0; i < 16; ++i) {
                        const int s = (i & 3) + 8 * (i >> 2) + 4 * hh;
                        const float v = (s <= j) ? st0[i] * __expf(fminf(gs[0][i] - Mjv, 0.f)) : 0.f;
                        st0[i] = v; dsum += v;
                    }
                    pf[0][0] = cvt8(st0, 0); pf[0][1] = cvt8(st0, 8);
                    if (c == 1) {
#pragma unroll
                        for (int i = 0; i < 16; ++i) {
                            const int s = 32 + (i & 3) + 8 * (i >> 2) + 4 * hh;
                            const float v = (s <= j) ? st1[i] * __expf(fminf(gs[1][i] - Mjv, 0.f)) : 0.f;
                            st1[i] = v; dsum += v;
                        }
                        pf[1][0] = cvt8(st1, 0); pf[1][1] = cvt8(st1, 8);
                    }
                    f32x16 n1;
#pragma unroll
                    for (int i = 0; i < 16; ++i) n1[i] = 0.f;
#pragma unroll
                    for (int s2 = 0; s2 < 2; ++s2) {
                        const bf16x8 A = ld2x4x(sm + ML_VT + (vt * 32 + r) * ML_RS, 16 * s2 + 4 * hh, 8 * ((2 * vt + (r >> 4)) & 7));
                        n1 = __builtin_amdgcn_mfma_f32_32x32x16_bf16(A, pf[0][s2], n1, 0, 0, 0);
                    }
                    if (c == 1) {
#pragma unroll
                        for (int s2 = 0; s2 < 2; ++s2) {
                            const bf16x8 A = ld2x4x(sm + ML_VT + (vt * 32 + r) * ML_RS, 32 + 16 * s2 + 4 * hh, 8 * ((2 * vt + (r >> 4)) & 7));
                            n1 = __builtin_amdgcn_mfma_f32_32x32x16_bf16(A, pf[1][s2], n1, 0, 0, 0);
                        }
                    }
                    dsum += __shfl_xor(dsum, 32);
                    const float den = dsum + interj * nq;
                    const float rd = 1.f / fmaxf(fabsf(den), a_edn[j]);
#pragma unroll
                    for (int g4 = 0; g4 < 4; ++g4) {
                        uint2 w;
                        w.x = pk_bf16((n1[4 * g4] + interj * n2[4 * g4]) * rd, (n1[4 * g4 + 1] + interj * n2[4 * g4 + 1]) * rd);
                        w.y = pk_bf16((n1[4 * g4 + 2] + interj * n2[4 * g4 + 2]) * rd, (n1[4 * g4 + 3] + interj * n2[4 * g4 + 3]) * rd);
                        *(uint2*)(sm + ML_OUT + j * 272 + (vt * 32 + 8 * g4 + 4 * hh) * 2) = w;
                    }
                }
            }
            lds_barrier();
            if (do_out) {
                const int pos = cl * 64 + srow; const int t = dir ? Ts - 1 - pos : pos;
                bf16_t* dst = hdir + ((size_t)dir * M + base + t) * 512 + h * 128 + part * 16;
                *(uint4*)dst = *(const uint4*)(sm + ML_OUT + srow * 272 + part * 32);
                *(uint4*)(dst + 8) = *(const uint4*)(sm + ML_OUT + srow * 272 + part * 32 + 16);
            }
        }
    }
}

constexpr size_t NVT_CTX = (size_t)128 * 32 * 4096;
__device__ __forceinline__ void phase_vtrans(const P& p, unsigned char* sm) {
    const bf16_t* nv = (const bf16_t*)(p.ws + WS_NV);
    bf16_t* nvT = (bf16_t*)(p.ws + WS_NVT);
    const int tid = opaque_tid();
    for (int it = blockIdx.x; it < 128 * 36; it += gridDim.x) {
        const int bh = it / 36, tt = it % 36, b = bh >> 3, h = bh & 7;
        const int row0 = tt < 32 ? b * T + tt * 64 : ML + b * CT + (tt - 32) * 64;
        __syncthreads();
        {
            const int tk = tid >> 3, pc = tid & 7;
            const uint4 v = *(const uint4*)(nv + (size_t)(row0 + tk) * 512 + h * 64 + pc * 8);
            const unsigned w[4] = {v.x, v.y, v.z, v.w};
#pragma unroll
            for (int i = 0; i < 4; ++i) {
                *(bf16_t*)(sm + (pc * 8 + 2 * i) * 144 + tk * 2) = (bf16_t)(w[i] & 0xffffu);
                *(bf16_t*)(sm + (pc * 8 + 2 * i + 1) * 144 + tk * 2) = (bf16_t)(w[i] >> 16);
            }
        }
        __syncthreads();
        {
            const int d = tid >> 3, pc = tid & 7;
            const uint4 v8 = *(const uint4*)(sm + d * 144 + pc * 16);
            if (tt < 32) *(uint4*)(nvT + ((size_t)(bh * 32 + tt) * 8 + pc) * 512 + d * 8) = v8;
            else *(uint4*)(nvT + NVT_CTX + ((size_t)bh * 64 + d) * 256 + (tt - 32) * 64 + pc * 8) = v8;
        }
    }
    __syncthreads();
}

typedef float f32x4v __attribute__((ext_vector_type(4)));
constexpr int NA_KC = 0, NA_VC = 36864, NA_RPB = 36864 + 33792, NA_CTL = NA_RPB + 14880;
constexpr size_t WS_CNT = 0xE4000;
__device__ __forceinline__ void phase_na(const P& p, int l, unsigned char* sm) {
    const bool need_ctx = (l == 0);
    const bf16_t* nq = (const bf16_t*)(p.ws + WS_NQ); const bf16_t* nk = (const bf16_t*)(p.ws + WS_NK);
    const bf16_t* nvT = (const bf16_t*)(p.ws + WS_NVT);
    bf16_t* mix = (bf16_t*)(p.ws + WS_MIX);
    unsigned* counter = (unsigned*)(p.ws + WS_CNT) + 16 * l;
    const int tid = opaque_tid(); const int lane = tid & 63, wave = tid >> 6;
    float* rpb_s = (float*)(sm + NA_RPB);
    volatile int* ctl = (volatile int*)(sm + NA_CTL);
    __syncthreads();
    {
        float rv[8];
#pragma unroll
        for (int q = 0; q < 8; ++q) { const int i = tid + NT * q; rv[q] = i < 8 * 465 ? p.na_rpb[(size_t)l * 8 * 465 + i] : 0.f; }
#pragma unroll
        for (int q = 0; q < 8; ++q) { const int i = tid + NT * q; if (i < 8 * 465) rpb_s[i] = rv[q]; }
    }
    for (;;) {
        __syncthreads();
        if (tid == 0) ctl[0] = (int)atomicAdd(counter, 1u);
        __syncthreads();
        const int item = ctl[0];
        const int nitems = need_ctx ? 640 : 512;
        if (item >= nitems) break;
        const bool cq_item = item >= 512;
        const int bh = cq_item ? (item - 512) : (item >> 2), quarter = item & 3, b = bh >> 3, h = bh & 7;
        {
            uint4 kv[4], vv[4];
#pragma unroll
            for (int i = 0; i < 4; ++i) { const int id = tid + NT * i;
                kv[i] = *(const uint4*)(nk + (size_t)(ML + b * CT + (id >> 3)) * 512 + h * 64 + (id & 7) * 8);
                vv[i] = *(const uint4*)(nvT + NVT_CTX + ((size_t)bh * 64 + (id >> 5)) * 256 + (id & 31) * 8); }
#pragma unroll
            for (int i = 0; i < 4; ++i) { const int id = tid + NT * i;
                *(uint4*)(sm + NA_KC + (id >> 3) * 144 + (id & 7) * 16) = kv[i];
                *(uint4*)(sm + NA_VC + (id >> 5) * 528 + (id & 31) * 16) = vv[i]; }
        }
        __syncthreads();
        const int nun = cq_item ? 16 : 32;
        for (int un = wave; un < nun; un += NW) {
            int lane_o = lane; asm volatile("" : "+v"(lane_o));
            const int fr = lane_o & 15, fq = lane_o >> 4, krow_off = 8 * (fr >> 2) + (fr & 3);
            const bool lat = !cq_item;
            int qtok0, r = 0, cb = 0;
            if (lat) { r = quarter * 8 + (un >> 2); cb = un & 3; qtok0 = b * T + r * 64 + cb * 16; }
            else qtok0 = ML + b * CT + un * 16;
            const int r0 = min(max(r - 4, 0), 24);
            const int c0 = min(max(cb * 16 - 8, 0), 32);
            const int qc = cb * 16 + fr;
            const int wl = min(max(qc - 8, 0), 48);
            const bf16_t* qp = nq + (size_t)(qtok0 + fr) * 512 + h * 64 + 8 * fq;
            const bf16x8 qf0 = *(const bf16x8*)qp, qf1 = *(const bf16x8*)(qp + 32);
            float mrun = -1e30f, sum = 0.f;
            f32x4v o[4];
#pragma unroll
            for (int m = 0; m < 4; ++m) o[m] = (f32x4v){0.f, 0.f, 0.f, 0.f};
#define NA_GROUP(S0, S1, VF0, VF1, VF2, VF3) do { \
                float gm_ = fmaxf(fmaxf(fmaxf(S0[0], S0[1]), fmaxf(S0[2], S0[3])), fmaxf(fmaxf(S1[0], S1[1]), fmaxf(S1[2], S1[3]))); \
                gm_ = fmaxf(gm_, __shfl_xor(gm_, 16)); gm_ = fmaxf(gm_, __shfl_xor(gm_, 32)); \
                const float mn_ = fmaxf(mrun, gm_); const float al_ = __expf(mrun - mn_); mrun = mn_; \
                float ps_ = 0.f; \
                _Pragma("unroll") for (int j_ = 0; j_ < 4; ++j_) { S0[j_] = __expf(S0[j_] - mn_); S1[j_] = __expf(S1[j_] - mn_); ps_ += S0[j_] + S1[j_]; } \
                sum = sum * al_ + ps_; \
                _Pragma("unroll") for (int m_ = 0; m_ < 4; ++m_) { o[m_][0] *= al_; o[m_][1] *= al_; o[m_][2] *= al_; o[m_][3] *= al_; } \
                union { unsigned u[4]; bf16x8 v; } pf_; \
                pf_.u[0] = pk_bf16(S0[0], S0[1]); pf_.u[1] = pk_bf16(S0[2], S0[3]); pf_.u[2] = pk_bf16(S1[0], S1[1]); pf_.u[3] = pk_bf16(S1[2], S1[3]); \
                o[0] = __builtin_amdgcn_mfma_f32_16x16x32_bf16(VF0, pf_.v, o[0], 0, 0, 0); o[1] = __builtin_amdgcn_mfma_f32_16x16x32_bf16(VF1, pf_.v, o[1], 0, 0, 0); \
                o[2] = __builtin_amdgcn_mfma_f32_16x16x32_bf16(VF2, pf_.v, o[2], 0, 0, 0); o[3] = __builtin_amdgcn_mfma_f32_16x16x32_bf16(VF3, pf_.v, o[3], 0, 0, 0); } while (0)
            if (lat) {
                const float* rp = rpb_s + h * 465;
                const bf16_t* vbase = nvT + (size_t)(bh * 32 + r0) * 4096 + ((c0 >> 3) + fq) * 512 + fr * 8;
                const bf16_t* kbase = nk + nk_frag_off(bh, r0, (c0 >> 3) + (fr >> 2), 0, 0, fr & 3, fq);
                int dcv[8]; bool okv[8];
#pragma unroll
                for (int j = 0; j < 8; ++j) { const int kc = c0 + 8 * fq + j; okv[j] = (kc >= wl) && (kc < wl + 16); dcv[j] = min(max(kc - qc + 15, 0), 30); }
#define NA_LOADG(K, V, i) do { \
                    const bf16_t* kp_ = kbase + (size_t)(i) * 4096; \
                    K[0] = *(const bf16x8*)kp_; K[1] = *(const bf16x8*)(kp_ + 128); K[2] = *(const bf16x8*)(kp_ + 256); K[3] = *(const bf16x8*)(kp_ + 384); \
                    const bf16_t* vp_ = vbase + (size_t)(i) * 4096; \
                    V[0] = *(const bf16x8*)vp_; V[1] = *(const bf16x8*)(vp_ + 128); V[2] = *(const bf16x8*)(vp_ + 256); V[3] = *(const bf16x8*)(vp_ + 384); \
                    } while (0)
#define NA_COMPG(K, V, i) do { \
                    float BB[8]; const float* rr_ = rp + (r0 + (i) - r + 7) * 31; \
                    _Pragma("unroll") for (int j_ = 0; j_ < 8; ++j_) BB[j_] = rr_[dcv[j_]]; \
                    f32x4v a0_ = {0.f, 0.f, 0.f, 0.f}, a1_ = {0.f, 0.f, 0.f, 0.f}; \
                    a0_ = __builtin_amdgcn_mfma_f32_16x16x32_bf16(K[0], qf0, a0_, 0, 0, 0); a0_ = __builtin_amdgcn_mfma_f32_16x16x32_bf16(K[1], qf1, a0_, 0, 0, 0); \
                    a1_ = __builtin_amdgcn_mfma_f32_16x16x32_bf16(K[2], qf0, a1_, 0, 0, 0); a1_ = __builtin_amdgcn_mfma_f32_16x16x32_bf16(K[3], qf1, a1_, 0, 0, 0); \
                    _Pragma("unroll") for (int j_ = 0; j_ < 4; ++j_) { a0_[j_] = okv[j_] ? a0_[j_] + BB[j_] : -1e30f; a1_[j_] = okv[4 + j_] ? a1_[j_] + BB[4 + j_] : -1e30f; } \
                    NA_GROUP(a0_, a1_, V[0], V[1], V[2], V[3]); } while (0)
                bf16x8 KA[4], VA[4], KB[4], VB[4];
                NA_LOADG(KA, VA, 0);
                NA_LOADG(KB, VB, 1); NA_COMPG(KA, VA, 0);
                NA_LOADG(KA, VA, 2); NA_COMPG(KB, VB, 1);
                NA_LOADG(KB, VB, 3); NA_COMPG(KA, VA, 2);
                NA_LOADG(KA, VA, 4); NA_COMPG(KB, VB, 3);
                NA_LOADG(KB, VB, 5); NA_COMPG(KA, VA, 4);
                NA_LOADG(KA, VA, 6); NA_COMPG(KB, VB, 5);
                NA_LOADG(KB, VB, 7); NA_COMPG(KA, VA, 6);
                NA_COMPG(KB, VB, 7);
#undef NA_LOADG
#undef NA_COMPG
            }
#pragma unroll
            for (int pg = 0; pg < 8; ++pg) {
                const unsigned char* kp = sm + NA_KC + (32 * pg + krow_off) * 144 + 16 * fq;
                const bf16x8 k00 = *(const bf16x8*)kp, k01 = *(const bf16x8*)(kp + 64);
                const bf16x8 k10 = *(const bf16x8*)(kp + 4 * 144), k11 = *(const bf16x8*)(kp + 4 * 144 + 64);
                const unsigned char* vp = sm + NA_VC + fr * 528 + (32 * pg + 8 * fq) * 2;
                const bf16x8 vf0 = *(const bf16x8*)vp, vf1 = *(const bf16x8*)(vp + 16 * 528), vf2 = *(const bf16x8*)(vp + 32 * 528), vf3 = *(const bf16x8*)(vp + 48 * 528);
                f32x4v a0 = {0.f, 0.f, 0.f, 0.f}, a1 = {0.f, 0.f, 0.f, 0.f};
                a0 = __builtin_amdgcn_mfma_f32_16x16x32_bf16(k00, qf0, a0, 0, 0, 0); a0 = __builtin_amdgcn_mfma_f32_16x16x32_bf16(k01, qf1, a0, 0, 0, 0);
                a1 = __builtin_amdgcn_mfma_f32_16x16x32_bf16(k10, qf0, a1, 0, 0, 0); a1 = __builtin_amdgcn_mfma_f32_16x16x32_bf16(k11, qf1, a1, 0, 0, 0);
                NA_GROUP(a0, a1, vf0, vf1, vf2, vf3);
            }
#undef NA_GROUP
            sum += __shfl_xor(sum, 16); sum += __shfl_xor(sum, 32);
            const float rs = 1.f / sum;
            bf16_t* op = mix + (size_t)(qtok0 + fr) * 1024 + 512 + h * 64 + 4 * fq;
#pragma unroll
            for (int m = 0; m < 4; ++m) {
                uint2 w; w.x = pk_bf16(o[m][0] * rs, o[m][1] * rs); w.y = pk_bf16(o[m][2] * rs, o[m][3] * rs);
                *(uint2*)(op + m * 16) = w;
            }
        }
    }
}

__device__ __forceinline__ void phase_combine(const P& p, int l) {
    const bool need_ctx = (l == 0);
    const bf16_t* hdir = (const bf16_t*)(p.ws + WS_HDIR); const bf16_t* ob = (const bf16_t*)(p.ws + WS_O);
    bf16_t* mix = (bf16_t*)(p.ws + WS_MIX);
    const int tid_ = opaque_tid(); const int lane = tid_ & 63, wave = tid_ >> 6;
    const float4 nw0 = *(const float4*)(p.ml_norm_w + l * 512 + lane * 8), nw1 = *(const float4*)(p.ml_norm_w + l * 512 + lane * 8 + 4);
    const float nw[8] = {nw0.x, nw0.y, nw0.z, nw0.w, nw1.x, nw1.y, nw1.z, nw1.w};
    const int rows = need_ctx ? M : ML;
    for (int r = blockIdx.x * NW + wave; r < rows; r += gridDim.x * NW) {
        const size_t o0 = (size_t)r * 512 + lane * 8;
        const uint4 a = *(const uint4*)(hdir + o0), b = *(const uint4*)(hdir + (size_t)M * 512 + o0), og = *(const uint4*)(ob + o0);
        const unsigned aw[4] = {a.x, a.y, a.z, a.w}, bw[4] = {b.x, b.y, b.z, b.w}, gw[4] = {og.x, og.y, og.z, og.w};
        float v[8]; float s = 0.f;
#pragma unroll
        for (int i = 0; i < 4; ++i) {
            v[2 * i] = __uint_as_float(aw[i] << 16) + __uint_as_float(bw[i] << 16);
            v[2 * i + 1] = __uint_as_float(aw[i] & 0xffff0000u) + __uint_as_float(bw[i] & 0xffff0000u);
            s += v[2 * i] + v[2 * i + 1];
        }
        s += __shfl_xor(s, 8); s += __shfl_xor(s, 4); s += __shfl_xor(s, 2); s += __shfl_xor(s, 1);
        const float mu = s * (1.f / 128.f);
        float q = 0.f;
#pragma unroll
        for (int i = 0; i < 8; ++i) { v[i] -= mu; q += v[i] * v[i]; }
        q += __shfl_xor(q, 8); q += __shfl_xor(q, 4); q += __shfl_xor(q, 2); q += __shfl_xor(q, 1);
        const float rstd = rsqrtf(q * (1.f / 128.f) + LN_EPS);
        float o[8];
#pragma unroll
        for (int i = 0; i < 4; ++i) {
            o[2 * i] = v[2 * i] * rstd * nw[2 * i] * sigmoidf(__uint_as_float(gw[i] << 16));
            o[2 * i + 1] = v[2 * i + 1] * rstd * nw[2 * i + 1] * sigmoidf(__uint_as_float(gw[i] & 0xffff0000u));
        }
        *(uint4*)(mix + (size_t)r * 1024 + lane * 8) = make_uint4(pk_bf16(o[0], o[1]), pk_bf16(o[2], o[3]), pk_bf16(o[4], o[5]), pk_bf16(o[6], o[7]));
    }
}

__device__ __forceinline__ void phase_outproj(const P& p, int l, unsigned char* smraw) {
    const int rows = (l == 0) ? M : ML;
    pg8::Gemm g{(const pg8::bf16_t*)(p.ws + WS_MIX), (const pg8::bf16_t*)(p.ws + WS_WOUT) + (size_t)l * 1024 * 1024, rows, 1024, 1024};
    pg8::StaticOrder S; S.init(rows, 1024, (int)gridDim.x, (int)blockIdx.x);
    pg8::EpiBf16<0> E{(pg8::bf16_t*)(p.ws + WS_Y), 1024, nullptr, 0, 0};
    pg8::gemm_phase<pg8::EpiBf16<0>, pg8::StaticOrder, false>((PG8_LAS unsigned char*)smraw, g, S, E, nullptr);
}

__device__ __forceinline__ void phase_ln1(const P& p, int l) {
    const bf16_t* y = (const bf16_t*)(p.ws + WS_Y);
    bf16_t* u2 = (bf16_t*)(p.ws + WS_U2);
    const float* lw = p.ln1_w + l * D; const float* lb = p.ln1_b + l * D;
    const int tid_ = opaque_tid(); const int lane = tid_ & 63, wave = tid_ >> 6;
    const int rows = (l == 0) ? M : ML;
    const int k0 = lane * 16;
    for (int rp = blockIdx.x * NW + wave; rp < rows / 2; rp += gridDim.x * NW) {
        float z[2][16]; float s[2] = {0.f, 0.f};
#pragma unroll
        for (int h = 0; h < 2; ++h) {
            const int r = 2 * rp + h;
            const float* xr = xrow(p, l, r); const float* mp = modp(p, l, r);
            const uint4 ya = *(const uint4*)(y + (size_t)r * 1024 + k0), yb = *(const uint4*)(y + (size_t)r * 1024 + k0 + 8);
            const unsigned yw[8] = {ya.x, ya.y, ya.z, ya.w, yb.x, yb.y, yb.z, yb.w};
#pragma unroll
            for (int v4 = 0; v4 < 4; ++v4) {
                const float4 xv = *(const float4*)(xr + k0 + v4 * 4), g1 = *(const float4*)(mp + 2048 + k0 + v4 * 4);
                z[h][v4 * 4 + 0] = ALPHA * xv.x + g1.x * __uint_as_float(yw[v4 * 2] << 16);
                z[h][v4 * 4 + 1] = ALPHA * xv.y + g1.y * __uint_as_float(yw[v4 * 2] & 0xffff0000u);
                z[h][v4 * 4 + 2] = ALPHA * xv.z + g1.z * __uint_as_float(yw[v4 * 2 + 1] << 16);
                z[h][v4 * 4 + 3] = ALPHA * xv.w + g1.w * __uint_as_float(yw[v4 * 2 + 1] & 0xffff0000u);
                s[h] += (z[h][v4 * 4] + z[h][v4 * 4 + 1]) + (z[h][v4 * 4 + 2] + z[h][v4 * 4 + 3]);
            }
        }
        float mu[2], rstd[2];
#pragma unroll
        for (int h = 0; h < 2; ++h) mu[h] = wave_sum(s[h]) * (1.f / 1024.f);
#pragma unroll
        for (int h = 0; h < 2; ++h) {
            float q = 0.f;
#pragma unroll
            for (int i = 0; i < 16; ++i) { const float d = z[h][i] - mu[h]; q += d * d; }
            rstd[h] = rsqrtf(wave_sum(q) * (1.f / 1024.f) + LN_EPS);
        }
#pragma unroll
        for (int h = 0; h < 2; ++h) {
            const int r = 2 * rp + h;
            const float* mp = modp(p, l, r);
            float* xo = xrow_w(p, r);
            float uo[16]; float am = 0.f; float x1v[16];
#pragma unroll
            for (int v4 = 0; v4 < 4; ++v4) {
                const int k = k0 + v4 * 4;
                const float4 w4 = *(const float4*)(lw + k), b4 = *(const float4*)(lb + k), sc = *(const float4*)(mp + 4096 + k), sh = *(const float4*)(mp + 3072 + k);
                float4 o;
                o.x = (z[h][v4 * 4] - mu[h]) * rstd[h] * w4.x + b4.x; o.y = (z[h][v4 * 4 + 1] - mu[h]) * rstd[h] * w4.y + b4.y;
                o.z = (z[h][v4 * 4 + 2] - mu[h]) * rstd[h] * w4.z + b4.z; o.w = (z[h][v4 * 4 + 3] - mu[h]) * rstd[h] * w4.w + b4.w;
                x1v[v4 * 4] = o.x; x1v[v4 * 4 + 1] = o.y; x1v[v4 * 4 + 2] = o.z; x1v[v4 * 4 + 3] = o.w;
                uo[v4 * 4] = o.x * (1.f + sc.x) + sh.x; uo[v4 * 4 + 1] = o.y * (1.f + sc.y) + sh.y; uo[v4 * 4 + 2] = o.z * (1.f + sc.z) + sh.z; uo[v4 * 4 + 3] = o.w * (1.f + sc.w) + sh.w;
            }
            {
                bf16_t* xb = (bf16_t*)xo + k0;
                *(uint4*)xb = make_uint4(pk_bf16(x1v[0], x1v[1]), pk_bf16(x1v[2], x1v[3]), pk_bf16(x1v[4], x1v[5]), pk_bf16(x1v[6], x1v[7]));
                *(uint4*)(xb + 8) = make_uint4(pk_bf16(x1v[8], x1v[9]), pk_bf16(x1v[10], x1v[11]), pk_bf16(x1v[12], x1v[13]), pk_bf16(x1v[14], x1v[15]));
            }
            bf16_t* up_ = u2 + (size_t)r * 1024 + k0;
            *(uint4*)up_ = make_uint4(pk_bf16(uo[0], uo[1]), pk_bf16(uo[2], uo[3]), pk_bf16(uo[4], uo[5]), pk_bf16(uo[6], uo[7]));
            *(uint4*)(up_ + 8) = make_uint4(pk_bf16(uo[8], uo[9]), pk_bf16(uo[10], uo[11]), pk_bf16(uo[12], uo[13]), pk_bf16(uo[14], uo[15]));
#pragma unroll
            for (int i = 0; i < 16; ++i) am = fmaxf(am, fabsf(uo[i]));
            am = wave_max(am);
            const float inv = am > 0.f ? 127.f / am : 0.f;
            unsigned w[4];
#pragma unroll
            for (int d = 0; d < 4; ++d) {
                unsigned x = 0;
#pragma unroll
                for (int i = 0; i < 4; ++i) x |= (unsigned)(min(max((int)rintf(uo[d * 4 + i] * inv), -127), 127) & 0xff) << (8 * i);
                w[d] = x;
            }
            *(uint4*)(p.ws + WS_U2Q + (size_t)r * 1024 + k0) = make_uint4(w[0], w[1], w[2], w[3]);
            if (lane == 0) ((float*)(p.ws + WS_USC))[r] = am > 0.f ? am / 127.f : 0.f;
        }
    }
}

__device__ __forceinline__ void phase_peerq(const P& p, int l, unsigned char* smraw) {
    const int rows = (l == 0) ? M : ML;
    pg8::Gemm g{(const pg8::bf16_t*)(p.ws + WS_U2), (const pg8::bf16_t*)(p.ws + WS_WQ) + (size_t)l * 2048 * 1024, rows, 2048, 1024};
    pg8::StaticOrder S; S.init(rows, 2048, (int)gridDim.x, (int)blockIdx.x);
    pg8::EpiBf16<0> E{(pg8::bf16_t*)(p.ws + WS_Q), 2048, nullptr, 0, 0};
    pg8::gemm_phase<pg8::EpiBf16<0>, pg8::StaticOrder, false>((PG8_LAS unsigned char*)smraw, g, S, E, nullptr);
}

__device__ __forceinline__ unsigned f2key(float f) { const unsigned u = __float_as_uint(f); return (u & 0x80000000u) ? ~u : (u | 0x80000000u); }
__device__ __forceinline__ float key2f(unsigned k) { const unsigned u = (k & 0x80000000u) ? (k & 0x7fffffffu) : ~k; return __uint_as_float(u); }
__device__ __forceinline__ void ce_desc(unsigned& a, unsigned& b) { const unsigned mx = a > b ? a : b, mn = a > b ? b : a; a = mx; b = mn; }
__device__ __forceinline__ void sort16_desc(unsigned (&a)[16]) {
#pragma unroll
    for (int k = 2; k <= 16; k <<= 1)
#pragma unroll
        for (int j = k >> 1; j > 0; j >>= 1)
#pragma unroll
            for (int i = 0; i < 16; ++i) { const int l = i ^ j; if (l > i) { if ((i & k) == 0) ce_desc(a[i], a[l]); else ce_desc(a[l], a[i]); } }
}
__device__ __forceinline__ void merge16_desc(unsigned (&a)[16], const unsigned (&b)[16]) {
#pragma unroll
    for (int i = 0; i < 16; ++i) a[i] = a[i] > b[15 - i] ? a[i] : b[15 - i];
#pragma unroll
    for (int j = 8; j > 0; j >>= 1)
#pragma unroll
        for (int i = 0; i < 16; ++i) { const int l = i ^ j; if (l > i) ce_desc(a[i], a[l]); }
}
__device__ __forceinline__ void top16_of_acc(const f32x16 (&acc)[4], int hh, unsigned (&out)[16]) {
    unsigned g1[16], g2[16], g3[16];
#pragma unroll
    for (int r = 0; r < 16; ++r) {
        const int nb = (r & 3) + 8 * (r >> 2);
        out[r] = (f2key(acc[0][r]) & ~127u) | (unsigned)(127 - (nb + 4 * hh));
        g1[r]  = (f2key(acc[1][r]) & ~127u) | (unsigned)(127 - (32 + nb + 4 * hh));
        g2[r]  = (f2key(acc[2][r]) & ~127u) | (unsigned)(127 - (64 + nb + 4 * hh));
        g3[r]  = (f2key(acc[3][r]) & ~127u) | (unsigned)(127 - (96 + nb + 4 * hh));
    }
    sort16_desc(out); sort16_desc(g1); sort16_desc(g2); sort16_desc(g3);
    merge16_desc(out, g1); merge16_desc(g2, g3); merge16_desc(out, g2);
#pragma unroll
    for (int i = 0; i < 16; ++i) g1[i] = (unsigned)__shfl_xor((int)out[i], 32);
    merge16_desc(out, g1);
}
constexpr int TK_KEYS_BYTES = 256 * 272;
__device__ __forceinline__ void phase_topk(const P& p, int l, unsigned char* smraw) {
    const bf16_t* q = (const bf16_t*)(p.ws + WS_Q);
    int* eidx = (int*)(p.ws + WS_EIDX); float* egate = (float*)(p.ws + WS_EGATE);
    const int tid = opaque_tid(); const int lane = tid & 63, wave = tid >> 6, tl = lane & 31, hh = lane >> 5;
    unsigned char* keys_lds = smraw;
    PG8_LAS unsigned char* slot = (PG8_LAS unsigned char*)smraw + TK_KEYS_BYTES + wave * 2048 + lane * 32;
    const int rows = (l == 0) ? M : ML;
    const int nchunks = rows / 256;
    int cur_h = -1;
    for (int it = blockIdx.x; it < 8 * nchunks; it += gridDim.x) {
        const int h = it & 7, chunk = it >> 3;
        if (h != cur_h) {
            __syncthreads();
            const float* kb = p.peer_keys + (size_t)(l * 8 + h) * 2 * 128 * 128;
            {
                float4 f0[8], f1[8];
#pragma unroll
                for (int q = 0; q < 8; ++q) { const int i = tid + NT * q; const int row = i >> 4, c8 = i & 15;
                    f0[q] = *(const float4*)(kb + (size_t)row * 128 + c8 * 8); f1[q] = *(const float4*)(kb + (size_t)row * 128 + c8 * 8 + 4); }
#pragma unroll
                for (int q = 0; q < 8; ++q) { const int i = tid + NT * q; const int row = i >> 4, c8 = i & 15;
                    uint4 w; w.x = pk_bf16(f0[q].x, f0[q].y); w.y = pk_bf16(f0[q].z, f0[q].w); w.z = pk_bf16(f1[q].x, f1[q].y); w.w = pk_bf16(f1[q].z, f1[q].w);
                    *(uint4*)(keys_lds + row * 272 + c8 * 16) = w; }
            }
            __syncthreads();
            cur_h = h;
        }
        const int t0 = (chunk * 8 + wave) * 32;
        const bf16_t* qrow = q + (size_t)(t0 + tl) * 2048 + h * 256 + 8 * hh;
        unsigned T1[16], T2[16];
#pragma unroll
        for (int half = 0; half < 2; ++half) {
            bf16x8 bq[8];
#pragma unroll
            for (int ks = 0; ks < 8; ++ks) bq[ks] = *(const bf16x8*)(qrow + half * 128 + ks * 16);
            f32x16 acc[4];
#pragma unroll
            for (int mt = 0; mt < 4; ++mt)
#pragma unroll
                for (int r = 0; r < 16; ++r) acc[mt][r] = 0.f;
#pragma unroll
            for (int ks = 0; ks < 8; ++ks)
#pragma unroll
                for (int mt = 0; mt < 4; ++mt) {
                    const bf16x8 a = *(const bf16x8*)(keys_lds + (half * 128 + mt * 32 + tl) * 272 + ks * 32 + 16 * hh);
                    acc[mt] = __builtin_amdgcn_mfma_f32_32x32x16_bf16(a, bq[ks], acc[mt], 0, 0, 0);
                }
            if (half == 0) top16_of_acc(acc, hh, T1); else top16_of_acc(acc, hh, T2);
        }
        {
            uint4 w1, w2;
#define PK4(T, o) ((127u - (T[o] & 127u)) | ((127u - (T[o + 1] & 127u)) << 8) | ((127u - (T[o + 2] & 127u)) << 16) | ((127u - (T[o + 3] & 127u)) << 24))
            w1.x = PK4(T1, 0); w1.y = PK4(T1, 4); w1.z = PK4(T1, 8); w1.w = PK4(T1, 12);
            w2.x = PK4(T2, 0); w2.y = PK4(T2, 4); w2.z = PK4(T2, 8); w2.w = PK4(T2, 12);
#undef PK4
            *(PG8_LAS pg8::u32x4*)slot = (pg8::u32x4){w1.x, w1.y, w1.z, w1.w}; *(PG8_LAS pg8::u32x4*)(slot + 16) = (pg8::u32x4){w2.x, w2.y, w2.z, w2.w};
        }
        float v1[16], v2[16];
#pragma unroll
        for (int i = 0; i < 16; ++i) { v1[i] = key2f(T1[i] & ~127u); v2[i] = key2f(T2[i] & ~127u); }
        unsigned cg0[16], cg1[16], cg2[16], cg3[16];
        cg0[0] = (f2key(v1[0] + v2[0]) & ~255u) | 255u;
        cg0[1] = (f2key(v1[0] + v2[1]) & ~255u) | 254u;
        cg0[2] = (f2key(v1[0] + v2[2]) & ~255u) | 253u;
        cg0[3] = (f2key(v1[0] + v2[3]) & ~255u) | 252u;
        cg0[4] = (f2key(v1[0] + v2[4]) & ~255u) | 251u;
        cg0[5] = (f2key(v1[0] + v2[5]) & ~255u) | 250u;
        cg0[6] = (f2key(v1[0] + v2[6]) & ~255u) | 249u;
        cg0[7] = (f2key(v1[0] + v2[7]) & ~255u) | 248u;
        cg0[8] = (f2key(v1[0] + v2[8]) & ~255u) | 247u;
        cg0[9] = (f2key(v1[0] + v2[9]) & ~255u) | 246u;
        cg0[10] = (f2key(v1[0] + v2[10]) & ~255u) | 245u;
        cg0[11] = (f2key(v1[0] + v2[11]) & ~255u) | 244u;
        cg0[12] = (f2key(v1[0] + v2[12]) & ~255u) | 243u;
        cg0[13] = (f2key(v1[0] + v2[13]) & ~255u) | 242u;
        cg0[14] = (f2key(v1[0] + v2[14]) & ~255u) | 241u;
        cg0[15] = (f2key(v1[0] + v2[15]) & ~255u) | 240u;
        cg1[0] = (f2key(v1[1] + v2[0]) & ~255u) | 239u;
        cg1[1] = (f2key(v1[1] + v2[1]) & ~255u) | 238u;
        cg1[2] = (f2key(v1[1] + v2[2]) & ~255u) | 237u;
        cg1[3] = (f2key(v1[1] + v2[3]) & ~255u) | 236u;
        cg1[4] = (f2key(v1[1] + v2[4]) & ~255u) | 235u;
        cg1[5] = (f2key(v1[1] + v2[5]) & ~255u) | 234u;
        cg1[6] = (f2key(v1[1] + v2[6]) & ~255u) | 233u;
        cg1[7] = (f2key(v1[1] + v2[7]) & ~255u) | 232u;
        cg1[8] = (f2key(v1[2] + v2[0]) & ~255u) | 223u;
        cg1[9] = (f2key(v1[2] + v2[1]) & ~255u) | 222u;
        cg1[10] = (f2key(v1[2] + v2[2]) & ~255u) | 221u;
        cg1[11] = (f2key(v1[2] + v2[3]) & ~255u) | 220u;
        cg1[12] = (f2key(v1[2] + v2[4]) & ~255u) | 219u;
        cg1[13] = (f2key(v1[3] + v2[0]) & ~255u) | 207u;
        cg1[14] = (f2key(v1[3] + v2[1]) & ~255u) | 206u;
        cg1[15] = (f2key(v1[3] + v2[2]) & ~255u) | 205u;
        cg2[0] = (f2key(v1[3] + v2[3]) & ~255u) | 204u;
        cg2[1] = (f2key(v1[4] + v2[0]) & ~255u) | 191u;
        cg2[2] = (f2key(v1[4] + v2[1]) & ~255u) | 190u;
        cg2[3] = (f2key(v1[4] + v2[2]) & ~255u) | 189u;
        cg2[4] = (f2key(v1[5] + v2[0]) & ~255u) | 175u;
        cg2[5] = (f2key(v1[5] + v2[1]) & ~255u) | 174u;
        cg2[6] = (f2key(v1[6] + v2[0]) & ~255u) | 159u;
        cg2[7] = (f2key(v1[6] + v2[1]) & ~255u) | 158u;
        cg2[8] = (f2key(v1[7] + v2[0]) & ~255u) | 143u;
        cg2[9] = (f2key(v1[7] + v2[1]) & ~255u) | 142u;
        cg2[10] = (f2key(v1[8] + v2[0]) & ~255u) | 127u;
        cg2[11] = (f2key(v1[9] + v2[0]) & ~255u) | 111u;
        cg2[12] = (f2key(v1[10] + v2[0]) & ~255u) | 95u;
        cg2[13] = (f2key(v1[11] + v2[0]) & ~255u) | 79u;
        cg2[14] = (f2key(v1[12] + v2[0]) & ~255u) | 63u;
        cg2[15] = (f2key(v1[13] + v2[0]) & ~255u) | 47u;
        cg3[0] = (f2key(v1[14] + v2[0]) & ~255u) | 31u;
        cg3[1] = (f2key(v1[15] + v2[0]) & ~255u) | 15u;
        cg3[2] = 0u;
        cg3[3] = 0u;
        cg3[4] = 0u;
        cg3[5] = 0u;
        cg3[6] = 0u;
        cg3[7] = 0u;
        cg3[8] = 0u;
        cg3[9] = 0u;
        cg3[10] = 0u;
        cg3[11] = 0u;
        cg3[12] = 0u;
        cg3[13] = 0u;
        cg3[14] = 0u;
        cg3[15] = 0u;
        sort16_desc(cg0); sort16_desc(cg1); sort16_desc(cg2); sort16_desc(cg3);
        merge16_desc(cg0, cg1); merge16_desc(cg2, cg3); merge16_desc(cg0, cg2);
        const float top0 = key2f(cg0[0] & ~255u);
        float ev[16]; float es = 0.f;
#pragma unroll
        for (int j = 0; j < 16; ++j) { ev[j] = expf(key2f(cg0[j] & ~255u) - top0); es += ev[j]; }
        const float rs = 1.f / es;
        __builtin_amdgcn_wave_barrier();
        int eo[8]; float go[8];
#pragma unroll
        for (int jj = 0; jj < 8; ++jj) {
            const unsigned wlo_ = cg0[jj], whi_ = cg0[jj + 8]; const unsigned w = hh ? whi_ : wlo_;
            const unsigned cid = 255u - (w & 255u);
            const int i1 = slot[cid >> 4], i2 = slot[16 + (cid & 15u)];
            eo[jj] = i1 * 128 + i2;
            const float elo_ = ev[jj], ehi_ = ev[jj + 8]; go[jj] = (hh ? ehi_ : elo_) * rs;
        }
        int* ep = eidx + (size_t)(t0 + tl) * 128 + h * 16 + 8 * hh;
        float* gp = egate + (size_t)(t0 + tl) * 128 + h * 16 + 8 * hh;
        *(int4*)ep = make_int4(eo[0], eo[1], eo[2], eo[3]); *(int4*)(ep + 4) = make_int4(eo[4], eo[5], eo[6], eo[7]);
        *(float4*)gp = make_float4(go[0], go[1], go[2], go[3]); *(float4*)(gp + 4) = make_float4(go[4], go[5], go[6], go[7]);
        __builtin_amdgcn_wave_barrier();
    }
}

__device__ __forceinline__ void phase_tabprep(const P& p, int l, unsigned char* sm) {
    const int tid_ = opaque_tid(); const int lane = tid_ & 63, wave = tid_ >> 6;
    float* sc = (float*)(p.ws + WS_TSC);
    unsigned* counter = (unsigned*)(p.ws + WS_CNT) + 16 * (2 + l);
    volatile int* ctl = (volatile int*)sm;
    for (;;) {
        __syncthreads();
        if (tid_ == 0) ctl[0] = (int)atomicAdd(counter, 1u);
        __syncthreads();
        const int chunk = ctl[0];
        if (chunk >= 512) break;
      for (int jj = 0; jj < 8; ++jj) {
        const int job = chunk * 64 + jj * 8 + wave;
        const int tbl = job >> 14, e = job & 16383;
        const float* src = (tbl ? p.peer_down : p.peer_up) + ((size_t)l * 16384 + e) * 1024 + lane * 16;
        const float4 v0 = *(const float4*)src, v1 = *(const float4*)(src + 4), v2 = *(const float4*)(src + 8), v3 = *(const float4*)(src + 12);
        const float f[16] = {v0.x, v0.y, v0.z, v0.w, v1.x, v1.y, v1.z, v1.w, v2.x, v2.y, v2.z, v2.w, v3.x, v3.y, v3.z, v3.w};
        float am = 0.f;
#pragma unroll
        for (int i = 0; i < 16; ++i) am = fmaxf(am, fabsf(f[i]));
        am = wave_max(am);
        const float inv = am > 0.f ? 127.f / am : 0.f;
        unsigned w[4];
#pragma unroll
        for (int d = 0; d < 4; ++d) {
            unsigned x = 0;
#pragma unroll
            for (int i = 0; i < 4; ++i) { const int q = min(max((int)rintf(f[d * 4 + i] * inv), -127), 127); x |= (unsigned)(q & 0xff) << (8 * i); }
            w[d] = x;
        }
        *(uint4*)(p.ws + (tbl ? WS_TDN : WS_TUP) + (size_t)(lane >> 3) * (16384 * 128) + (size_t)e * 128 + (lane & 7) * 16) = make_uint4(w[0], w[1], w[2], w[3]);
        if (lane == 0) sc[job] = am > 0.f ? am / 127.f : 0.f;
      }
    }
    __syncthreads();
}

constexpr size_t WS_PD = WS_Q;
constexpr size_t WS_Z  = WS_Q + (size_t)M * 1024 * 2;
__device__ __forceinline__ float readlane_f(float v, int l) { return __int_as_float(__builtin_amdgcn_readlane(__float_as_int(v), l)); }
__device__ __forceinline__ float dot16u8(const uint4& w, const float* u, float acc) {
    const unsigned ww[4] = {w.x, w.y, w.z, w.w};
#pragma unroll
    for (int d = 0; d < 4; ++d)
#pragma unroll
        for (int i = 0; i < 4; ++i) acc += u[d * 4 + i] * (float)((ww[d] >> (8 * i)) & 0xffu);
    return acc;
}
__device__ __forceinline__ void fma16u8(float* y, const uint4& w, float a) {
    const unsigned ww[4] = {w.x, w.y, w.z, w.w};
#pragma unroll
    for (int d = 0; d < 4; ++d)
#pragma unroll
        for (int i = 0; i < 4; ++i) y[d * 4 + i] += a * (float)((ww[d] >> (8 * i)) & 0xffu);
}
__device__ __forceinline__ int idot16(const uint4& w, const uint4& u) {
    int a = __builtin_amdgcn_sdot4((int)w.x, (int)u.x, 0, false); a = __builtin_amdgcn_sdot4((int)w.y, (int)u.y, a, false);
    a = __builtin_amdgcn_sdot4((int)w.z, (int)u.z, a, false); return __builtin_amdgcn_sdot4((int)w.w, (int)u.w, a, false);
}
__device__ __forceinline__ void tdot4x4(int* y, const uint4& w0, const uint4& w1, const uint4& w2, const uint4& w3, unsigned cq) {
    const unsigned a0[4] = {w0.x, w0.y, w0.z, w0.w}, a1[4] = {w1.x, w1.y, w1.z, w1.w}, a2[4] = {w2.x, w2.y, w2.z, w2.w}, a3[4] = {w3.x, w3.y, w3.z, w3.w};
#pragma unroll
    for (int r = 0; r < 4; ++r) {
        const unsigned lo01 = __builtin_amdgcn_perm(a1[r], a0[r], 0x05010400u), hi01 = __builtin_amdgcn_perm(a1[r], a0[r], 0x07030602u);
        const unsigned lo23 = __builtin_amdgcn_perm(a3[r], a2[r], 0x05010400u), hi23 = __builtin_amdgcn_perm(a3[r], a2[r], 0x07030602u);
        const unsigned c0 = __builtin_amdgcn_perm(lo23, lo01, 0x05040100u), c1 = __builtin_amdgcn_perm(lo23, lo01, 0x07060302u);
        const unsigned c2 = __builtin_amdgcn_perm(hi23, hi01, 0x05040100u), c3 = __builtin_amdgcn_perm(hi23, hi01, 0x07060302u);
        y[4 * r + 0] = __builtin_amdgcn_sdot4((int)c0, (int)cq, y[4 * r + 0], false);
        y[4 * r + 1] = __builtin_amdgcn_sdot4((int)c1, (int)cq, y[4 * r + 1], false);
        y[4 * r + 2] = __builtin_amdgcn_sdot4((int)c2, (int)cq, y[4 * r + 2], false);
        y[4 * r + 3] = __builtin_amdgcn_sdot4((int)c3, (int)cq, y[4 * r + 3], false);
    }
}
__device__ __forceinline__ unsigned my_xcc() { return (unsigned)__builtin_amdgcn_s_getreg((3 << 11) | 20) & 7u; }

template <int PH>
__device__ __forceinline__ void phase_eslice(const P& p, int l, unsigned char* sm) {
    const bf16_t* u2 = (const bf16_t*)(p.ws + WS_U2);
    const int* eidx = (const int*)(p.ws + WS_EIDX); const float* coefp = (const float*)(p.ws + WS_EGATE);
    const unsigned char* tab = p.ws + (PH == 0 ? WS_TUP : WS_TDN);
    bf16_t* pdb = (bf16_t*)(p.ws + WS_PD);
    unsigned* cnts = (unsigned*)(p.ws + WS_CNT + 256) + (size_t)((l * 2 + PH) * 8) * 16;
    const int tid = opaque_tid(); const int lane = tid & 63, wave = tid >> 6;
    volatile int* ctl = (volatile int*)sm;
    const int rows = (l == 0) ? M : ML;
    const int nchunks = rows / 128;
    const unsigned xcc = my_xcc();
    for (int att = 0; att < 8; ++att) {
        const int slice = (int)((xcc + (unsigned)att) & 7u);
        for (;;) {
            __syncthreads();
            if (tid == 0) ctl[0] = (int)atomicAdd(cnts + slice * 16, 1u);
            __syncthreads();
            const int chunk = ctl[0];
            if (chunk >= nchunks) break;
            int lane_o = lane; asm volatile("" : "+v"(lane_o));
            const int sub = lane_o & 7, g = lane_o >> 3;
            const int t0 = chunk * 128 + wave * 16;
            const unsigned char* tsl = tab + (size_t)slice * (16384 * 128) + sub * 16;
#define LD_EV(dst, tok) do { const int4* ep_ = (const int4*)(eidx + (size_t)(tok) * 128 + 16 * g); dst[0] = ep_[0]; dst[1] = ep_[1]; dst[2] = ep_[2]; dst[3] = ep_[3]; } while (0)
#define GATHER(dst, ev) do { _Pragma("unroll") for (int q_ = 0; q_ < 4; ++q_) { \
            dst[4 * q_ + 0] = *(const uint4*)(tsl + (size_t)ev[q_].x * 128); dst[4 * q_ + 1] = *(const uint4*)(tsl + (size_t)ev[q_].y * 128); \
            dst[4 * q_ + 2] = *(const uint4*)(tsl + (size_t)ev[q_].z * 128); dst[4 * q_ + 3] = *(const uint4*)(tsl + (size_t)ev[q_].w * 128); } } while (0)
#define LD_SMALL(dst, tok) do { if (PH == 0) { dst[0] = *(const uint4*)(p.ws + WS_U2Q + (size_t)(tok) * 1024 + slice * 128 + sub * 16); } \
            else { const unsigned char* rb_ = (const unsigned char*)(coefp + (size_t)(tok) * 128); dst[0] = *(const uint4*)(rb_ + 16 * g); dst[1].x = *(const unsigned*)(rb_ + 128); \
                   const unsigned xq_ = *(const unsigned*)((const bf16_t*)xrow_w(p, (tok)) + ocol); const float2 gq_ = *(const float2*)(modp(p, l, (tok)) + 5120 + ocol); \
                   dst[2].x = xq_ << 16; dst[2].y = xq_ & 0xffff0000u; dst[2].z = __float_as_uint(gq_.x); dst[2].w = __float_as_uint(gq_.y); } } while (0)
            const int ocol = slice * 128 + sub * 16 + ((lane_o & 32) ? 8 : 0) + ((lane_o & 16) ? 4 : 0) + ((lane_o & 8) ? 2 : 0);
            auto compute = [&](const uint4 (&W)[16], const uint4 (&smx)[3], const int t) {
                if (PH == 0) {
                    float acc[16];
#pragma unroll
                    for (int b = 0; b < 16; ++b) acc[b] = (float)idot16(W[b], smx[0]);
                    const bool s4 = sub & 4, s2 = sub & 2, s1 = sub & 1;
                    float d8[8];
#pragma unroll
                    for (int i = 0; i < 8; ++i) { const float lo_ = acc[i], hi_ = acc[i + 8]; const float keep = s4 ? hi_ : lo_, send = s4 ? lo_ : hi_; d8[i] = keep + __shfl_xor(send, 4); }
                    float d4[4];
#pragma unroll
                    for (int i = 0; i < 4; ++i) { const float lo_ = d8[i], hi_ = d8[i + 4]; const float keep = s2 ? hi_ : lo_, send = s2 ? lo_ : hi_; d4[i] = keep + __shfl_xor(send, 2); }
                    float d2[2];
#pragma unroll
                    for (int i = 0; i < 2; ++i) { const float lo_ = d4[i], hi_ = d4[i + 2]; const float keep = s1 ? hi_ : lo_, send = s1 ? lo_ : hi_; d2[i] = keep + __shfl_xor(send, 1); }
                    const int b0 = (s4 ? 8 : 0) + (s2 ? 4 : 0) + (s1 ? 2 : 0);
                    *(unsigned*)(pdb + ((size_t)slice * rows + t) * 128 + 16 * g + b0) = pk_bf16(d2[0], d2[1]);
                } else {
                    int yi[16];
#pragma unroll
                    for (int i = 0; i < 16; ++i) yi[i] = 0;
                    const unsigned cq[4] = {smx[0].x, smx[0].y, smx[0].z, smx[0].w};
                    const float csc = __uint_as_float(smx[1].x);
                    tdot4x4(yi, W[0], W[1], W[2], W[3], cq[0]); tdot4x4(yi, W[4], W[5], W[6], W[7], cq[1]);
                    tdot4x4(yi, W[8], W[9], W[10], W[11], cq[2]); tdot4x4(yi, W[12], W[13], W[14], W[15], cq[3]);
                    const bool h32 = lane_o & 32, h16 = lane_o & 16, h8 = lane_o & 8;
                    int y8[8];
#pragma unroll
                    for (int i = 0; i < 8; ++i) { const int lo_ = yi[i], hi_ = yi[i + 8]; const int keep = h32 ? hi_ : lo_, send = h32 ? lo_ : hi_; y8[i] = keep + __shfl_xor(send, 32); }
                    int y4[4];
#pragma unroll
                    for (int i = 0; i < 4; ++i) { const int lo_ = y8[i], hi_ = y8[i + 4]; const int keep = h16 ? hi_ : lo_, send = h16 ? lo_ : hi_; y4[i] = keep + __shfl_xor(send, 16); }
                    int y2[2];
#pragma unroll
                    for (int i = 0; i < 2; ++i) { const int lo_ = y4[i], hi_ = y4[i + 2]; const int keep = h8 ? hi_ : lo_, send = h8 ? lo_ : hi_; y2[i] = keep + __shfl_xor(send, 8); }
                    const float zx = ALPHA * __uint_as_float(smx[2].x) + __uint_as_float(smx[2].z) * ((float)y2[0] * csc), zy = ALPHA * __uint_as_float(smx[2].y) + __uint_as_float(smx[2].w) * ((float)y2[1] * csc);
                    *(unsigned*)((bf16_t*)(p.ws + WS_Z) + (size_t)t * 1024 + ocol) = pk_bf16(zx, zy);
                }
            };
            int4 ev0[4], ev1[4];
            uint4 WA[16], WB[16];
            uint4 sm0[3], sm1[3];
            sm0[1] = make_uint4(0, 0, 0, 0); sm1[1] = make_uint4(0, 0, 0, 0); sm0[2] = make_uint4(0, 0, 0, 0); sm1[2] = make_uint4(0, 0, 0, 0);
            LD_EV(ev0, t0); LD_EV(ev1, t0 + 1);
            LD_SMALL(sm0, t0); LD_SMALL(sm1, t0 + 1);
            GATHER(WA, ev0);
            LD_EV(ev0, t0 + 2);
#pragma unroll 1
            for (int tk = 0; tk < 16; tk += 2) {
                const int t = t0 + tk;
                GATHER(WB, ev1);
                if (tk + 3 < 16) LD_EV(ev1, t + 3);
                compute(WA, sm0, t);
                if (tk + 2 < 16) { LD_SMALL(sm0, t + 2); GATHER(WA, ev0); }
                if (tk + 4 < 16) LD_EV(ev0, t + 4);
                compute(WB, sm1, t + 1);
                if (tk + 3 < 16) LD_SMALL(sm1, t + 3);
            }
#undef LD_EV
#undef GATHER
#undef LD_SMALL
        }
    }
    __syncthreads();
}

__device__ __forceinline__ void phase_ecoef(const P& p, int l) {
    const int* eidx = (const int*)(p.ws + WS_EIDX); float* egate = (float*)(p.ws + WS_EGATE);
    const bf16_t* pdb = (const bf16_t*)(p.ws + WS_PD);
    const float* scu = (const float*)(p.ws + WS_TSC); const float* scd = scu + 16384;
    const int tid_ = opaque_tid(); const int lane = tid_ & 63, wave = tid_ >> 6, hl = lane & 31;
    const int rows = (l == 0) ? M : ML;
    for (int rp = blockIdx.x * NW + wave; rp < rows / 2; rp += gridDim.x * NW) {
        const int r = 2 * rp + (lane >> 5);
        const float usc = ((const float*)(p.ws + WS_USC))[r];
        float4 d = {0.f, 0.f, 0.f, 0.f};
#pragma unroll
        for (int x = 0; x < 8; ++x) { const uint2 v = *(const uint2*)(pdb + ((size_t)x * rows + r) * 128 + 4 * hl);
            d.x += __uint_as_float(v.x << 16); d.y += __uint_as_float(v.x & 0xffff0000u); d.z += __uint_as_float(v.y << 16); d.w += __uint_as_float(v.y & 0xffff0000u); }
        const int4 e = *(const int4*)(eidx + (size_t)r * 128 + 4 * hl);
        const float4 g = *(const float4*)(egate + (size_t)r * 128 + 4 * hl);
        float cf[4];
        cf[0] = g.x * scd[e.x] * gelu_tanh(scu[e.x] * usc * d.x); cf[1] = g.y * scd[e.y] * gelu_tanh(scu[e.y] * usc * d.y);
        cf[2] = g.z * scd[e.z] * gelu_tanh(scu[e.z] * usc * d.z); cf[3] = g.w * scd[e.w] * gelu_tanh(scu[e.w] * usc * d.w);
        float am = fmaxf(fmaxf(fabsf(cf[0]), fabsf(cf[1])), fmaxf(fabsf(cf[2]), fabsf(cf[3])));
        am = fmaxf(am, __shfl_xor(am, 16)); am = fmaxf(am, __shfl_xor(am, 8)); am = fmaxf(am, __shfl_xor(am, 4)); am = fmaxf(am, __shfl_xor(am, 2)); am = fmaxf(am, __shfl_xor(am, 1));
        const float inv = am > 0.f ? 127.f / am : 0.f;
        unsigned w = 0;
#pragma unroll
        for (int i = 0; i < 4; ++i) w |= (unsigned)(min(max((int)rintf(cf[i] * inv), -127), 127) & 0xff) << (8 * i);
        unsigned char* rowb = (unsigned char*)(egate + (size_t)r * 128);
        __builtin_amdgcn_wave_barrier();
        *(unsigned*)(rowb + 4 * hl) = w;
        if (hl == 0) *(float*)(rowb + 128) = am > 0.f ? am / 127.f : 0.f;
    }
}

__device__ __forceinline__ void phase_eln(const P& p, int l, float* sm) {
    const float* lw = p.ln2_w + l * D; const float* lb = p.ln2_b + l * D;
    const int tid_ = opaque_tid(); const int lane = tid_ & 63, wave = tid_ >> 6;
    const int rows = (l == 0) ? M : ML;
    const bool nxt = (l == 0);
    bf16_t* u1 = (bf16_t*)(p.ws + WS_U1);
    float* gates = (float*)(p.ws + WS_GATES);
    if (nxt) {
        __syncthreads();
#pragma unroll 1
        for (int i0 = 0; i0 < 16 * 1024; i0 += 16 * NT) {
            float wv[16];
#pragma unroll
            for (int q = 0; q < 16; ++q) { const int i = i0 + tid_ + NT * q; wv[q] = p.w_in[(size_t)(l + 1) * D * D_IN + (size_t)(i >> 4) * D_IN + 1536 + (i & 15)]; }
#pragma unroll
            for (int q = 0; q < 16; ++q) { const int i = i0 + tid_ + NT * q; sm[(i & 15) * 1024 + (i >> 4)] = wv[q]; }
        }
        __syncthreads();
    }
    for (int r = blockIdx.x * NW + wave; r < rows; r += gridDim.x * NW) {
        float* xo = xrow_w(p, r);
        const int k0 = lane * 16;
        float z[16]; float s = 0.f;
        {
            const uint4 za = *(const uint4*)((const bf16_t*)(p.ws + WS_Z) + (size_t)r * 1024 + k0), zb = *(const uint4*)((const bf16_t*)(p.ws + WS_Z) + (size_t)r * 1024 + k0 + 8);
            const unsigned zw[8] = {za.x, za.y, za.z, za.w, zb.x, zb.y, zb.z, zb.w};
#pragma unroll
            for (int i = 0; i < 8; ++i) { z[2 * i] = __uint_as_float(zw[i] << 16); z[2 * i + 1] = __uint_as_float(zw[i] & 0xffff0000u); s += z[2 * i] + z[2 * i + 1]; }
        }
        const float mu = wave_sum(s) * (1.f / 1024.f);
        float q = 0.f;
#pragma unroll
        for (int i = 0; i < 16; ++i) { const float d = z[i] - mu; q += d * d; }
        const float rstd = rsqrtf(wave_sum(q) * (1.f / 1024.f) + LN_EPS);
#pragma unroll
        for (int v4 = 0; v4 < 4; ++v4) {
            const int k = k0 + v4 * 4;
            const float4 w4 = *(const float4*)(lw + k), b4 = *(const float4*)(lb + k);
            float4 o;
            o.x = (z[v4 * 4] - mu) * rstd * w4.x + b4.x; o.y = (z[v4 * 4 + 1] - mu) * rstd * w4.y + b4.y;
            o.z = (z[v4 * 4 + 2] - mu) * rstd * w4.z + b4.z; o.w = (z[v4 * 4 + 3] - mu) * rstd * w4.w + b4.w;
            *(float4*)(xo + k) = o;
            z[v4 * 4] = o.x; z[v4 * 4 + 1] = o.y; z[v4 * 4 + 2] = o.z; z[v4 * 4 + 3] = o.w;
        }
        if (nxt) {
            const float* mp = modp(p, l + 1, r);
            float u[16];
#pragma unroll
            for (int v4 = 0; v4 < 4; ++v4) {
                const int k = k0 + v4 * 4;
                const float4 sc = *(const float4*)(mp + 1024 + k), sh = *(const float4*)(mp + k);
                u[v4 * 4] = z[v4 * 4] * (1.f + sc.x) + sh.x; u[v4 * 4 + 1] = z[v4 * 4 + 1] * (1.f + sc.y) + sh.y;
                u[v4 * 4 + 2] = z[v4 * 4 + 2] * (1.f + sc.z) + sh.z; u[v4 * 4 + 3] = z[v4 * 4 + 3] * (1.f + sc.w) + sh.w;
                uint2 pk; pk.x = pk_bf16(u[v4 * 4], u[v4 * 4 + 1]); pk.y = pk_bf16(u[v4 * 4 + 2], u[v4 * 4 + 3]);
                *(uint2*)(u1 + (size_t)r * 1024 + k) = pk;
            }
            float ga[16];
#pragma unroll
            for (int g = 0; g < 16; ++g) ga[g] = 0.f;
#pragma unroll 1
            for (int v4 = 0; v4 < 4; ++v4) {
                const int k = k0 + v4 * 4;
                const float u0 = v4 == 0 ? u[0] : v4 == 1 ? u[4] : v4 == 2 ? u[8] : u[12], u1v = v4 == 0 ? u[1] : v4 == 1 ? u[5] : v4 == 2 ? u[9] : u[13];
                const float u2v = v4 == 0 ? u[2] : v4 == 1 ? u[6] : v4 == 2 ? u[10] : u[14], u3v = v4 == 0 ? u[3] : v4 == 1 ? u[7] : v4 == 2 ? u[11] : u[15];
#pragma unroll
                for (int g = 0; g < 16; ++g) {
                    const float4 w = *(const float4*)(sm + g * 1024 + k);
                    ga[g] += u0 * w.x + u1v * w.y + u2v * w.z + u3v * w.w;
                }
            }
            const float mine = wave_sum16(ga, lane);
            if (lane < 16) gates[(size_t)r * 16 + lane] = mine + p.b_gate[(l + 1) * 16 + lane];
        }
    }
    __syncthreads();
}

#define XB_TMO      128
#define XB_XCNT(j)  (256  + 64 * (j))
#define XB_XSUB(j)  (1280 + 64 * (j))
#define XB_XGEN(j)  (2304 + 64 * (j))
#define XB_TOP      3328
#define XB_TOPGEN   3392
#define XCD_BAR_WORDS 3456
#define XB_SPIN_CAP (1u << 18)
#define LAS __attribute__((address_space(3)))

__device__ __forceinline__ unsigned xb_ld(unsigned* p)              { return __hip_atomic_load(p, __ATOMIC_RELAXED, __HIP_MEMORY_SCOPE_AGENT); }
__device__ __forceinline__ unsigned xb_add(unsigned* p, unsigned v) { return __hip_atomic_fetch_add(p, v, __ATOMIC_RELAXED, __HIP_MEMORY_SCOPE_AGENT); }
__device__ __forceinline__ unsigned xb_xcc_id() { return (unsigned)__builtin_amdgcn_s_getreg((3 << 11) | 20) & 0xFu; }
#define XB_SPIN(cond, bar) do { unsigned _sp = 0; while (cond) { __builtin_amdgcn_s_sleep(1); \
    if ((++_sp & 255u) == 0u) { if (xb_ld(&(bar)[XB_TMO])) break; if (_sp > XB_SPIN_CAP) { atomicAdd(&(bar)[XB_TMO], 1u); break; } } } } while (0)

struct XcdBarrier {
    unsigned* bar; unsigned x;
    volatile LAS unsigned* st;
};

__device__ __forceinline__ XcdBarrier xcd_barrier_post(unsigned* bar, volatile LAS unsigned* st) {
    XcdBarrier b; b.bar = bar; b.x = xb_xcc_id(); b.st = st;
    if (threadIdx.x == 0) (void)xb_add(&bar[XB_XCNT(b.x)], 1u);
    return b;
}
__device__ __forceinline__ void xcd_barrier_complete(unsigned* bar, unsigned x, unsigned& nloc, unsigned& nx) {
    const unsigned G = gridDim.x * gridDim.y * gridDim.z;
    unsigned sum, cnt, mine, sp = 0u;
    for (;;) {
        sum = 0u; cnt = 0u; mine = 0u;
#pragma unroll
        for (unsigned j = 0; j < 16; ++j) { const unsigned c = xb_ld(&bar[XB_XCNT(j)]); sum += c; cnt += (c > 0u) ? 1u : 0u; mine = (j == x) ? c : mine; }
        if (sum == G) break;
        __builtin_amdgcn_s_sleep(1);
        if ((++sp & 255u) == 0u) { if (xb_ld(&bar[XB_TMO])) break; if (sp > XB_SPIN_CAP) { atomicAdd(&bar[XB_TMO], 1u); break; } }
    }
    nloc = mine > 0u ? mine : 1u; nx = cnt > 0u ? cnt : 1u;
}

__device__ __forceinline__ void xcd_barrier(const XcdBarrier& b) {
    asm volatile("s_waitcnt vmcnt(0)" ::: "memory");
    __syncthreads();
    if (threadIdx.x == 0) {
        unsigned* bar = b.bar;
        __builtin_amdgcn_s_waitcnt(0);
        unsigned nloc = b.st[0], nx = b.st[1];
        if (nloc == 0u) { xcd_barrier_complete(bar, b.x, nloc, nx); b.st[0] = nloc; b.st[1] = nx; }
        const unsigned old = xb_add(&bar[XB_XSUB(b.x)], 1u);
        const unsigned gen = old / nloc;
        if (old + 1u == (gen + 1u) * nloc) {
            __builtin_amdgcn_fence(__ATOMIC_RELEASE, "agent");
            asm volatile("s_waitcnt vmcnt(0)" ::: "memory");
            const unsigned og = xb_add(&bar[XB_TOP], 1u);
            const unsigned tg = og / nx;
            if (og + 1u == (tg + 1u) * nx) xb_add(&bar[XB_TOPGEN], 1u);
            else XB_SPIN(xb_ld(&bar[XB_TOPGEN]) == tg, bar);
            __builtin_amdgcn_fence(__ATOMIC_ACQUIRE, "agent");
            xb_add(&bar[XB_XGEN(b.x)], 1u);
            asm volatile("s_waitcnt vmcnt(0)" ::: "memory");
        } else {
            XB_SPIN(xb_ld(&bar[XB_XGEN(b.x)]) == gen, bar);
            __builtin_amdgcn_fence(__ATOMIC_ACQUIRE, "agent");
            asm volatile("s_waitcnt vmcnt(0)" ::: "memory");
        }
    }
    __syncthreads();
}

__global__ void __launch_bounds__(NT, 2) mega(P p, int lo, int hi) {
    extern __shared__ __attribute__((aligned(16))) unsigned char smem_raw[];
    float* sm = (float*)smem_raw;
    cg::grid_group grid = cg::this_grid();
    volatile LAS unsigned* xb_st = (volatile LAS unsigned*)(smem_raw + 128 * 1024);
    if (threadIdx.x < 4) xb_st[threadIdx.x] = 0u;
    __syncthreads();
    const XcdBarrier xbar = xcd_barrier_post((unsigned*)(p.ws + WS_BAR), xb_st);
#define GRID_SYNC(k) do { if ((k) == 0) grid.sync(); else xcd_barrier(xbar); } while (0)
#ifdef PROBE_MASK
    unsigned tacc_ = 0, t0_ = 0;
    const bool timer_ = (blockIdx.x == 0);
#define STEP(k, body) do { const int k_ = (k); if (lo <= k_ && k_ < hi) { if (timer_) t0_ = (unsigned)__builtin_amdgcn_s_memrealtime(); body; if (k_ + 1 < hi) GRID_SYNC(k_); \
        if (timer_ && ((PROBE_MASK >> (k_ == 0 ? 0 : 1 + (k_ - 1) % 13)) & 1)) tacc_ += (unsigned)__builtin_amdgcn_s_memrealtime() - t0_; } } while (0)
#else
#define STEP(k, body) do { const int k_ = (k); if (lo <= k_ && k_ < hi) { body; if (k_ + 1 < hi) GRID_SYNC(k_); } } while (0)
#endif
    STEP(0, { phase_mod(p, sm); phase_wprep(p, sm); });
#pragma unroll 1
    for (int l = 0; l < 2; ++l) {
        const int s0 = 1 + 13 * l;
        if (l == 0) STEP(s0 + 0, phase_u1prep(p, l, sm));
        STEP(s0 + 1, phase_inproj(p, l, smem_raw));
        STEP(s0 + 2, { phase_conv(p, l, sm); phase_vtrans(p, smem_raw); phase_gatescan(p, l, sm); });
        STEP(s0 + 3, { phase_mlstm(p, l, smem_raw); __syncthreads(); phase_na(p, l, smem_raw); phase_tabprep(p, l, smem_raw); });
        STEP(s0 + 4, phase_combine(p, l));
        STEP(s0 + 5, phase_outproj(p, l, smem_raw));
        STEP(s0 + 6, phase_ln1(p, l));
        STEP(s0 + 7, phase_peerq(p, l, smem_raw));
        STEP(s0 + 8, phase_topk(p, l, smem_raw));
        STEP(s0 + 9, phase_eslice<0>(p, l, smem_raw));
        STEP(s0 + 10, phase_ecoef(p, l));
        STEP(s0 + 11, phase_eslice<1>(p, l, smem_raw));
        STEP(s0 + 12, phase_eln(p, l, sm));
    }
#undef STEP
#ifdef PROBE_MASK
    if (timer_) { const unsigned te = (unsigned)__builtin_amdgcn_s_memrealtime(); while ((unsigned)__builtin_amdgcn_s_memrealtime() - te < 8u * tacc_) __builtin_amdgcn_s_sleep(32); }
#endif
}

extern "C" void kernel_launch(void* const* d_in, const int* in_sizes, int n_in, void* d_out, int out_size, void* d_ws,
                              size_t ws_size, hipStream_t stream) {
    static int grid_blocks = 0;
    if (!grid_blocks) {
        int dev = 0, cus = 0, per_cu = 0;
        hipGetDevice(&dev);
        hipDeviceGetAttribute(&cus, hipDeviceAttributeMultiprocessorCount, dev);
        hipFuncSetAttribute((const void*)mega, hipFuncAttributeMaxDynamicSharedMemorySize, LDS_BYTES);
        hipOccupancyMaxActiveBlocksPerMultiprocessor(&per_cu, (const void*)mega, NT, LDS_BYTES);
        if (per_cu < 1) per_cu = 1;
        grid_blocks = cus * per_cu;
        if (ws_size < WS_END) fprintf(stderr, "kernel_launch: workspace too small: %zu < %zu\n", ws_size, (size_t)WS_END);
    }
    P p{};
    const float** pp = (const float**)&p;
    for (int i = 0; i < 20; ++i) pp[i] = (const float*)d_in[i];
    p.out = (float*)d_out;
    p.ws = (unsigned char*)d_ws;
    hipMemsetAsync((unsigned char*)d_ws + WS_BAR, 0, (WS_CNT - WS_BAR) + 8192, stream);
#if SINGLE_LAUNCH
    int lo = 0, hi = NSTEPS;
    void* args[] = {&p, &lo, &hi};
    hipError_t e = hipLaunchCooperativeKernel((const void*)mega, dim3(grid_blocks), dim3(NT), args, LDS_BYTES, stream);
    if (e != hipSuccess) fprintf(stderr, "cooperative launch failed: %s (grid %d)\n", hipGetErrorString(e), grid_blocks);
#else
    for (int s = 0; s < NSTEPS; ++s) {
        int lo = s, hi = s + 1;
        void* args[] = {&p, &lo, &hi};
        hipError_t e = hipLaunchCooperativeKernel((const void*)mega, dim3(grid_blocks), dim3(NT), args, LDS_BYTES, stream);
        if (e != hipSuccess) fprintf(stderr, "launch %d failed: %s (grid %d)\n", s, hipGetErrorString(e), grid_blocks);
    }
#endif
}
```

```cpp
#include <hip/hip_runtime.h>
#include <hip/hip_cooperative_groups.h>
#include <cstdio>
#include <cstdint>
namespace cg = cooperative_groups;

#ifndef SINGLE_LAUNCH
#define SINGLE_LAUNCH 1
#endif

typedef unsigned short bf16_t;

constexpr int NT = 512;
constexpr int NW = NT / 64;
constexpr int D = 1024, NB = 16, T = 2048, CT = 256;
constexpr int ML = NB * T, MC = NB * CT, M = ML + MC;
constexpr int D_IN = 3088;
constexpr float ALPHA = 1.4142135623730951f;
constexpr float LN_EPS = 1e-5f;
constexpr int NSTEPS = 27;

constexpr size_t SZ_HALF = (size_t)M * 512 * 2;
constexpr size_t WS_MOD   = 0;
constexpr size_t WS_BAR   = 0xE0000;
constexpr size_t WS_XCTX  = 1u << 20;
constexpr size_t WS_R1    = WS_XCTX + (size_t)MC * 1024 * 4;
constexpr size_t WS_QKRAW = WS_R1;
constexpr size_t WS_V     = WS_R1 + 1 * SZ_HALF;
constexpr size_t WS_O     = WS_R1 + 2 * SZ_HALF;
constexpr size_t WS_NQ    = WS_R1 + 3 * SZ_HALF;
constexpr size_t WS_NK    = WS_R1 + 4 * SZ_HALF;
constexpr size_t WS_NV    = WS_R1 + 5 * SZ_HALF;
constexpr size_t WS_Y     = WS_R1;
constexpr size_t WS_Q     = WS_R1 + 2 * SZ_HALF;
constexpr size_t WS_GATES = WS_R1 + 6 * SZ_HALF;
constexpr size_t WS_R3    = WS_GATES + (size_t)M * 16 * 4;
constexpr size_t WS_QKACT = WS_R3;
constexpr size_t WS_HDIR  = WS_R3 + SZ_HALF;
constexpr size_t WS_EIDX  = WS_R3;
constexpr size_t WS_EIDX16 = WS_Y + ((size_t)16 << 20);
constexpr size_t WS_EGATE = WS_R3 + (size_t)M * 128 * 4;
constexpr size_t WS_U2Q   = WS_R3 + SZ_HALF;
constexpr size_t WS_USC   = WS_GATES;
constexpr size_t WS_MIX   = WS_R3 + 3 * SZ_HALF;
constexpr size_t WS_U2    = WS_MIX;
constexpr size_t WS_U1    = WS_MIX;
constexpr size_t WS_WIN   = WS_MIX + 2 * SZ_HALF;
constexpr size_t WS_WOUT  = WS_WIN + (size_t)2 * 3328 * 1024 * 2;
constexpr size_t WS_WQ    = WS_WOUT + (size_t)2 * 1024 * 1024 * 2;
constexpr size_t WS_NVT   = WS_WQ + (size_t)2 * 2048 * 1024 * 2;
constexpr size_t WS_TUP   = WS_NVT + (size_t)128 * 64 * 2304 * 2;
constexpr size_t WS_TDN   = WS_TUP + (size_t)16384 * 1024;
constexpr size_t WS_TSC   = WS_TDN + (size_t)16384 * 1024;
constexpr size_t WS_GSC   = WS_TSC + (size_t)2 * 16384 * 4;
constexpr size_t WS_END   = WS_GSC + (size_t)3 * 128 * 2304 * 4 + (size_t)128 * 36 * 4;

constexpr int LDS_BYTES = 128 * 1024 + 16;

struct P {
    const float *x, *c, *ctx, *c_ctx, *ada_w, *ada_b, *w_in, *b_gate, *conv_w, *ml_norm_w, *na_rpb, *w_out,
                *ln1_w, *ln1_b, *peer_wq, *peer_keys, *peer_up, *peer_down, *ln2_w, *ln2_b;
    float* out;
    unsigned char* ws;
};

typedef short bf16x8 __attribute__((ext_vector_type(8)));
typedef float f32x16 __attribute__((ext_vector_type(16)));
typedef float f32x4v __attribute__((ext_vector_type(4)));
__device__ __forceinline__ bf16_t f2bf(float f) {
    unsigned u = __float_as_uint(f);
    u += 0x7fffu + ((u >> 16) & 1u);
    return (bf16_t)(u >> 16);
}
__device__ __forceinline__ float bf2f(bf16_t h) { return __uint_as_float(((unsigned)h) << 16); }
typedef __bf16 bf16x2v_t __attribute__((ext_vector_type(2)));
typedef float f32x2v_t __attribute__((ext_vector_type(2)));
__device__ __forceinline__ unsigned pk_bf16(float lo, float hi) { const f32x2v_t f = {lo, hi}; return __builtin_bit_cast(unsigned, __builtin_convertvector(f, bf16x2v_t)); }
__device__ __forceinline__ int opaque_tid() { int v = threadIdx.x; asm volatile("" : "+v"(v)); return v; }
__device__ __forceinline__ float wave_sum(float v) {
#pragma unroll
    for (int o = 32; o; o >>= 1) v += __shfl_xor(v, o);
    return v;
}
__device__ __forceinline__ float wave_max(float v) {
#pragma unroll
    for (int o = 32; o; o >>= 1) v = fmaxf(v, __shfl_xor(v, o));
    return v;
}
__device__ __forceinline__ float siluf(float v) { return v / (1.f + expf(-v)); }
__device__ __forceinline__ float sigmoidf(float v) { return 1.f / (1.f + expf(-v)); }
__device__ __forceinline__ float logsigmoidf(float v) { return fminf(v, 0.f) - log1pf(expf(-fabsf(v))); }
__device__ __forceinline__ float gelu_tanh(float v) {
    const float k0 = 0.7978845608028654f;
    return 0.5f * v * (1.f + tanhf(k0 * (v + 0.044715f * v * v * v)));
}
__device__ __forceinline__ int mod_row(int r) { return r < ML ? (r >> 11) : 16; }
__device__ __forceinline__ const float* xrow(const P& p, int l, int r) {
    if (r < ML) return (l == 0 ? p.x : (const float*)p.out) + (size_t)r * D;
    return (l == 0 ? p.ctx : (const float*)(p.ws + WS_XCTX)) + (size_t)(r - ML) * D;
}
__device__ __forceinline__ float* xrow_w(const P& p, int r) {
    if (r < ML) return p.out + (size_t)r * D;
    return (float*)(p.ws + WS_XCTX) + (size_t)(r - ML) * D;
}
__device__ __forceinline__ const float* modp(const P& p, int l, int r) {
    return (const float*)(p.ws + WS_MOD) + (size_t)(l * 17 + mod_row(r)) * 6144;
}

__device__ __forceinline__ float wave_sum16(const float (&v)[16], int lane) {
    const bool b0 = lane & 1, b1 = lane & 2, b2 = lane & 4, b3 = lane & 8;
    float a8[8];
#pragma unroll
    for (int i = 0; i < 8; ++i) { const float lo_ = v[2 * i], hi_ = v[2 * i + 1]; const float keep = b0 ? hi_ : lo_, send = b0 ? lo_ : hi_; a8[i] = keep + __shfl_xor(send, 1); }
    float a4[4];
#pragma unroll
    for (int i = 0; i < 4; ++i) { const float lo_ = a8[2 * i], hi_ = a8[2 * i + 1]; const float keep = b1 ? hi_ : lo_, send = b1 ? lo_ : hi_; a4[i] = keep + __shfl_xor(send, 2); }
    float a2[2];
#pragma unroll
    for (int i = 0; i < 2; ++i) { const float lo_ = a4[2 * i], hi_ = a4[2 * i + 1]; const float keep = b2 ? hi_ : lo_, send = b2 ? lo_ : hi_; a2[i] = keep + __shfl_xor(send, 4); }
    float a1; { const float lo_ = a2[0], hi_ = a2[1]; const float keep = b3 ? hi_ : lo_, send = b3 ? lo_ : hi_; a1 = keep + __shfl_xor(send, 8); }
    a1 += __shfl_xor(a1, 16); a1 += __shfl_xor(a1, 32);
    return a1;
}

__device__ __forceinline__ void phase_mod(const P& p, float* sm) {
    float* mod = (float*)(p.ws + WS_MOD);
    const int tid = opaque_tid();
    {
        float cv[34];
#pragma unroll
        for (int q = 0; q < 34; ++q) { const int i = tid + NT * q; const int mr = i >> 10, k = i & 1023; cv[q] = mr < 16 ? p.c[mr * D + k] : p.c_ctx[k]; }
#pragma unroll
        for (int q = 0; q < 34; ++q) { const int i = tid + NT * q; const int mr = i >> 10, k = i & 1023; sm[mr * 1024 + ((k & 127) << 3) + (k >> 7)] = siluf(cv[q]); }
    }
    __syncthreads();
    float* red = sm + 17 * 1024;
    const int lane = tid & 63, kq = tid >> 6;
    for (int chunk = blockIdx.x; chunk < 192; chunk += gridDim.x) {
        const int l = chunk / 96, col0 = (chunk % 96) * 64;
        const float* w = p.ada_w + (size_t)l * D * 6144 + (size_t)(kq * 128) * 6144 + col0 + lane;
        float acc[17];
#pragma unroll
        for (int mr = 0; mr < 17; ++mr) acc[mr] = 0.f;
#pragma unroll 1
        for (int k0 = 0; k0 < 128; k0 += 32) {
            float wv[32];
#pragma unroll
            for (int kk = 0; kk < 32; ++kk) wv[kk] = w[(size_t)(k0 + kk) * 6144];
#pragma unroll
            for (int kk = 0; kk < 32; ++kk)
#pragma unroll
                for (int mr = 0; mr < 17; ++mr) acc[mr] += sm[mr * 1024 + (k0 + kk) * 8 + kq] * wv[kk];
        }
#pragma unroll
        for (int mr = 0; mr < 17; ++mr) red[(kq * 17 + mr) * 64 + lane] = acc[mr];
        __syncthreads();
        for (int o = tid; o < 17 * 64; o += NT) {
            const int mr = o >> 6, c = o & 63;
            float v = 0.f;
#pragma unroll
            for (int q = 0; q < 8; ++q) v += red[(q * 17 + mr) * 64 + c];
            mod[(size_t)(l * 17 + mr) * 6144 + col0 + c] = v + p.ada_b[l * 6144 + col0 + c];
        }
        __syncthreads();
    }
    __syncthreads();
}

namespace pg8 {
#define PG8_LAS __attribute__((address_space(3)))
typedef unsigned short bf16_t;
typedef short bf16x8 __attribute__((ext_vector_type(8)));
typedef float f32x4 __attribute__((ext_vector_type(4)));
typedef unsigned u32x4 __attribute__((ext_vector_type(4)));
constexpr int BM = 256, BK = 64, HALF = 128, HTB = HALF * BK * 2  , STAGE_BYTES = 8 * HTB, NXCD = 8, WGM = 8;

__host__ __device__ __forceinline__ int lds_byte(int r, int c) { const int st = (r >> 4) * 2 + (c >> 5), rr = r & 15, cc = c & 31, ob = rr * 64 + cc * 2; return st * 1024 + (ob ^ (((ob >> 9) & 1) << 5)); }
__host__ __device__ __forceinline__ void stage_rc(int b, int& R, int& C) { const int st = b / 1024, sb = b % 1024, swz = sb ^ (((sb >> 9) & 1) << 5); R = (st >> 1) * 16 + swz / 64; C = (st & 1) * 32 + (swz % 64) / 2; }
__host__ __device__ __forceinline__ int perm32(int rho) { const int n = rho >> 4, i = rho & 15; return 8 * (i >> 2) + 4 * n + (i & 3); }

struct Unit { int pm, pn; };
struct Gemm { const bf16_t* A; const bf16_t* Bt; int M, N, K; };

struct StaticOrder {
    int nM, nN, nwg, G, c;
    __host__ __device__ void init(int M, int N, int G_, int c_) { nM = M / BM; nN = N / BM; nwg = nM * nN; G = G_; c = c_; }
    __host__ __device__ bool next(int i, Unit& u) const {
        const long L = (long)i * G + c; if (L >= nwg) return false;
        int wgid = (int)L; { const int q = nwg / NXCD, r = nwg % NXCD, xcd = wgid % NXCD, off = wgid / NXCD; wgid = (xcd < r ? xcd * (q + 1) : r * (q + 1) + (xcd - r) * q) + off; }
        const int nig = WGM * nN, gid = wgid / nig, fm = gid * WGM, gsz = (nM - fm) < WGM ? (nM - fm) : WGM;
        u.pm = fm + ((wgid % nig) % gsz); u.pn = (wgid % nig) / gsz; return true;
    }
    __device__ __forceinline__ void a_ready(const Unit&) const {}
    __device__ __forceinline__ void done(const Unit&) const {}
};
__device__ __forceinline__ unsigned cvt_pk_bf16(float lo, float hi) { unsigned r; asm volatile("v_cvt_pk_bf16_f32 %0, %1, %2" : "=v"(r) : "v"(lo), "v"(hi)); return r; }
template <int ACT  > struct EpiBf16 {
    static constexpr bool PERM = true, AFTER_DRAIN = false;
    bf16_t* O; int ldc; const float* bias; int split_cols; size_t split_stride;
    __device__ __forceinline__ void operator()(const f32x4 (&acc)[2][2][4][2], const Unit& u, int wr, int wc, int fr, int fq) const {
        const int row0 = u.pm * BM + wr * 64 + fr; int colt = u.pn * BM; bf16_t* base = O;
        if (split_cols) { const int t = colt / split_cols; base += (size_t)t * split_stride; colt -= t * split_cols; }
        const int col0 = colt + wc * 32 + 8 * fq, bcol0 = u.pn * BM + wc * 32 + 8 * fq;
        f32x4 bv[2][2];
#pragma unroll
        for (int bj = 0; bj < 2; ++bj)
#pragma unroll
            for (int n = 0; n < 2; ++n) bv[bj][n] = bias ? *(const f32x4*)(bias + bcol0 + bj * HALF + 4 * n) : (f32x4){0.f, 0.f, 0.f, 0.f};
#pragma unroll
        for (int ai = 0; ai < 2; ++ai)
#pragma unroll
            for (int m = 0; m < 4; ++m) { bf16_t* rowp = base + (size_t)(row0 + ai * HALF + m * 16) * ldc + col0;
#pragma unroll
                for (int bj = 0; bj < 2; ++bj) { f32x4 v0 = acc[ai][bj][m][0] + bv[bj][0], v1 = acc[ai][bj][m][1] + bv[bj][1];
                    u32x4 w; w.x = cvt_pk_bf16(v0[0], v0[1]); w.y = cvt_pk_bf16(v0[2], v0[3]); w.z = cvt_pk_bf16(v1[0], v1[1]); w.w = cvt_pk_bf16(v1[2], v1[3]);
                    *(u32x4*)(rowp + bj * HALF) = w; } }
    }
};
struct EpiQFrag {
    static constexpr bool PERM = true, AFTER_DRAIN = false;
    bf16_t* O;
    __device__ __forceinline__ void operator()(const f32x4 (&acc)[2][2][4][2], const Unit& u, int wr, int wc, int fr, int fq) const {
        const int row0 = u.pm * BM + wr * 64 + fr, col0 = u.pn * BM + wc * 32 + 8 * fq;
#pragma unroll
        for (int ai = 0; ai < 2; ++ai)
#pragma unroll
            for (int m = 0; m < 4; ++m) { const int t = row0 + ai * HALF + m * 16;
#pragma unroll
                for (int bj = 0; bj < 2; ++bj) { const f32x4 v0 = acc[ai][bj][m][0], v1 = acc[ai][bj][m][1];
                    const int c = col0 + bj * HALF;
                    const size_t off = ((((size_t)(t >> 5) * 8 + (c >> 8)) * 2 + ((c >> 7) & 1)) * 8 + ((c >> 4) & 7)) * 512 + (size_t)(((c >> 3) & 1) * 32 + (t & 31)) * 8;
                    u32x4 w; w.x = cvt_pk_bf16(v0[0], v0[1]); w.y = cvt_pk_bf16(v0[2], v0[3]); w.z = cvt_pk_bf16(v1[0], v1[1]); w.w = cvt_pk_bf16(v1[2], v1[3]);
                    *(u32x4*)(O + off) = w; } }
    }
};
template <class Epi, class Sched, bool STAMP = false>
__device__ __forceinline__ void gemm_phase(PG8_LAS unsigned char* lds, const Gemm g, const Sched& S, const Epi& E, unsigned long long* stamps) {
    const int tid = opaque_tid(), wid = __builtin_amdgcn_readfirstlane(tid >> 6), lane = tid & 63, wr = wid >> 2, wc = wid & 3, fr = lane & 15, fq = lane >> 4;
    const int K = g.K, nt = K / BK;
    int ts_lo = 0, ts_hi = 0, nts = 0; const unsigned long long rt_entry = STAMP ? (unsigned long long)wall_clock64() : 0ull;
#define PG8_STAMP() do { if (STAMP && wid == 0 && nts < 64) { const unsigned long long _c = (unsigned long long)clock64(); \
        ts_lo = (lane == nts) ? (int)(unsigned)_c : ts_lo; ts_hi = (lane == nts) ? (int)(unsigned)(_c >> 32) : ts_hi; ++nts; } } while (0)
    PG8_STAMP();
    unsigned voffA[2], voffB[2];
#pragma unroll
    for (int i = 0; i < 2; ++i) { int R, C; stage_rc(tid * 16 + i * 8192, R, C); const int Rb = Epi::PERM ? ((R & ~31) + perm32(R & 31)) : R;
        voffA[i] = (unsigned)(R * K + C) * 2u; voffB[i] = (unsigned)(Rb * K + C) * 2u; }
    const size_t kstep = (size_t)(BK * 2);
    const size_t hstep = (size_t)HALF * K * 2;
    const size_t tstep = 2 * hstep;
    const unsigned ldsw = (unsigned)wid * 1024u;
    const int aoff = lds_byte(wr * 64 + fr, fq * 8), boff = lds_byte(wc * 32 + fr, fq * 8);
#define PG8_SA(b, h) (((b) * 2 + (h)) * HTB)
#define PG8_SB(b, h) ((4 + (b) * 2 + (h)) * HTB)
#define PG8_STAGE(bufoff, gbase, voff) do { _Pragma("unroll") for (int _i = 0; _i < 2; ++_i) \
        __builtin_amdgcn_global_load_lds((const unsigned*)((const char*)(gbase) + (voff)[_i]), (PG8_LAS unsigned*)(lds + (bufoff) + ldsw + _i * 8192), 16, 0, 0); } while (0)
#define PG8_LDA(dst, b, h) do { _Pragma("unroll") for (int m = 0; m < 4; ++m) _Pragma("unroll") for (int k = 0; k < 2; ++k) dst[m][k] = *(const PG8_LAS bf16x8*)(lds + PG8_SA(b, h) + aoff + m * 2048 + k * 1024); } while (0)
#define PG8_LDB(dst, b, h) do { _Pragma("unroll") for (int n = 0; n < 2; ++n) _Pragma("unroll") for (int k = 0; k < 2; ++k) dst[n][k] = *(const PG8_LAS bf16x8*)(lds + PG8_SB(b, h) + boff + n * 2048 + k * 1024); } while (0)
#define PG8_MMA(ai, bj, At, Bt) do { __builtin_amdgcn_s_setprio(1); _Pragma("unroll") for (int m = 0; m < 4; ++m) _Pragma("unroll") for (int n = 0; n < 2; ++n) _Pragma("unroll") for (int k = 0; k < 2; ++k) \
        acc[ai][bj][m][n] = __builtin_amdgcn_mfma_f32_16x16x32_bf16(Bt[n][k], At[m][k], acc[ai][bj][m][n], 0, 0, 0); __builtin_amdgcn_s_setprio(0); } while (0)
#define PG8_WAIT_V(n) asm volatile("s_waitcnt vmcnt(" #n ")" ::: "memory")
#define PG8_WAIT_L(n) asm volatile("s_waitcnt lgkmcnt(" #n ")" ::: "memory")
#define PG8_BAR __builtin_amdgcn_s_barrier()
#define PG8_SCHED __builtin_amdgcn_sched_barrier(0)
    Unit cur, nxt; int ui = 0;
    if (!S.next(0, cur)) return;
    f32x4 acc[2][2][4][2];
#pragma unroll
    for (int a = 0; a < 2; ++a)
#pragma unroll
        for (int b = 0; b < 2; ++b)
#pragma unroll
            for (int m = 0; m < 4; ++m)
#pragma unroll
                for (int n = 0; n < 2; ++n) acc[a][b][m][n] = (f32x4){0.f, 0.f, 0.f, 0.f};
    bf16x8 At[4][2], B0[2][2], B1[2][2];
    const char* cA = (const char*)g.A + (size_t)cur.pm * tstep; const char* cB = (const char*)g.Bt + (size_t)cur.pn * tstep;
    S.a_ready(cur);
    PG8_STAGE(PG8_SB(0, 0), cB, voffB); PG8_STAGE(PG8_SA(0, 0), cA, voffA); PG8_STAGE(PG8_SB(0, 1), cB + hstep, voffB); PG8_STAGE(PG8_SA(0, 1), cA + hstep, voffA);
    if (wr == 1) PG8_BAR;
    PG8_WAIT_V(4); PG8_BAR;
    PG8_STAGE(PG8_SB(1, 0), cB + kstep, voffB); PG8_STAGE(PG8_SA(1, 0), cA + kstep, voffA); PG8_STAGE(PG8_SB(1, 1), cB + hstep + kstep, voffB);
    PG8_WAIT_V(6); PG8_BAR;
    PG8_STAMP();
    for (;;) {
        const bool has_next = S.next(ui + 1, nxt);
        const char* nA = has_next ? (const char*)g.A + (size_t)nxt.pm * tstep : cA; const char* nB = has_next ? (const char*)g.Bt + (size_t)nxt.pn * tstep : cB;
        for (int t = 0; t < nt; t += 2) {
            const bool last = (t == nt - 2);
            const char* a1 = cA + (size_t)(t + 1) * kstep;
            const char* a2 = last ? nA : cA + (size_t)(t + 2) * kstep; const char* b2 = last ? nB : cB + (size_t)(t + 2) * kstep;
            const char* a3 = a2 + kstep; const char* b3 = b2 + kstep;
            if (last && has_next) S.a_ready(nxt);
            PG8_LDB(B0, 0, 0); PG8_SCHED; PG8_LDA(At, 0, 0); PG8_STAGE(PG8_SA(1, 1), a1 + hstep, voffA);
            PG8_WAIT_L(8); PG8_BAR; PG8_WAIT_L(0); PG8_MMA(0, 0, At, B0); PG8_BAR; PG8_SCHED;
            PG8_LDB(B1, 0, 1); PG8_STAGE(PG8_SB(0, 0), b2, voffB);
            PG8_BAR; PG8_WAIT_L(0); PG8_MMA(0, 1, At, B1); PG8_BAR;
            PG8_LDA(At, 0, 1); PG8_STAGE(PG8_SA(0, 0), a2, voffA);
            PG8_BAR; PG8_WAIT_L(0); PG8_MMA(1, 0, At, B0); PG8_BAR; PG8_SCHED;
            PG8_STAGE(PG8_SB(0, 1), b2 + hstep, voffB);
            PG8_WAIT_V(6); PG8_BAR; PG8_MMA(1, 1, At, B1); PG8_BAR;
            PG8_LDB(B0, 1, 0); PG8_SCHED; PG8_LDA(At, 1, 0); PG8_STAGE(PG8_SA(0, 1), a2 + hstep, voffA);
            PG8_WAIT_L(8); PG8_BAR; PG8_WAIT_L(0); PG8_MMA(0, 0, At, B0); PG8_BAR; PG8_SCHED;
            PG8_LDB(B1, 1, 1); PG8_STAGE(PG8_SB(1, 0), b3, voffB);
            PG8_BAR; PG8_WAIT_L(0); PG8_MMA(0, 1, At, B1); PG8_BAR;
            PG8_LDA(At, 1, 1); PG8_STAGE(PG8_SA(1, 0), a3, voffA);
            PG8_BAR; PG8_WAIT_L(0); PG8_MMA(1, 0, At, B0); PG8_BAR; PG8_SCHED;
            PG8_STAGE(PG8_SB(1, 1), b3 + hstep, voffB);
            PG8_WAIT_V(6); PG8_BAR; PG8_MMA(1, 1, At, B1); PG8_BAR;
        }
        PG8_STAMP();
        if constexpr (!Epi::AFTER_DRAIN) { E(acc, cur, wr, wc, fr, fq); S.done(cur); }
        PG8_STAMP();
        if (!has_next) break;
#pragma unroll
        for (int a = 0; a < 2; ++a)
#pragma unroll
            for (int b = 0; b < 2; ++b)
#pragma unroll
                for (int m = 0; m < 4; ++m)
#pragma unroll
                    for (int n = 0; n < 2; ++n) acc[a][b][m][n] = (f32x4){0.f, 0.f, 0.f, 0.f};
        cur = nxt; cA = nA; cB = nB; ++ui;
    }
    PG8_WAIT_V(0);
    if (wr == 0) PG8_BAR;
    PG8_BAR;
    if constexpr (Epi::AFTER_DRAIN) { E.fused(acc, cur, wr, wc, fr, fq, lds, wid, lane); S.done(cur); }
    PG8_STAMP();
    if (STAMP && wid == 0) { stamps[lane] = lane < nts ? (((unsigned long long)(unsigned)ts_hi << 32) | (unsigned)ts_lo) : 0ull;
        if (lane == 62) stamps[62] = rt_entry; if (lane == 63) stamps[63] = (unsigned long long)wall_clock64(); }
#undef PG8_STAMP
#undef PG8_SA
#undef PG8_SB
#undef PG8_STAGE
#undef PG8_LDA
#undef PG8_LDB
#undef PG8_MMA
#undef PG8_WAIT_V
#undef PG8_WAIT_L
#undef PG8_BAR
#undef PG8_SCHED
}
}


struct WprepTile { const float* src; bf16_t* dst; int Nsrc; float sc; };
__device__ __forceinline__ WprepTile wprep_decode(const P& p, int tile, int tid) {
    const int l = tile / 1600; int t = tile % 1600;
    const float* src; bf16_t* dst; int Nsrc, which;
    if (t < 832) { which = 0; src = p.w_in + (size_t)l * D * D_IN; Nsrc = D_IN; dst = (bf16_t*)(p.ws + WS_WIN) + (size_t)l * 3328 * 1024; }
    else if (t < 1088) { which = 1; t -= 832; src = p.w_out + (size_t)l * D * D; Nsrc = D; dst = (bf16_t*)(p.ws + WS_WOUT) + (size_t)l * 1024 * 1024; }
    else { which = 2; t -= 1088; src = p.peer_wq + (size_t)l * D * 2048; Nsrc = 2048; dst = (bf16_t*)(p.ws + WS_WQ) + (size_t)l * 2048 * 1024; }
    const int tn = t / 16, tk = t % 16;
    const int nn = tid & 63; const int n = tn * 64 + nn;
    const bool zero = (which == 0 && n >= 3088);
    const int nsrc = which != 0 ? n : (n < 1536 ? n : (n < 3072 ? n + 16 : (zero ? 0 : 1536 + (n - 3072))));
    WprepTile r;
    r.sc = zero ? 0.f : ((which == 0 && n >= 1536 && n < 2048) ? 0.125f : 1.f);
    r.src = src + (size_t)(tk * 64 + (tid >> 6)) * Nsrc + nsrc; r.Nsrc = Nsrc;
    r.dst = dst + (size_t)(tn * 64) * 1024 + tk * 64;
    return r;
}
__device__ __forceinline__ void phase_wprep(const P& p, float* sm) {
    const int tid = opaque_tid();
    float (*tl)[64][65] = (float (*)[64][65])sm;
    const int ntile = 2 * 1600;
    for (int tile = blockIdx.x; tile < ntile; tile += 4 * gridDim.x) {
        WprepTile W[4]; bool has[4];
#pragma unroll
        for (int k = 0; k < 4; ++k) { const int tk_ = tile + k * (int)gridDim.x; has[k] = tk_ < ntile; W[k] = wprep_decode(p, has[k] ? tk_ : tile, tid); }
        float v[4][8];
#pragma unroll
        for (int k = 0; k < 4; ++k)
#pragma unroll
            for (int q = 0; q < 8; ++q) v[k][q] = W[k].src[(size_t)(8 * q) * W[k].Nsrc];
#pragma unroll
        for (int k = 0; k < 4; ++k)
#pragma unroll
            for (int q = 0; q < 8; ++q) tl[k][(tid >> 6) + 8 * q][tid & 63] = v[k][q] * W[k].sc;
        __syncthreads();
        for (int i = tid; i < 4096; i += NT) {
            const int nn = i >> 6, kk = i & 63;
#pragma unroll
            for (int k = 0; k < 4; ++k) if (has[k]) W[k].dst[(size_t)nn * 1024 + kk] = f2bf(tl[k][kk][nn]);
        }
        __syncthreads();
    }
}

__device__ __forceinline__ void phase_u1prep(const P& p, int l) {
    bf16_t* u1 = (bf16_t*)(p.ws + WS_U1);
    const int tid_ = opaque_tid(); const int lane = tid_ & 63, wave = tid_ >> 6;
    const int nwv = gridDim.x * NW, ppw = (M / 2 + nwv - 1) / nwv;
    const int rp_lo = (blockIdx.x * NW + wave) * ppw, rp_hi = min(rp_lo + ppw, M / 2);
    float4 sc[4], sh[4];
#pragma unroll
    for (int i = 0; i < 4; ++i) { sc[i] = make_float4(0.f, 0.f, 0.f, 0.f); sh[i] = make_float4(0.f, 0.f, 0.f, 0.f); }
    int cur_mr = -1;
    for (int rp = rp_lo; rp < rp_hi; ++rp) {
        float4 xv[2][4];
#pragma unroll
        for (int h = 0; h < 2; ++h) {
            const int r = 2 * rp + h; const float* xr = xrow(p, l, r);
#pragma unroll
            for (int i = 0; i < 4; ++i) { const int k0 = i * 256 + lane * 4; xv[h][i] = *(const float4*)(xr + k0); }
        }
        { const int mr = mod_row(2 * rp);
          if (mr != cur_mr) { cur_mr = mr; const float* mp = modp(p, l, 2 * rp);
#pragma unroll
              for (int i = 0; i < 4; ++i) { const int k0 = i * 256 + lane * 4; sc[i] = *(const float4*)(mp + 1024 + k0); sh[i] = *(const float4*)(mp + k0); } } }
#pragma unroll
        for (int h = 0; h < 2; ++h) {
            const int r = 2 * rp + h;
#pragma unroll
            for (int i = 0; i < 4; ++i) {
                const int k0 = i * 256 + lane * 4;
                uint2 pk;
                pk.x = pk_bf16(xv[h][i].x * (1.f + sc[i].x) + sh[i].x, xv[h][i].y * (1.f + sc[i].y) + sh[i].y);
                pk.y = pk_bf16(xv[h][i].z * (1.f + sc[i].z) + sh[i].z, xv[h][i].w * (1.f + sc[i].w) + sh[i].w);
                *(uint2*)(u1 + (size_t)r * 1024 + k0) = pk;
            }
        }
    }
}

__device__ __forceinline__ size_t nk_frag_off(int bh, int row, int a, int w, int ks, int key4, int fq) {
    return (size_t)(bh * 32 + row) * 4096 + a * 512 + w * 256 + ks * 128 + key4 * 32 + fq * 8;
}
struct EpiInproj {
    static constexpr bool PERM = true, AFTER_DRAIN = false;
    pg8::bf16_t* O; size_t split_stride; float* gates; const float* bgate;
    __device__ __forceinline__ void operator()(const pg8::f32x4 (&acc)[2][2][4][2], const pg8::Unit& u, int wr, int wc, int fr, int fq) const {
        const int row0 = u.pm * pg8::BM + wr * 64 + fr; const int colt0 = u.pn * pg8::BM;
        const int t = colt0 / 512;
        if (t == 6) {
            if (wc == 0 && fq < 2) {
#pragma unroll
                for (int ai = 0; ai < 2; ++ai)
#pragma unroll
                    for (int m = 0; m < 4; ++m) {
                        const int row = row0 + ai * pg8::HALF + m * 16;
                        const pg8::f32x4 v0 = acc[ai][0][m][0], v1 = acc[ai][0][m][1];
                        const float4 b0 = *(const float4*)(bgate + 8 * fq), b1 = *(const float4*)(bgate + 8 * fq + 4);
                        *(float4*)(gates + (size_t)row * 16 + 8 * fq) = make_float4(v0[0] + b0.x, v0[1] + b0.y, v0[2] + b0.z, v0[3] + b0.w);
                        *(float4*)(gates + (size_t)row * 16 + 8 * fq + 4) = make_float4(v1[0] + b1.x, v1[1] + b1.y, v1[2] + b1.z, v1[3] + b1.w);
                    }
            }
            return;
        }
        pg8::bf16_t* base = O + (size_t)t * split_stride; const int colt = colt0 - t * 512;
        const int col0 = colt + wc * 32 + 8 * fq;
        const bool frag = (t == 4) && (u.pm < ML / 256);
#pragma unroll
        for (int ai = 0; ai < 2; ++ai)
#pragma unroll
            for (int m = 0; m < 4; ++m) {
                const int row = row0 + ai * pg8::HALF + m * 16;
#pragma unroll
                for (int bj = 0; bj < 2; ++bj) {
                    const pg8::f32x4 v0 = acc[ai][bj][m][0], v1 = acc[ai][bj][m][1];
                    pg8::u32x4 w; w.x = pg8::cvt_pk_bf16(v0[0], v0[1]); w.y = pg8::cvt_pk_bf16(v0[2], v0[3]); w.z = pg8::cvt_pk_bf16(v1[0], v1[1]); w.w = pg8::cvt_pk_bf16(v1[2], v1[3]);
                    const int c = col0 + bj * pg8::HALF;
                    if (frag) {
                        const int b = row >> 11, tb = row & 2047, h = c >> 6, d = c & 63;
                        const int grow = tb >> 6, gcol = tb & 63;
                        *(pg8::u32x4*)(base + nk_frag_off(b * 8 + h, grow, gcol >> 3, (gcol >> 2) & 1, d >> 5, gcol & 3, (d >> 3) & 3)) = w;
                    } else {
                        *(pg8::u32x4*)(base + (size_t)row * 512 + c) = w;
                    }
                }
            }
    }
};
__device__ __forceinline__ void phase_inproj(const P& p, int l, unsigned char* smraw) {
    pg8::Gemm g{(const pg8::bf16_t*)(p.ws + WS_U1), (const pg8::bf16_t*)(p.ws + WS_WIN) + (size_t)l * 3328 * 1024, M, 3072, 1024};
    pg8::StaticOrder S; S.init(M, 3072, (int)gridDim.x, (int)blockIdx.x);
    EpiInproj E{(pg8::bf16_t*)(p.ws + WS_QKRAW), (size_t)M * 512, (float*)(p.ws + WS_GATES), p.b_gate + l * 16};
    pg8::gemm_phase<EpiInproj, pg8::StaticOrder, false>((PG8_LAS unsigned char*)smraw, g, S, E, nullptr);
    {
        const int tid = opaque_tid(); const int lane = tid & 63, wave = tid >> 6, fr = lane & 15, fq = lane >> 4;
        const bf16_t* wg = (const bf16_t*)(p.ws + WS_WIN) + ((size_t)l * 3328 + 3072) * 1024;
        const bf16_t* u1 = (const bf16_t*)(p.ws + WS_U1);
        float* gates = (float*)(p.ws + WS_GATES);
        __syncthreads();
        {
            uint4 wv[4];
#pragma unroll
            for (int q = 0; q < 4; ++q) { const int id = tid + NT * q; wv[q] = *(const uint4*)(wg + (size_t)(id >> 7) * 1024 + (id & 127) * 8); }
#pragma unroll
            for (int q = 0; q < 4; ++q) { const int id = tid + NT * q; *(uint4*)(smraw + (id >> 7) * 2064 + (id & 127) * 16) = wv[q]; }
        }
        __syncthreads();
        const float bias = p.b_gate[l * 16 + fr];
        for (int rt = blockIdx.x * NW + wave; rt < M / 16; rt += gridDim.x * NW) {
            f32x4v acc = {0.f, 0.f, 0.f, 0.f};
            const bf16_t* ap = u1 + (size_t)(rt * 16 + fr) * 1024 + 8 * fq;
#pragma unroll 1
            for (int kb = 0; kb < 4; ++kb) {
                bf16x8 a[8];
#pragma unroll
                for (int ks = 0; ks < 8; ++ks) a[ks] = *(const bf16x8*)(ap + (kb * 8 + ks) * 32);
#pragma unroll
                for (int ks = 0; ks < 8; ++ks) {
                    const bf16x8 bw = *(const bf16x8*)(smraw + fr * 2064 + ((kb * 8 + ks) * 32 + 8 * fq) * 2);
                    acc = __builtin_amdgcn_mfma_f32_16x16x32_bf16(a[ks], bw, acc, 0, 0, 0);
                }
            }
#pragma unroll
            for (int i = 0; i < 4; ++i) gates[(size_t)(rt * 16 + 4 * fq + i) * 16 + fr] = acc[i] + bias;
        }
        __syncthreads();
    }
}

__device__ __forceinline__ void phase_conv(const P& p, int l, float* sm) {
    const bf16_t* qkraw = (const bf16_t*)(p.ws + WS_QKRAW);
    bf16_t* qkact = (bf16_t*)(p.ws + WS_QKACT);
    const int tid = opaque_tid();
    float* cw_s = sm;
    float* cs_s = sm + 2560;
    float* sn_s = sm + 2560 + 1024;
    __syncthreads();
    for (int i = tid; i < 2560; i += NT) cw_s[i] = p.conv_w[l * 2560 + i];
    for (int i = tid; i < 1024; i += NT) { const int pos = i >> 4, f = i & 15; const float ang = (float)pos * powf(10000.f, -(float)f / 16.f); cs_s[i] = cosf(ang); sn_s[i] = sinf(ang); }
    __syncthreads();
    const int total = M * 32;
    for (int it = blockIdx.x * NT + tid; it < total; it += gridDim.x * NT) {
        const int r = it >> 5, hq = (it >> 2) & 7, jg = it & 3;
        const int c1 = hq * 64 + jg * 8;
        int base, t, Ts;
        if (r < ML) { base = r & ~2047; t = r & 2047; Ts = T; } else { const int rc = r - ML; base = ML + (rc & ~255); t = rc & 255; Ts = CT; }
        float y1[8], y2[8];
#pragma unroll
        for (int i = 0; i < 8; ++i) { y1[i] = 0.f; y2[i] = 0.f; }
#pragma unroll
        for (int jj = 0; jj < 5; ++jj) {
            const int tt = t + jj - 2;
            if (tt >= 0 && tt < Ts) {
                const bf16_t* rp = qkraw + (size_t)(base + tt) * 512 + c1;
                const uint4 a = *(const uint4*)rp, b = *(const uint4*)(rp + 32);
                const unsigned aw[4] = {a.x, a.y, a.z, a.w}, bw[4] = {b.x, b.y, b.z, b.w};
                const float* w1 = cw_s + jj * 512 + c1; const float* w2 = w1 + 32;
#pragma unroll
                for (int i = 0; i < 4; ++i) {
                    y1[2 * i] += __uint_as_float(aw[i] << 16) * w1[2 * i]; y1[2 * i + 1] += __uint_as_float(aw[i] & 0xffff0000u) * w1[2 * i + 1];
                    y2[2 * i] += __uint_as_float(bw[i] << 16) * w2[2 * i]; y2[2 * i + 1] += __uint_as_float(bw[i] & 0xffff0000u) * w2[2 * i + 1];
                }
            }
        }
        const float ks = hq >= 4 ? 0.125f : 1.f;
        const bool lat = r < ML;
        const int pos = (jg < 2) ? (t >> 6) : (t & 63);
        float o1[8], o2[8];
#pragma unroll
        for (int i = 0; i < 8; ++i) {
            const float a = siluf(y1[i]) * ks, b = siluf(y2[i]) * ks;
            if (lat) { const float cs = cs_s[pos * 16 + ((jg & 1) * 8 + i)], sn = sn_s[pos * 16 + ((jg & 1) * 8 + i)]; o1[i] = a * cs - b * sn; o2[i] = a * sn + b * cs; }
            else { o1[i] = a; o2[i] = b; }
        }
        bf16_t* op = qkact + (size_t)r * 512 + c1;
        *(uint4*)op = make_uint4(pk_bf16(o1[0], o1[1]), pk_bf16(o1[2], o1[3]), pk_bf16(o1[4], o1[5]), pk_bf16(o1[6], o1[7]));
        *(uint4*)(op + 32) = make_uint4(pk_bf16(o2[0], o2[1]), pk_bf16(o2[2], o2[3]), pk_bf16(o2[4], o2[5]), pk_bf16(o2[6], o2[7]));
    }
    __syncthreads();
}

typedef short bf16x4s __attribute__((ext_vector_type(4)));
constexpr int ML_RS = 144;
constexpr int ML_K = 0, ML_WKT = 9216, ML_Q = 18432, ML_VT = 27648, ML_OUT = 46080, ML_ARR = 63488;
__device__ __forceinline__ bf16x8 cvt8(const f32x16& x, int o) {
    union { unsigned u[4]; bf16x8 v; } r;
    r.u[0] = pk_bf16(x[o], x[o + 1]); r.u[1] = pk_bf16(x[o + 2], x[o + 3]); r.u[2] = pk_bf16(x[o + 4], x[o + 5]); r.u[3] = pk_bf16(x[o + 6], x[o + 7]);
    return r.v;
}
__device__ __forceinline__ bf16x8 ld2x4(const unsigned char* p) {
    union { bf16x4s h[2]; bf16x8 v; } r; r.h[0] = *(const bf16x4s*)p; r.h[1] = *(const bf16x4s*)(p + 16); return r.v;
}
__device__ __forceinline__ void lds_barrier() { asm volatile("s_waitcnt lgkmcnt(0)" ::: "memory"); __builtin_amdgcn_s_barrier(); asm volatile("" ::: "memory"); }
__device__ __forceinline__ void phase_gatescan(const P& p, int l, float* sm) {
    const float* gates = (const float*)(p.ws + WS_GATES);
    float* Gs = (float*)(p.ws + WS_GSC); float* PMs = Gs + 128 * 2304; float* Bs = PMs + 128 * 2304; float* MINs = Bs + 128 * 2304;
    const int tid = opaque_tid(); const int lane = tid & 63, wave = tid >> 6;
    float* b63 = sm; float* pm63 = sm + 64;
    for (int item = blockIdx.x; item < NB * 4 * 2; item += gridDim.x) {
        const int dir = item & 1, h = (item >> 1) & 3, b = item >> 3;
        __syncthreads();
        for (int ci = wave; ci < 36; ci += NW) {
            const bool isctx = ci < 4; const int base = isctx ? ML + b * CT : b * T; const int Ts = isctx ? CT : T; const int cl = isctx ? ci : ci - 4;
            const int pos = cl * 64 + lane; const int t = dir ? Ts - 1 - pos : pos;
            const float* gp = gates + (size_t)(base + t) * 16;
            const float li = gp[(2 * dir) * 4 + h], lfx = gp[(2 * dir + 1) * 4 + h];
            float bsum = fminf(lfx, 0.f) - __logf(1.f + __expf(-fabsf(lfx)));
#pragma unroll
            for (int d = 1; d < 64; d <<= 1) { const float tt = __shfl_up(bsum, d); if (lane >= d) bsum += tt; }
            const float g = li - bsum;
            float pm = g;
#pragma unroll
            for (int d = 1; d < 64; d <<= 1) { const float tt = __shfl_up(pm, d); if (lane >= d) pm = fmaxf(pm, tt); }
            const size_t idx = (size_t)item * 2304 + ci * 64 + lane;
            Gs[idx] = g; PMs[idx] = pm; Bs[idx] = bsum;
            if (lane == 63) { b63[ci] = bsum; pm63[ci] = pm; }
        }
        __syncthreads();
        if (tid == 0) {
            float m = 0.f;
            for (int ci = 0; ci < 36; ++ci) { MINs[item * 36 + ci] = m; m = b63[ci] + fmaxf(m, pm63[ci]); }
        }
    }
    __syncthreads();
}

__device__ __forceinline__ bf16x8 ld2x4x(const unsigned char* row, int s, int x) {
    union { bf16x4s h[2]; bf16x8 v; } r; r.h[0] = *(const bf16x4s*)(row + ((s ^ x) * 2)); r.h[1] = *(const bf16x4s*)(row + (((s + 8) ^ x) * 2)); return r.v;
}
__device__ __forceinline__ void phase_mlstm(const P& p, int l, unsigned char* sm) {
    const bool need_ctx = (l == 0);
    const bf16_t* qkact = (const bf16_t*)(p.ws + WS_QKACT);
    const bf16_t* vb = (const bf16_t*)(p.ws + WS_V);
    const float* Gs = (const float*)(p.ws + WS_GSC); const float* PMs = Gs + 128 * 2304; const float* Bs = PMs + 128 * 2304; const float* MINs = Bs + 128 * 2304;
    bf16_t* hdir = (bf16_t*)(p.ws + WS_HDIR);
    const int tid = opaque_tid(); const int lane = tid & 63, wave = tid >> 6, r = lane & 31, hh = lane >> 5;
    const int c = wave & 1, vt = wave >> 1, j = c * 32 + r;
    float* a_g = (float*)(sm + ML_ARR); float* a_M = a_g + 64; float* a_inter = a_M + 64; float* a_edn = a_inter + 64; float* a_n = a_edn + 64;
    const int srow = tid >> 3, part = tid & 7;
    for (int item = blockIdx.x; item < NB * 4 * 2; item += gridDim.x) {
        const int dir = item & 1, h = (item >> 1) & 3, b = item >> 3;
        f32x16 X0, X1;
#pragma unroll
        for (int i = 0; i < 16; ++i) { X0[i] = 0.f; X1[i] = 0.f; }
        __syncthreads();
        if (tid < 128) a_n[tid] = 0.f;
        uint4 pq, pk, pv0, pv1; float pg = 0.f, pgj = 0.f, ppm = 0.f, pb = 0.f, pmin = 0.f, ppm63 = 0.f;
        auto issue = [&](int ci) {
            const bool isctx = ci < 4; const int base = isctx ? ML + b * CT : b * T; const int Ts = isctx ? CT : T; const int cl = isctx ? ci : ci - 4;
            const int pos = cl * 64 + srow; const int t = dir ? Ts - 1 - pos : pos; const size_t ro = (size_t)(base + t) * 512;
            pq = *(const uint4*)(qkact + ro + h * 64 + part * 8); pk = *(const uint4*)(qkact + ro + 256 + h * 64 + part * 8);
            pv0 = *(const uint4*)(vb + ro + h * 128 + part * 16); pv1 = *(const uint4*)(vb + ro + h * 128 + part * 16 + 8);
            const size_t gi = (size_t)item * 2304 + ci * 64;
            pg = Gs[gi + srow]; pmin = MINs[item * 36 + ci]; ppm63 = PMs[gi + 63];
            if (tid < 64) { pgj = Gs[gi + tid]; ppm = PMs[gi + tid]; pb = Bs[gi + tid]; }
        };
        issue(0);
#pragma unroll 1
        for (int ci = 0; ci < 36; ++ci) {
            const bool isctx = ci < 4; const int base = isctx ? ML + b * CT : b * T; const int Ts = isctx ? CT : T; const int cl = isctx ? ci : ci - 4;
            const bool do_out = (!isctx) || need_ctx;
            const int nb = (ci & 1) * 64;
            const float m_in = pmin, M63 = fmaxf(pmin, ppm63);
            const float so = __expf(m_in - M63);
            const float wrow = __expf(pg - M63);
            *(uint4*)(sm + ML_Q + srow * ML_RS + part * 16) = pq;
            *(uint4*)(sm + ML_K + srow * ML_RS + part * 16) = pk;
            {
                const unsigned kw[4] = {pk.x, pk.y, pk.z, pk.w};
                const unsigned w[8] = {pv0.x, pv0.y, pv0.z, pv0.w, pv1.x, pv1.y, pv1.z, pv1.w};
#pragma unroll
                for (int i = 0; i < 4; ++i) {
                    *(bf16_t*)(sm + ML_WKT + (part * 8 + 2 * i) * ML_RS + (srow ^ (8 * part)) * 2) = f2bf(wrow * __uint_as_float(kw[i] << 16));
                    *(bf16_t*)(sm + ML_WKT + (part * 8 + 2 * i + 1) * ML_RS + (srow ^ (8 * part)) * 2) = f2bf(wrow * __uint_as_float(kw[i] & 0xffff0000u));
                }
#pragma unroll
                for (int i = 0; i < 8; ++i) {
                    *(bf16_t*)(sm + ML_VT + (part * 16 + 2 * i) * ML_RS + (srow ^ (8 * part)) * 2) = (bf16_t)(w[i] & 0xffffu);
                    *(bf16_t*)(sm + ML_VT + (part * 16 + 2 * i + 1) * ML_RS + (srow ^ (8 * part)) * 2) = (bf16_t)(w[i] >> 16);
                }
            }
            if (tid < 64) { const float Mv = fmaxf(m_in, ppm); a_g[tid] = pgj; a_M[tid] = Mv; a_inter[tid] = __expf(m_in - Mv); a_edn[tid] = __expf(-(pb + Mv)); }
            if (ci + 1 < 36) issue(ci + 1);
            lds_barrier();
            {
                const float Mjv = a_M[j], interj = a_inter[j];
                float nq;
                {
                    float acc = 0.f;
                    const unsigned char* qr = sm + ML_Q + j * ML_RS + hh * 64;
#pragma unroll
                    for (int k8 = 0; k8 < 4; ++k8) {
                        const uint4 w = *(const uint4*)(qr + k8 * 16);
                        const float4 n0 = *(const float4*)(a_n + nb + hh * 32 + k8 * 8), n1 = *(const float4*)(a_n + nb + hh * 32 + k8 * 8 + 4);
                        acc += n0.x * __uint_as_float(w.x << 16) + n0.y * __uint_as_float(w.x & 0xffff0000u) + n0.z * __uint_as_float(w.y << 16) + n0.w * __uint_as_float(w.y & 0xffff0000u);
                        acc += n1.x * __uint_as_float(w.z << 16) + n1.y * __uint_as_float(w.z & 0xffff0000u) + n1.z * __uint_as_float(w.w << 16) + n1.w * __uint_as_float(w.w & 0xffff0000u);
                    }
                    nq = acc + __shfl_xor(acc, 32);
                }
                {
                    const int k = wave * 8 + (lane >> 3), pc = lane & 7;
                    const uint4 w = *(const uint4*)(sm + ML_WKT + k * ML_RS + pc * 16);
                    float sacc = (__uint_as_float(w.x << 16) + __uint_as_float(w.x & 0xffff0000u)) + (__uint_as_float(w.y << 16) + __uint_as_float(w.y & 0xffff0000u))
                               + (__uint_as_float(w.z << 16) + __uint_as_float(w.z & 0xffff0000u)) + (__uint_as_float(w.w << 16) + __uint_as_float(w.w & 0xffff0000u));
                    sacc += __shfl_xor(sacc, 1); sacc += __shfl_xor(sacc, 2); sacc += __shfl_xor(sacc, 4);
                    if (pc == 0) a_n[(nb ^ 64) + k] = so * a_n[nb + k] + sacc;
                }
                f32x16 st0, st1, n2;
#pragma unroll
                for (int i = 0; i < 16; ++i) { st0[i] = 0.f; st1[i] = 0.f; n2[i] = 0.f; }
                float gs[2][16];
                if (do_out) {
#pragma unroll
                    for (int a = 0; a < 2; ++a)
#pragma unroll
                        for (int i = 0; i < 16; ++i) gs[a][i] = a_g[a * 32 + (i & 3) + 8 * (i >> 2) + 4 * hh];
#pragma unroll
                    for (int ks = 0; ks < 4; ++ks) {
                        const bf16x8 B = *(const bf16x8*)(sm + ML_Q + j * ML_RS + ks * 32 + hh * 16);
                        const bf16x8 A0 = *(const bf16x8*)(sm + ML_K + r * ML_RS + ks * 32 + hh * 16);
                        st0 = __builtin_amdgcn_mfma_f32_32x32x16_bf16(A0, B, st0, 0, 0, 0);
                        if (c == 1) {
                            const bf16x8 A1 = *(const bf16x8*)(sm + ML_K + (32 + r) * ML_RS + ks * 32 + hh * 16);
                            st1 = __builtin_amdgcn_mfma_f32_32x32x16_bf16(A1, B, st1, 0, 0, 0);
                        }
                    }
#pragma unroll
                    for (int s2 = 0; s2 < 2; ++s2) {
                        const bf16x8 B0 = ld2x4(sm + ML_Q + j * ML_RS + (16 * s2 + 4 * hh) * 2);
                        n2 = __builtin_amdgcn_mfma_f32_32x32x16_bf16(cvt8(X0, 8 * s2), B0, n2, 0, 0, 0);
                        const bf16x8 B1 = ld2x4(sm + ML_Q + j * ML_RS + (32 + 16 * s2 + 4 * hh) * 2);
                        n2 = __builtin_amdgcn_mfma_f32_32x32x16_bf16(cvt8(X1, 8 * s2), B1, n2, 0, 0, 0);
                    }
                }
#pragma unroll
                for (int i = 0; i < 16; ++i) { X0[i] *= so; X1[i] *= so; }
#pragma unroll
                for (int ks = 0; ks < 4; ++ks) {
                    const bf16x8 Bv = *(const bf16x8*)(sm + ML_VT + (vt * 32 + r) * ML_RS + (((ks * 16 + hh * 8) ^ (8 * ((2 * vt + (r >> 4)) & 7))) * 2));
                    const bf16x8 A0 = *(const bf16x8*)(sm + ML_WKT + r * ML_RS + (((ks * 16 + hh * 8) ^ (8 * ((r >> 3) & 7))) * 2));
                    X0 = __builtin_amdgcn_mfma_f32_32x32x16_bf16(A0, Bv, X0, 0, 0, 0);
                    const bf16x8 A1 = *(const bf16x8*)(sm + ML_WKT + (32 + r) * ML_RS + (((ks * 16 + hh * 8) ^ (8 * ((4 + (r >> 3)) & 7))) * 2));
                    X1 = __builtin_amdgcn_mfma_f32_32x32x16_bf16(A1, Bv, X1, 0, 0, 0);
                }
                if (do_out) {
                    float dsum = 0.f;
                    bf16x8 pf[2][2];
#pragma unroll
                    for (int i = 0; i < 16; ++i) {
                        const int s = (i & 3) + 8 * (i >> 2) + 4 * hh;
                        const float v = (s <= j) ? st0[i] * __expf(fminf(gs[0][i] - Mjv, 0.f)) : 0.f;
                        st0[i] = v; dsum += v;
                    }
                    pf[0][0] = cvt8(st0, 0); pf[0][1] = cvt8(st0, 8);
                    if (c == 1) {
#pragma unroll
                        for (int i = 0; i < 16; ++i) {
                            const int s = 32 + (i & 3) + 8 * (i >> 2) + 4 * hh;
                            const float v = (s <= j) ? st1[i] * __expf(fminf(gs[1][i] - Mjv, 0.f)) : 0.f;
                            st1[i] = v; dsum += v;
                        }
                        pf[1][0] = cvt8(st1, 0); pf[1][1] = cvt8(st1, 8);
                    }
                    f32x16 n1;
#pragma unroll
                    for (int i = 0; i < 16; ++i) n1[i] = 0.f;
#pragma unroll
                    for (int s2 = 0; s2 < 2; ++s2) {
                        const bf16x8 A = ld2x4x(sm + ML_VT + (vt * 32 + r) * ML_RS, 16 * s2 + 4 * hh, 8 * ((2 * vt + (r >> 4)) & 7));
                        n1 = __builtin_amdgcn_mfma_f32_32x32x16_bf16(A, pf[0][s2], n1, 0, 0, 0);
                    }
                    if (c == 1) {
#pragma unroll
                        for (int s2 = 0; s2 < 2; ++s2) {
                            const bf16x8 A = ld2x4x(sm + ML_VT + (vt * 32 + r) * ML_RS, 32 + 16 * s2 + 4 * hh, 8 * ((2 * vt + (r >> 4)) & 7));
                            n1 = __builtin_amdgcn_mfma_f32_32x32x16_bf16(A, pf[1][s2], n1, 0, 0, 0);
                        }
                    }
                    dsum += __shfl_xor(dsum, 32);
                    const float den = dsum + interj * nq;
                    const float rd = 1.f / fmaxf(fabsf(den), a_edn[j]);
#pragma unroll
                    for (int g4 = 0; g4 < 4; ++g4) {
                        uint2 w;
                        w.x = pk_bf16((n1[4 * g4] + interj * n2[4 * g4]) * rd, (n1[4 * g4 + 1] + interj * n2[4 * g4 + 1]) * rd);
                        w.y = pk_bf16((n1[4 * g4 + 2] + interj * n2[4 * g4 + 2]) * rd, (n1[4 * g4 + 3] + interj * n2[4 * g4 + 3]) * rd);
                        *(uint2*)(sm + ML_OUT + j * 272 + (vt * 32 + 8 * g4 + 4 * hh) * 2) = w;
                    }
                }
            }
            lds_barrier();
            if (do_out) {
                const int pos = cl * 64 + srow; const int t = dir ? Ts - 1 - pos : pos;
                bf16_t* dst = hdir + ((size_t)dir * M + base + t) * 512 + h * 128 + part * 16;
                *(uint4*)dst = *(const uint4*)(sm + ML_OUT + srow * 272 + part * 32);
                *(uint4*)(dst + 8) = *(const uint4*)(sm + ML_OUT + srow * 272 + part * 32 + 16);
            }
        }
    }
}

constexpr size_t NVT_CTX = (size_t)128 * 32 * 4096;
__device__ __forceinline__ void phase_vtrans(const P& p, unsigned char* sm) {
    const bf16_t* nv = (const bf16_t*)(p.ws + WS_NV);
    bf16_t* nvT = (bf16_t*)(p.ws + WS_NVT);
    const int tid = opaque_tid();
    for (int it = blockIdx.x; it < 128 * 36; it += gridDim.x) {
        const int bh = it / 36, tt = it % 36, b = bh >> 3, h = bh & 7;
        const int row0 = tt < 32 ? b * T + tt * 64 : ML + b * CT + (tt - 32) * 64;
        __syncthreads();
        {
            const int tk = tid >> 3, pc = tid & 7;
            const uint4 v = *(const uint4*)(nv + (size_t)(row0 + tk) * 512 + h * 64 + pc * 8);
            const unsigned w[4] = {v.x, v.y, v.z, v.w};
#pragma unroll
            for (int i = 0; i < 4; ++i) {
                *(bf16_t*)(sm + (pc * 8 + 2 * i) * 144 + tk * 2) = (bf16_t)(w[i] & 0xffffu);
                *(bf16_t*)(sm + (pc * 8 + 2 * i + 1) * 144 + tk * 2) = (bf16_t)(w[i] >> 16);
            }
        }
        __syncthreads();
        {
            const int d = tid >> 3, pc = tid & 7;
            const uint4 v8 = *(const uint4*)(sm + d * 144 + pc * 16);
            if (tt < 32) *(uint4*)(nvT + ((size_t)(bh * 32 + tt) * 8 + pc) * 512 + d * 8) = v8;
            else *(uint4*)(nvT + NVT_CTX + ((size_t)bh * 64 + d) * 256 + (tt - 32) * 64 + pc * 8) = v8;
        }
    }
    __syncthreads();
}

constexpr int NA_KC = 0, NA_VC = 36864, NA_RPB = 36864 + 33792, NA_CTL = NA_RPB + 14880;
constexpr size_t WS_CNT = 0xE4000;
__device__ __forceinline__ void phase_na(const P& p, int l, unsigned char* sm) {
    const bool need_ctx = (l == 0);
    const bf16_t* nq = (const bf16_t*)(p.ws + WS_NQ); const bf16_t* nk = (const bf16_t*)(p.ws + WS_NK);
    const bf16_t* nvT = (const bf16_t*)(p.ws + WS_NVT);
    bf16_t* mix = (bf16_t*)(p.ws + WS_MIX);
    unsigned* counter = (unsigned*)(p.ws + WS_CNT) + 16 * l;
    const int tid = opaque_tid(); const int lane = tid & 63, wave = tid >> 6;
    float* rpb_s = (float*)(sm + NA_RPB);
    volatile int* ctl = (volatile int*)(sm + NA_CTL);
    __syncthreads();
    {
        float rv[8];
#pragma unroll
        for (int q = 0; q < 8; ++q) { const int i = tid + NT * q; rv[q] = i < 8 * 465 ? p.na_rpb[(size_t)l * 8 * 465 + i] : 0.f; }
#pragma unroll
        for (int q = 0; q < 8; ++q) { const int i = tid + NT * q; if (i < 8 * 465) rpb_s[i] = rv[q]; }
    }
    for (;;) {
        __syncthreads();
        if (tid == 0) ctl[0] = (int)atomicAdd(counter, 1u);
        __syncthreads();
        const int item = ctl[0];
        const int nitems = need_ctx ? 640 : 512;
        if (item >= nitems) break;
        const bool cq_item = item >= 512;
        const int bh = cq_item ? (item - 512) : (item >> 2), quarter = item & 3, b = bh >> 3, h = bh & 7;
        {
            uint4 kv[4], vv[4];
#pragma unroll
            for (int i = 0; i < 4; ++i) { const int id = tid + NT * i;
                kv[i] = *(const uint4*)(nk + (size_t)(ML + b * CT + (id >> 3)) * 512 + h * 64 + (id & 7) * 8);
                vv[i] = *(const uint4*)(nvT + NVT_CTX + ((size_t)bh * 64 + (id >> 5)) * 256 + (id & 31) * 8); }
#pragma unroll
            for (int i = 0; i < 4; ++i) { const int id = tid + NT * i;
                *(uint4*)(sm + NA_KC + (id >> 3) * 144 + (id & 7) * 16) = kv[i];
                *(uint4*)(sm + NA_VC + (id >> 5) * 528 + (id & 31) * 16) = vv[i]; }
        }
        __syncthreads();
        const int nun = cq_item ? 16 : 32;
        for (int un = wave; un < nun; un += NW) {
            int lane_o = lane; asm volatile("" : "+v"(lane_o));
            const int fr = lane_o & 15, fq = lane_o >> 4, krow_off = 8 * (fr >> 2) + (fr & 3);
            const bool lat = !cq_item;
            int qtok0, r = 0, cb = 0;
            if (lat) { r = quarter * 8 + (un & 7); cb = un >> 3; qtok0 = b * T + r * 64 + cb * 16; }
            else qtok0 = ML + b * CT + un * 16;
            const int r0 = min(max(r - 4, 0), 24);
            const int c0 = min(max(cb * 16 - 8, 0), 32);
            const int qc = cb * 16 + fr;
            const int wl = min(max(qc - 8, 0), 48);
            const bf16_t* qp = nq + (size_t)(qtok0 + fr) * 512 + h * 64 + 8 * fq;
            const bf16x8 qf0 = *(const bf16x8*)qp, qf1 = *(const bf16x8*)(qp + 32);
            float mrun = -1e30f, sum = 0.f;
            f32x4v o[4];
#pragma unroll
            for (int m = 0; m < 4; ++m) o[m] = (f32x4v){0.f, 0.f, 0.f, 0.f};
#define NA_GROUP(S0, S1, VF0, VF1, VF2, VF3) do { \
                float gm_ = fmaxf(fmaxf(fmaxf(S0[0], S0[1]), fmaxf(S0[2], S0[3])), fmaxf(fmaxf(S1[0], S1[1]), fmaxf(S1[2], S1[3]))); \
                gm_ = fmaxf(gm_, __shfl_xor(gm_, 16)); gm_ = fmaxf(gm_, __shfl_xor(gm_, 32)); \
                const float mn_ = fmaxf(mrun, gm_); const float al_ = __expf(mrun - mn_); mrun = mn_; \
                float ps_ = 0.f; \
                _Pragma("unroll") for (int j_ = 0; j_ < 4; ++j_) { S0[j_] = __expf(S0[j_] - mn_); S1[j_] = __expf(S1[j_] - mn_); ps_ += S0[j_] + S1[j_]; } \
                sum = sum * al_ + ps_; \
                _Pragma("unroll") for (int m_ = 0; m_ < 4; ++m_) { o[m_][0] *= al_; o[m_][1] *= al_; o[m_][2] *= al_; o[m_][3] *= al_; } \
                union { unsigned u[4]; bf16x8 v; } pf_; \
                pf_.u[0] = pk_bf16(S0[0], S0[1]); pf_.u[1] = pk_bf16(S0[2], S0[3]); pf_.u[2] = pk_bf16(S1[0], S1[1]); pf_.u[3] = pk_bf16(S1[2], S1[3]); \
                o[0] = __builtin_amdgcn_mfma_f32_16x16x32_bf16(VF0, pf_.v, o[0], 0, 0, 0); o[1] = __builtin_amdgcn_mfma_f32_16x16x32_bf16(VF1, pf_.v, o[1], 0, 0, 0); \
                o[2] = __builtin_amdgcn_mfma_f32_16x16x32_bf16(VF2, pf_.v, o[2], 0, 0, 0); o[3] = __builtin_amdgcn_mfma_f32_16x16x32_bf16(VF3, pf_.v, o[3], 0, 0, 0); } while (0)
            auto ctx_group = [&](const int pg) {
                const unsigned char* kp = sm + NA_KC + (32 * pg + krow_off) * 144 + 16 * fq;
                const bf16x8 k00 = *(const bf16x8*)kp, k01 = *(const bf16x8*)(kp + 64);
                const bf16x8 k10 = *(const bf16x8*)(kp + 4 * 144), k11 = *(const bf16x8*)(kp + 4 * 144 + 64);
                const unsigned char* vp = sm + NA_VC + fr * 528 + (32 * pg + 8 * fq) * 2;
                const bf16x8 vf0 = *(const bf16x8*)vp, vf1 = *(const bf16x8*)(vp + 16 * 528), vf2 = *(const bf16x8*)(vp + 32 * 528), vf3 = *(const bf16x8*)(vp + 48 * 528);
                f32x4v a0 = {0.f, 0.f, 0.f, 0.f}, a1 = {0.f, 0.f, 0.f, 0.f};
                a0 = __builtin_amdgcn_mfma_f32_16x16x32_bf16(k00, qf0, a0, 0, 0, 0); a0 = __builtin_amdgcn_mfma_f32_16x16x32_bf16(k01, qf1, a0, 0, 0, 0);
                a1 = __builtin_amdgcn_mfma_f32_16x16x32_bf16(k10, qf0, a1, 0, 0, 0); a1 = __builtin_amdgcn_mfma_f32_16x16x32_bf16(k11, qf1, a1, 0, 0, 0);
                NA_GROUP(a0, a1, vf0, vf1, vf2, vf3);
            };
            const int nlead = lat ? wave : 0;
#pragma unroll 1
            for (int pg = 0; pg < nlead; ++pg) ctx_group(pg);
            if (lat) {
                const float* rp = rpb_s + h * 465;
                const bf16_t* vbase = nvT + (size_t)(bh * 32 + r0) * 4096 + ((c0 >> 3) + fq) * 512 + fr * 8;
                const bf16_t* kbase = nk + nk_frag_off(bh, r0, (c0 >> 3) + (fr >> 2), 0, 0, fr & 3, fq);
                int dcv[8]; bool okv[8];
#pragma unroll
                for (int j = 0; j < 8; ++j) { const int kc = c0 + 8 * fq + j; okv[j] = (kc >= wl) && (kc < wl + 16); dcv[j] = min(max(kc - qc + 15, 0), 30); }
#define NA_LOADG(K, V, i) do { \
                    const bf16_t* kp_ = kbase + (size_t)(i) * 4096; \
                    K[0] = *(const bf16x8*)kp_; K[1] = *(const bf16x8*)(kp_ + 128); K[2] = *(const bf16x8*)(kp_ + 256); K[3] = *(const bf16x8*)(kp_ + 384); \
                    const bf16_t* vp_ = vbase + (size_t)(i) * 4096; \
                    V[0] = *(const bf16x8*)vp_; V[1] = *(const bf16x8*)(vp_ + 128); V[2] = *(const bf16x8*)(vp_ + 256); V[3] = *(const bf16x8*)(vp_ + 384); \
                    } while (0)
#define NA_COMPG(K, V, i) do { \
                    float BB[8]; const float* rr_ = rp + (r0 + (i) - r + 7) * 31; \
                    _Pragma("unroll") for (int j_ = 0; j_ < 8; ++j_) BB[j_] = rr_[dcv[j_]]; \
                    f32x4v a0_ = {0.f, 0.f, 0.f, 0.f}, a1_ = {0.f, 0.f, 0.f, 0.f}; \
                    a0_ = __builtin_amdgcn_mfma_f32_16x16x32_bf16(K[0], qf0, a0_, 0, 0, 0); a0_ = __builtin_amdgcn_mfma_f32_16x16x32_bf16(K[1], qf1, a0_, 0, 0, 0); \
                    a1_ = __builtin_amdgcn_mfma_f32_16x16x32_bf16(K[2], qf0, a1_, 0, 0, 0); a1_ = __builtin_amdgcn_mfma_f32_16x16x32_bf16(K[3], qf1, a1_, 0, 0, 0); \
                    _Pragma("unroll") for (int j_ = 0; j_ < 4; ++j_) { a0_[j_] = okv[j_] ? a0_[j_] + BB[j_] : -1e30f; a1_[j_] = okv[4 + j_] ? a1_[j_] + BB[4 + j_] : -1e30f; } \
                    NA_GROUP(a0_, a1_, V[0], V[1], V[2], V[3]); } while (0)
                bf16x8 KA[4], VA[4], KB[4], VB[4];
                NA_LOADG(KA, VA, 0);
                NA_LOADG(KB, VB, 1); NA_COMPG(KA, VA, 0);
                NA_LOADG(KA, VA, 2); NA_COMPG(KB, VB, 1);
                NA_LOADG(KB, VB, 3); NA_COMPG(KA, VA, 2);
                NA_LOADG(KA, VA, 4); NA_COMPG(KB, VB, 3);
                NA_LOADG(KB, VB, 5); NA_COMPG(KA, VA, 4);
                NA_LOADG(KA, VA, 6); NA_COMPG(KB, VB, 5);
                NA_LOADG(KB, VB, 7); NA_COMPG(KA, VA, 6);
                NA_COMPG(KB, VB, 7);
#undef NA_LOADG
#undef NA_COMPG
            }
#pragma unroll 1
            for (int pg = nlead; pg < 8; ++pg) ctx_group(pg);
#undef NA_GROUP
            sum += __shfl_xor(sum, 16); sum += __shfl_xor(sum, 32);
            const float rs = 1.f / sum;
            bf16_t* op = mix + (size_t)(qtok0 + fr) * 1024 + 512 + h * 64 + 4 * fq;
#pragma unroll
            for (int m = 0; m < 4; ++m) {
                uint2 w; w.x = pk_bf16(o[m][0] * rs, o[m][1] * rs); w.y = pk_bf16(o[m][2] * rs, o[m][3] * rs);
                *(uint2*)(op + m * 16) = w;
            }
        }
    }
}

__device__ __forceinline__ void phase_combine(const P& p, int l) {
    const bool need_ctx = (l == 0);
    const bf16_t* hdir = (const bf16_t*)(p.ws + WS_HDIR); const bf16_t* ob = (const bf16_t*)(p.ws + WS_O);
    bf16_t* mix = (bf16_t*)(p.ws + WS_MIX);
    const int tid_ = opaque_tid(); const int lane = tid_ & 63, wave = tid_ >> 6;
    const float4 nw0 = *(const float4*)(p.ml_norm_w + l * 512 + lane * 8), nw1 = *(const float4*)(p.ml_norm_w + l * 512 + lane * 8 + 4);
    const float nw[8] = {nw0.x, nw0.y, nw0.z, nw0.w, nw1.x, nw1.y, nw1.z, nw1.w};
    const int rows = need_ctx ? M : ML;
    for (int rp = blockIdx.x * NW + wave; rp < rows / 2; rp += gridDim.x * NW) {
        uint4 a[2], b[2], og[2];
#pragma unroll
        for (int h = 0; h < 2; ++h) { const size_t o0 = (size_t)(2 * rp + h) * 512 + lane * 8; a[h] = *(const uint4*)(hdir + o0); b[h] = *(const uint4*)(hdir + (size_t)M * 512 + o0); og[h] = *(const uint4*)(ob + o0); }
#pragma unroll
        for (int h = 0; h < 2; ++h) {
            const int r = 2 * rp + h;
            const unsigned aw[4] = {a[h].x, a[h].y, a[h].z, a[h].w}, bw[4] = {b[h].x, b[h].y, b[h].z, b[h].w}, gw[4] = {og[h].x, og[h].y, og[h].z, og[h].w};
            float v[8]; float s = 0.f;
#pragma unroll
            for (int i = 0; i < 4; ++i) {
                v[2 * i] = __uint_as_float(aw[i] << 16) + __uint_as_float(bw[i] << 16);
                v[2 * i + 1] = __uint_as_float(aw[i] & 0xffff0000u) + __uint_as_float(bw[i] & 0xffff0000u);
                s += v[2 * i] + v[2 * i + 1];
            }
            s += __shfl_xor(s, 8); s += __shfl_xor(s, 4); s += __shfl_xor(s, 2); s += __shfl_xor(s, 1);
            const float mu = s * (1.f / 128.f);
            float q = 0.f;
#pragma unroll
            for (int i = 0; i < 8; ++i) { v[i] -= mu; q += v[i] * v[i]; }
            q += __shfl_xor(q, 8); q += __shfl_xor(q, 4); q += __shfl_xor(q, 2); q += __shfl_xor(q, 1);
            const float rstd = rsqrtf(q * (1.f / 128.f) + LN_EPS);
            float o[8];
#pragma unroll
            for (int i = 0; i < 4; ++i) {
                o[2 * i] = v[2 * i] * rstd * nw[2 * i] * sigmoidf(__uint_as_float(gw[i] << 16));
                o[2 * i + 1] = v[2 * i + 1] * rstd * nw[2 * i + 1] * sigmoidf(__uint_as_float(gw[i] & 0xffff0000u));
            }
            *(uint4*)(mix + (size_t)r * 1024 + lane * 8) = make_uint4(pk_bf16(o[0], o[1]), pk_bf16(o[2], o[3]), pk_bf16(o[4], o[5]), pk_bf16(o[6], o[7]));
        }
    }
}

__device__ __forceinline__ void phase_outproj(const P& p, int l, unsigned char* smraw) {
    const int rows = (l == 0) ? M : ML;
    pg8::Gemm g{(const pg8::bf16_t*)(p.ws + WS_MIX), (const pg8::bf16_t*)(p.ws + WS_WOUT) + (size_t)l * 1024 * 1024, rows, 1024, 1024};
    pg8::StaticOrder S; S.init(rows, 1024, (int)gridDim.x, (int)blockIdx.x);
    pg8::EpiBf16<0> E{(pg8::bf16_t*)(p.ws + WS_Y), 1024, nullptr, 0, 0};
    pg8::gemm_phase<pg8::EpiBf16<0>, pg8::StaticOrder, false>((PG8_LAS unsigned char*)smraw, g, S, E, nullptr);
}

__device__ __forceinline__ void phase_ln1(const P& p, int l) {
    const bf16_t* y = (const bf16_t*)(p.ws + WS_Y);
    bf16_t* u2 = (bf16_t*)(p.ws + WS_U2);
    const float* lw = p.ln1_w + l * D; const float* lb = p.ln1_b + l * D;
    const int tid_ = opaque_tid(); const int lane = tid_ & 63, wave = tid_ >> 6;
    const int rows = (l == 0) ? M : ML;
    const int k0 = lane * 16;
    const int nwv = gridDim.x * NW, qpw = (rows / 4 + nwv - 1) / nwv;
    const int rp_lo = (blockIdx.x * NW + wave) * qpw, rp_hi = min(rp_lo + qpw, rows / 4);
    float4 w4r[4], b4r[4], g1r[4], scr[4], shr[4];
#pragma unroll
    for (int v4 = 0; v4 < 4; ++v4) { w4r[v4] = *(const float4*)(lw + k0 + v4 * 4); b4r[v4] = *(const float4*)(lb + k0 + v4 * 4);
        g1r[v4] = make_float4(0.f, 0.f, 0.f, 0.f); scr[v4] = make_float4(0.f, 0.f, 0.f, 0.f); shr[v4] = make_float4(0.f, 0.f, 0.f, 0.f); }
    int cur_mr = -1;
    for (int rp = rp_lo; rp < rp_hi; ++rp) {
        { const int mr = mod_row(4 * rp);
          if (mr != cur_mr) { cur_mr = mr; const float* mpq = modp(p, l, 4 * rp);
#pragma unroll
              for (int v4 = 0; v4 < 4; ++v4) { g1r[v4] = *(const float4*)(mpq + 2048 + k0 + v4 * 4); scr[v4] = *(const float4*)(mpq + 4096 + k0 + v4 * 4); shr[v4] = *(const float4*)(mpq + 3072 + k0 + v4 * 4); } } }
        float z[4][16]; float s[4] = {0.f, 0.f, 0.f, 0.f};
#pragma unroll
        for (int h = 0; h < 4; ++h) {
            const int r = 4 * rp + h;
            const float* xr = xrow(p, l, r); const float* mp = modp(p, l, r);
            const uint4 ya = *(const uint4*)(y + (size_t)r * 1024 + k0), yb = *(const uint4*)(y + (size_t)r * 1024 + k0 + 8);
            const unsigned yw[8] = {ya.x, ya.y, ya.z, ya.w, yb.x, yb.y, yb.z, yb.w};
#pragma unroll
            for (int v4 = 0; v4 < 4; ++v4) {
                float4 xv; const float4 g1 = g1r[v4];
                if (l == 0) xv = *(const float4*)(xr + k0 + v4 * 4);
                else { const uint2 xb_ = *(const uint2*)((const bf16_t*)xr + k0 + v4 * 4);
                       xv = make_float4(__uint_as_float(xb_.x << 16), __uint_as_float(xb_.x & 0xffff0000u), __uint_as_float(xb_.y << 16), __uint_as_float(xb_.y & 0xffff0000u)); }
                z[h][v4 * 4 + 0] = ALPHA * xv.x + g1.x * __uint_as_float(yw[v4 * 2] << 16);
                z[h][v4 * 4 + 1] = ALPHA * xv.y + g1.y * __uint_as_float(yw[v4 * 2] & 0xffff0000u);
                z[h][v4 * 4 + 2] = ALPHA * xv.z + g1.z * __uint_as_float(yw[v4 * 2 + 1] << 16);
                z[h][v4 * 4 + 3] = ALPHA * xv.w + g1.w * __uint_as_float(yw[v4 * 2 + 1] & 0xffff0000u);
                s[h] += (z[h][v4 * 4] + z[h][v4 * 4 + 1]) + (z[h][v4 * 4 + 2] + z[h][v4 * 4 + 3]);
            }
        }
        float mu[4], rstd[4];
#pragma unroll
        for (int h = 0; h < 4; ++h) mu[h] = wave_sum(s[h]) * (1.f / 1024.f);
#pragma unroll
        for (int h = 0; h < 4; ++h) {
            float q = 0.f;
#pragma unroll
            for (int i = 0; i < 16; ++i) { const float d = z[h][i] - mu[h]; q += d * d; }
            rstd[h] = rsqrtf(wave_sum(q) * (1.f / 1024.f) + LN_EPS);
        }
#pragma unroll
        for (int h = 0; h < 4; ++h) {
            const int r = 4 * rp + h;
            const float* mp = modp(p, l, r);
            float* xo = xrow_w(p, r);
            float uo[16]; float am = 0.f; float x1v[16];
#pragma unroll
            for (int v4 = 0; v4 < 4; ++v4) {
                const int k = k0 + v4 * 4;
                const float4 w4 = w4r[v4], b4 = b4r[v4], sc = scr[v4], sh = shr[v4];
                float4 o;
                o.x = (z[h][v4 * 4] - mu[h]) * rstd[h] * w4.x + b4.x; o.y = (z[h][v4 * 4 + 1] - mu[h]) * rstd[h] * w4.y + b4.y;
                o.z = (z[h][v4 * 4 + 2] - mu[h]) * rstd[h] * w4.z + b4.z; o.w = (z[h][v4 * 4 + 3] - mu[h]) * rstd[h] * w4.w + b4.w;
                x1v[v4 * 4] = o.x; x1v[v4 * 4 + 1] = o.y; x1v[v4 * 4 + 2] = o.z; x1v[v4 * 4 + 3] = o.w;
                uo[v4 * 4] = o.x * (1.f + sc.x) + sh.x; uo[v4 * 4 + 1] = o.y * (1.f + sc.y) + sh.y; uo[v4 * 4 + 2] = o.z * (1.f + sc.z) + sh.z; uo[v4 * 4 + 3] = o.w * (1.f + sc.w) + sh.w;
            }
            {
                bf16_t* xb = (bf16_t*)xo + k0;
                *(uint4*)xb = make_uint4(pk_bf16(x1v[0], x1v[1]), pk_bf16(x1v[2], x1v[3]), pk_bf16(x1v[4], x1v[5]), pk_bf16(x1v[6], x1v[7]));
                *(uint4*)(xb + 8) = make_uint4(pk_bf16(x1v[8], x1v[9]), pk_bf16(x1v[10], x1v[11]), pk_bf16(x1v[12], x1v[13]), pk_bf16(x1v[14], x1v[15]));
            }
            bf16_t* up_ = u2 + (size_t)r * 1024 + k0;
            *(uint4*)up_ = make_uint4(pk_bf16(uo[0], uo[1]), pk_bf16(uo[2], uo[3]), pk_bf16(uo[4], uo[5]), pk_bf16(uo[6], uo[7]));
            *(uint4*)(up_ + 8) = make_uint4(pk_bf16(uo[8], uo[9]), pk_bf16(uo[10], uo[11]), pk_bf16(uo[12], uo[13]), pk_bf16(uo[14], uo[15]));
#pragma unroll
            for (int i = 0; i < 16; ++i) am = fmaxf(am, fabsf(uo[i]));
            am = wave_max(am);
            const float inv = am > 0.f ? 127.f / am : 0.f;
            unsigned w[4];
#pragma unroll
            for (int d = 0; d < 4; ++d) {
                unsigned x = 0;
#pragma unroll
                for (int i = 0; i < 4; ++i) x |= (unsigned)(min(max((int)rintf(uo[d * 4 + i] * inv), -127), 127) & 0xff) << (8 * i);
                w[d] = x;
            }
            *(uint4*)(p.ws + WS_U2Q + (size_t)r * 1024 + k0) = make_uint4(w[0], w[1], w[2], w[3]);
            if (lane == 0) ((float*)(p.ws + WS_USC))[r] = am > 0.f ? am / 127.f : 0.f;
        }
    }
}

__device__ __forceinline__ void phase_peerq(const P& p, int l, unsigned char* smraw) {
    const int rows = (l == 0) ? M : ML;
    pg8::Gemm g{(const pg8::bf16_t*)(p.ws + WS_U2), (const pg8::bf16_t*)(p.ws + WS_WQ) + (size_t)l * 2048 * 1024, rows, 2048, 1024};
    pg8::StaticOrder S; S.init(rows, 2048, (int)gridDim.x, (int)blockIdx.x);
    pg8::EpiQFrag E{(pg8::bf16_t*)(p.ws + WS_Q)};
    pg8::gemm_phase<pg8::EpiQFrag, pg8::StaticOrder, false>((PG8_LAS unsigned char*)smraw, g, S, E, nullptr);
}

__device__ __forceinline__ unsigned f2key(float f) { const unsigned u = __float_as_uint(f); return (u & 0x80000000u) ? ~u : (u | 0x80000000u); }
__device__ __forceinline__ float key2f(unsigned k) { const unsigned u = (k & 0x80000000u) ? (k & 0x7fffffffu) : ~k; return __uint_as_float(u); }
__device__ __forceinline__ void ce_desc(unsigned& a, unsigned& b) { const unsigned mx = a > b ? a : b, mn = a > b ? b : a; a = mx; b = mn; }
__device__ __forceinline__ void sort16_desc(unsigned (&a)[16]) {
#define CE(i, j) ce_desc(a[i], a[j]);
    CE(0,1) CE(2,3) CE(0,2) CE(1,3) CE(1,2) CE(4,5) CE(6,7) CE(4,6) CE(5,7) CE(5,6) CE(0,4) CE(2,6) CE(2,4) CE(1,5) CE(3,7) CE(3,5) CE(1,2) CE(3,4) CE(5,6) CE(8,9) CE(10,11) CE(8,10) CE(9,11) CE(9,10) CE(12,13) CE(14,15) CE(12,14) CE(13,15) CE(13,14) CE(8,12) CE(10,14) CE(10,12) CE(9,13) CE(11,15) CE(11,13) CE(9,10) CE(11,12) CE(13,14) CE(0,8) CE(4,12) CE(4,8) CE(2,10) CE(6,14) CE(6,10) CE(2,4) CE(6,8) CE(10,12) CE(1,9) CE(5,13) CE(5,9) CE(3,11) CE(7,15) CE(7,11) CE(3,5) CE(7,9) CE(11,13) CE(1,2) CE(3,4) CE(5,6) CE(7,8) CE(9,10) CE(11,12) CE(13,14)
#undef CE
}
__device__ __forceinline__ void merge16_desc(unsigned (&a)[16], const unsigned (&b)[16]) {
#pragma unroll
    for (int i = 0; i < 16; ++i) a[i] = a[i] > b[15 - i] ? a[i] : b[15 - i];
#pragma unroll
    for (int j = 8; j > 0; j >>= 1)
#pragma unroll
        for (int i = 0; i < 16; ++i) { const int l = i ^ j; if (l > i) ce_desc(a[i], a[l]); }
}
__device__ __forceinline__ void top16_of_acc(const f32x16 (&acc)[4], int hh, unsigned (&out)[16]) {
    unsigned g1[16], g2[16], g3[16];
#pragma unroll
    for (int r = 0; r < 16; ++r) {
        const int nb = (r & 3) + 8 * (r >> 2);
        out[r] = (f2key(acc[0][r]) & ~127u) | (unsigned)(127 - (nb + 4 * hh));
        g1[r]  = (f2key(acc[1][r]) & ~127u) | (unsigned)(127 - (32 + nb + 4 * hh));
        g2[r]  = (f2key(acc[2][r]) & ~127u) | (unsigned)(127 - (64 + nb + 4 * hh));
        g3[r]  = (f2key(acc[3][r]) & ~127u) | (unsigned)(127 - (96 + nb + 4 * hh));
    }
    sort16_desc(out); sort16_desc(g1); sort16_desc(g2); sort16_desc(g3);
    merge16_desc(out, g1); merge16_desc(g2, g3); merge16_desc(out, g2);
#pragma unroll
    for (int i = 0; i < 16; ++i) g1[i] = (unsigned)__shfl_xor((int)out[i], 32);
    merge16_desc(out, g1);
}
constexpr int TK_KEYS_BYTES = 256 * 272;
__device__ __forceinline__ void phase_topk(const P& p, int l, unsigned char* smraw) {
    const bf16_t* q = (const bf16_t*)(p.ws + WS_Q);
    int* eidx = (int*)(p.ws + WS_EIDX); float* egate = (float*)(p.ws + WS_EGATE);
    const int tid = opaque_tid(); const int lane = tid & 63, wave = tid >> 6, tl = lane & 31, hh = lane >> 5;
    unsigned char* keys_lds = smraw;
    PG8_LAS unsigned char* slot = (PG8_LAS unsigned char*)smraw + TK_KEYS_BYTES + wave * 2048 + lane * 32;
    const int rows = (l == 0) ? M : ML;
    const int nchunks = rows / 256;
    int cur_h = -1;
    for (int it = blockIdx.x; it < 8 * nchunks; it += gridDim.x) {
        const int h = it & 7, chunk = it >> 3;
        if (h != cur_h) {
            __syncthreads();
            const float* kb = p.peer_keys + (size_t)(l * 8 + h) * 2 * 128 * 128;
            {
                float4 f0[8], f1[8];
#pragma unroll
                for (int q = 0; q < 8; ++q) { const int i = tid + NT * q; const int row = i >> 4, c8 = i & 15;
                    f0[q] = *(const float4*)(kb + (size_t)row * 128 + c8 * 8); f1[q] = *(const float4*)(kb + (size_t)row * 128 + c8 * 8 + 4); }
#pragma unroll
                for (int q = 0; q < 8; ++q) { const int i = tid + NT * q; const int row = i >> 4, c8 = i & 15;
                    uint4 w; w.x = pk_bf16(f0[q].x, f0[q].y); w.y = pk_bf16(f0[q].z, f0[q].w); w.z = pk_bf16(f1[q].x, f1[q].y); w.w = pk_bf16(f1[q].z, f1[q].w);
                    *(uint4*)(keys_lds + row * 272 + c8 * 16) = w; }
            }
            __syncthreads();
            cur_h = h;
        }
        const int t0 = (chunk * 8 + wave) * 32;
        const bf16_t* qfrag = q + (((size_t)(t0 >> 5) * 8 + h) * 2) * 8 * 512 + lane * 8;
        unsigned T1[16], T2[16];
#pragma unroll
        for (int half = 0; half < 2; ++half) {
            bf16x8 bq[8];
#pragma unroll
            for (int ks = 0; ks < 8; ++ks) bq[ks] = *(const bf16x8*)(qfrag + (half * 8 + ks) * 512);
            f32x16 acc[4];
#pragma unroll
            for (int mt = 0; mt < 4; ++mt)
#pragma unroll
                for (int r = 0; r < 16; ++r) acc[mt][r] = 0.f;
#pragma unroll
            for (int ks = 0; ks < 8; ++ks)
#pragma unroll
                for (int mt = 0; mt < 4; ++mt) {
                    const bf16x8 a = *(const bf16x8*)(keys_lds + (half * 128 + mt * 32 + tl) * 272 + ks * 32 + 16 * hh);
                    acc[mt] = __builtin_amdgcn_mfma_f32_32x32x16_bf16(a, bq[ks], acc[mt], 0, 0, 0);
                }
            if (half == 0) top16_of_acc(acc, hh, T1); else top16_of_acc(acc, hh, T2);
        }
        {
            uint4 w1, w2;
#define PK4(T, o) ((127u - (T[o] & 127u)) | ((127u - (T[o + 1] & 127u)) << 8) | ((127u - (T[o + 2] & 127u)) << 16) | ((127u - (T[o + 3] & 127u)) << 24))
            w1.x = PK4(T1, 0); w1.y = PK4(T1, 4); w1.z = PK4(T1, 8); w1.w = PK4(T1, 12);
            w2.x = PK4(T2, 0); w2.y = PK4(T2, 4); w2.z = PK4(T2, 8); w2.w = PK4(T2, 12);
#undef PK4
            *(PG8_LAS pg8::u32x4*)slot = (pg8::u32x4){w1.x, w1.y, w1.z, w1.w}; *(PG8_LAS pg8::u32x4*)(slot + 16) = (pg8::u32x4){w2.x, w2.y, w2.z, w2.w};
        }
        float v1[16], v2[16];
#pragma unroll
        for (int i = 0; i < 16; ++i) { v1[i] = key2f(T1[i] & ~127u); v2[i] = key2f(T2[i] & ~127u); }
        unsigned cg0[16], cg1[16];
        { const float s_ = hh ? (v1[0] + v2[1]) : (v1[0] + v2[0]); cg0[0] = (f2key(s_) & ~255u) | (hh ? 254u : 255u); }
        { const float s_ = hh ? (v1[0] + v2[3]) : (v1[0] + v2[2]); cg0[1] = (f2key(s_) & ~255u) | (hh ? 252u : 253u); }
        { const float s_ = hh ? (v1[0] + v2[5]) : (v1[0] + v2[4]); cg0[2] = (f2key(s_) & ~255u) | (hh ? 250u : 251u); }
        { const float s_ = hh ? (v1[0] + v2[7]) : (v1[0] + v2[6]); cg0[3] = (f2key(s_) & ~255u) | (hh ? 248u : 249u); }
        { const float s_ = hh ? (v1[0] + v2[9]) : (v1[0] + v2[8]); cg0[4] = (f2key(s_) & ~255u) | (hh ? 246u : 247u); }
        { const float s_ = hh ? (v1[0] + v2[11]) : (v1[0] + v2[10]); cg0[5] = (f2key(s_) & ~255u) | (hh ? 244u : 245u); }
        { const float s_ = hh ? (v1[0] + v2[13]) : (v1[0] + v2[12]); cg0[6] = (f2key(s_) & ~255u) | (hh ? 242u : 243u); }
        { const float s_ = hh ? (v1[0] + v2[15]) : (v1[0] + v2[14]); cg0[7] = (f2key(s_) & ~255u) | (hh ? 240u : 241u); }
        { const float s_ = hh ? (v1[1] + v2[1]) : (v1[1] + v2[0]); cg0[8] = (f2key(s_) & ~255u) | (hh ? 238u : 239u); }
        { const float s_ = hh ? (v1[1] + v2[3]) : (v1[1] + v2[2]); cg0[9] = (f2key(s_) & ~255u) | (hh ? 236u : 237u); }
        { const float s_ = hh ? (v1[1] + v2[5]) : (v1[1] + v2[4]); cg0[10] = (f2key(s_) & ~255u) | (hh ? 234u : 235u); }
        { const float s_ = hh ? (v1[1] + v2[7]) : (v1[1] + v2[6]); cg0[11] = (f2key(s_) & ~255u) | (hh ? 232u : 233u); }
        { const float s_ = hh ? (v1[2] + v2[1]) : (v1[2] + v2[0]); cg0[12] = (f2key(s_) & ~255u) | (hh ? 222u : 223u); }
        { const float s_ = hh ? (v1[2] + v2[3]) : (v1[2] + v2[2]); cg0[13] = (f2key(s_) & ~255u) | (hh ? 220u : 221u); }
        { const float s_ = hh ? (v1[3] + v2[0]) : (v1[2] + v2[4]); cg0[14] = (f2key(s_) & ~255u) | (hh ? 207u : 219u); }
        { const float s_ = hh ? (v1[3] + v2[2]) : (v1[3] + v2[1]); cg0[15] = (f2key(s_) & ~255u) | (hh ? 205u : 206u); }
        { const float s_ = hh ? (v1[4] + v2[0]) : (v1[3] + v2[3]); cg1[0] = (f2key(s_) & ~255u) | (hh ? 191u : 204u); }
        { const float s_ = hh ? (v1[4] + v2[2]) : (v1[4] + v2[1]); cg1[1] = (f2key(s_) & ~255u) | (hh ? 189u : 190u); }
        { const float s_ = hh ? (v1[5] + v2[1]) : (v1[5] + v2[0]); cg1[2] = (f2key(s_) & ~255u) | (hh ? 174u : 175u); }
        { const float s_ = hh ? (v1[6] + v2[1]) : (v1[6] + v2[0]); cg1[3] = (f2key(s_) & ~255u) | (hh ? 158u : 159u); }
        { const float s_ = hh ? (v1[7] + v2[1]) : (v1[7] + v2[0]); cg1[4] = (f2key(s_) & ~255u) | (hh ? 142u : 143u); }
        { const float s_ = hh ? (v1[9] + v2[0]) : (v1[8] + v2[0]); cg1[5] = (f2key(s_) & ~255u) | (hh ? 111u : 127u); }
        { const float s_ = hh ? (v1[11] + v2[0]) : (v1[10] + v2[0]); cg1[6] = (f2key(s_) & ~255u) | (hh ? 79u : 95u); }
        { const float s_ = hh ? (v1[13] + v2[0]) : (v1[12] + v2[0]); cg1[7] = (f2key(s_) & ~255u) | (hh ? 47u : 63u); }
        { const float s_ = hh ? (v1[15] + v2[0]) : (v1[14] + v2[0]); cg1[8] = (f2key(s_) & ~255u) | (hh ? 15u : 31u); }
        cg1[9] = 0u;
        cg1[10] = 0u;
        cg1[11] = 0u;
        cg1[12] = 0u;
        cg1[13] = 0u;
        cg1[14] = 0u;
        cg1[15] = 0u;
        sort16_desc(cg0); sort16_desc(cg1);
        merge16_desc(cg0, cg1);
#pragma unroll
        for (int i = 0; i < 16; ++i) cg1[i] = (unsigned)__shfl_xor((int)cg0[i], 32);
        merge16_desc(cg0, cg1);
        const float top0 = key2f(cg0[0] & ~255u);
        float ev[16]; float es = 0.f;
#pragma unroll
        for (int j = 0; j < 16; ++j) { ev[j] = expf(key2f(cg0[j] & ~255u) - top0); es += ev[j]; }
        const float rs = 1.f / es;
        __builtin_amdgcn_wave_barrier();
        int eo[8]; float go[8];
#pragma unroll
        for (int jj = 0; jj < 8; ++jj) {
            const unsigned wlo_ = cg0[jj], whi_ = cg0[jj + 8]; const unsigned w = hh ? whi_ : wlo_;
            const unsigned cid = 255u - (w & 255u);
            const int i1 = slot[cid >> 4], i2 = slot[16 + (cid & 15u)];
            eo[jj] = i1 * 128 + i2;
            const float elo_ = ev[jj], ehi_ = ev[jj + 8]; go[jj] = (hh ? ehi_ : elo_) * rs;
        }
        int* ep = eidx + (size_t)(t0 + tl) * 128 + h * 16 + 8 * hh;
        *(uint4*)((unsigned short*)(p.ws + WS_EIDX16) + (size_t)(t0 + tl) * 128 + h * 16 + 8 * hh) = make_uint4((unsigned)eo[0] | ((unsigned)eo[1] << 16), (unsigned)eo[2] | ((unsigned)eo[3] << 16), (unsigned)eo[4] | ((unsigned)eo[5] << 16), (unsigned)eo[6] | ((unsigned)eo[7] << 16));
        float* gp = egate + (size_t)(t0 + tl) * 128 + h * 16 + 8 * hh;
        *(float4*)gp = make_float4(go[0], go[1], go[2], go[3]); *(float4*)(gp + 4) = make_float4(go[4], go[5], go[6], go[7]);
        __builtin_amdgcn_wave_barrier();
    }
}

__device__ __forceinline__ void phase_tabprep(const P& p, int l, unsigned char* sm) {
    const int tid_ = opaque_tid(); const int lane = tid_ & 63, wave = tid_ >> 6;
    float* sc = (float*)(p.ws + WS_TSC);
    unsigned* counter = (unsigned*)(p.ws + WS_CNT) + 16 * (2 + l);
    volatile int* ctl = (volatile int*)sm;
    for (;;) {
        __syncthreads();
        if (tid_ == 0) ctl[0] = (int)atomicAdd(counter, 1u);
        __syncthreads();
        const int chunk = ctl[0];
        if (chunk >= 512) break;
      for (int jj = 0; jj < 8; ++jj) {
        const int job = chunk * 64 + jj * 8 + wave;
        const int tbl = job >> 14, e = job & 16383;
        const float* src = (tbl ? p.peer_down : p.peer_up) + ((size_t)l * 16384 + e) * 1024 + lane * 16;
        const float4 v0 = *(const float4*)src, v1 = *(const float4*)(src + 4), v2 = *(const float4*)(src + 8), v3 = *(const float4*)(src + 12);
        const float f[16] = {v0.x, v0.y, v0.z, v0.w, v1.x, v1.y, v1.z, v1.w, v2.x, v2.y, v2.z, v2.w, v3.x, v3.y, v3.z, v3.w};
        float am = 0.f;
#pragma unroll
        for (int i = 0; i < 16; ++i) am = fmaxf(am, fabsf(f[i]));
        am = wave_max(am);
        {
            float ss = 0.f;
#pragma unroll
            for (int i = 0; i < 16; ++i) ss += f[i] * f[i];
            ss = wave_sum(ss);
            am = fminf(am, 2.6f * sqrtf(ss * (1.f / 1024.f)));
            const float inv = am > 0.f ? 7.f / am : 0.f;
            unsigned w[2];
#pragma unroll
            for (int d = 0; d < 2; ++d) {
                unsigned x = 0;
#pragma unroll
                for (int i = 0; i < 8; ++i) { const int q = min(max((int)rintf(f[d * 8 + i] * inv), -7), 7) + 8; x |= (unsigned)q << (4 * i); }
                w[d] = x;
            }
            if (tbl)
                *(uint2*)(sm + 1024 + lane * 520 + (jj * 8 + wave) * 8) = make_uint2(w[0], w[1]);
            else
                *(uint2*)(p.ws + WS_TUP + (size_t)(lane >> 4) * (16384 * 128) + (size_t)e * 128 + (lane & 15) * 8) = make_uint2(w[0], w[1]);
            if (lane == 0) sc[job] = am > 0.f ? am / 7.f : 0.f;
        }
      }
      if (chunk >= 256) {
          __syncthreads();
          const int e0 = (chunk - 256) * 64;
#pragma unroll
          for (int j = 0; j < 4; ++j) {
              const int o = (j * NT + tid_) * 16, strip = o >> 9, within = o & 511;
              const uint2 lo = *(const uint2*)(sm + 1024 + strip * 520 + within), hi = *(const uint2*)(sm + 1024 + strip * 520 + within + 8);
              *(uint4*)(p.ws + WS_TDN + (size_t)strip * (16384 * 8) + (size_t)e0 * 8 + within) = make_uint4(lo.x, lo.y, hi.x, hi.y);
          }
      }
    }
    __syncthreads();
}

constexpr size_t WS_PD = WS_Q;
constexpr size_t WS_Z  = WS_Q + (size_t)M * 1024 * 2;
__device__ __forceinline__ float readlane_f(float v, int l) { return __int_as_float(__builtin_amdgcn_readlane(__float_as_int(v), l)); }
__device__ __forceinline__ float dot16u8(const uint4& w, const float* u, float acc) {
    const unsigned ww[4] = {w.x, w.y, w.z, w.w};
#pragma unroll
    for (int d = 0; d < 4; ++d)
#pragma unroll
        for (int i = 0; i < 4; ++i) acc += u[d * 4 + i] * (float)((ww[d] >> (8 * i)) & 0xffu);
    return acc;
}
__device__ __forceinline__ void fma16u8(float* y, const uint4& w, float a) {
    const unsigned ww[4] = {w.x, w.y, w.z, w.w};
#pragma unroll
    for (int d = 0; d < 4; ++d)
#pragma unroll
        for (int i = 0; i < 4; ++i) y[d * 4 + i] += a * (float)((ww[d] >> (8 * i)) & 0xffu);
}
__device__ __forceinline__ int idot16(const uint4& w, const uint4& u) {
    int a = __builtin_amdgcn_sdot4((int)w.x, (int)u.x, 0, false); a = __builtin_amdgcn_sdot4((int)w.y, (int)u.y, a, false);
    a = __builtin_amdgcn_sdot4((int)w.z, (int)u.z, a, false); return __builtin_amdgcn_sdot4((int)w.w, (int)u.w, a, false);
}
__device__ __forceinline__ void tdot4x4(int* y, const uint4& w0, const uint4& w1, const uint4& w2, const uint4& w3, unsigned cq) {
    const unsigned a0[4] = {w0.x, w0.y, w0.z, w0.w}, a1[4] = {w1.x, w1.y, w1.z, w1.w}, a2[4] = {w2.x, w2.y, w2.z, w2.w}, a3[4] = {w3.x, w3.y, w3.z, w3.w};
#pragma unroll
    for (int r = 0; r < 4; ++r) {
        const unsigned lo01 = __builtin_amdgcn_perm(a1[r], a0[r], 0x05010400u), hi01 = __builtin_amdgcn_perm(a1[r], a0[r], 0x07030602u);
        const unsigned lo23 = __builtin_amdgcn_perm(a3[r], a2[r], 0x05010400u), hi23 = __builtin_amdgcn_perm(a3[r], a2[r], 0x07030602u);
        const unsigned c0 = __builtin_amdgcn_perm(lo23, lo01, 0x05040100u), c1 = __builtin_amdgcn_perm(lo23, lo01, 0x07060302u);
        const unsigned c2 = __builtin_amdgcn_perm(hi23, hi01, 0x05040100u), c3 = __builtin_amdgcn_perm(hi23, hi01, 0x07060302u);
        y[4 * r + 0] = __builtin_amdgcn_sdot4((int)c0, (int)cq, y[4 * r + 0], false);
        y[4 * r + 1] = __builtin_amdgcn_sdot4((int)c1, (int)cq, y[4 * r + 1], false);
        y[4 * r + 2] = __builtin_amdgcn_sdot4((int)c2, (int)cq, y[4 * r + 2], false);
        y[4 * r + 3] = __builtin_amdgcn_sdot4((int)c3, (int)cq, y[4 * r + 3], false);
    }
}
__device__ __forceinline__ unsigned my_xcc() { return (unsigned)__builtin_amdgcn_s_getreg((3 << 11) | 20) & 7u; }

template <int PH>
__device__ __forceinline__ void phase_eslice(const P& p, int l, unsigned char* sm) {
    const bf16_t* u2 = (const bf16_t*)(p.ws + WS_U2);
    const int* eidx = (const int*)(p.ws + WS_EIDX); const float* coefp = (const float*)(p.ws + WS_EGATE);
    const unsigned char* tab = p.ws + (PH == 0 ? WS_TUP : WS_TDN);
    bf16_t* pdb = (bf16_t*)(p.ws + WS_PD);
    unsigned* cnts = (unsigned*)(p.ws + WS_CNT + 256) + (size_t)((l * 2 + PH) * 8) * 16;
    const int tid = opaque_tid(); const int lane = tid & 63, wave = tid >> 6;
    volatile int* ctl = (volatile int*)sm;
    const int rows = (l == 0) ? M : ML;
    const int nchunks = rows / 128;
    const unsigned xcc = my_xcc();
    for (int att = 0; att < 4; ++att) {
        const int slice = (int)((xcc + (unsigned)att) & 3u);
        int nxt_chunk = 0;
        if (tid == 0) nxt_chunk = (int)atomicAdd(cnts + slice * 16, 1u);
        for (;;) {
            __syncthreads();
            if (tid == 0) ctl[0] = nxt_chunk;
            __syncthreads();
            const int chunk = ctl[0];
            if (chunk >= nchunks) break;
            if (tid == 0) nxt_chunk = (int)atomicAdd(cnts + slice * 16, 1u);
            int lane_o = lane; asm volatile("" : "+v"(lane_o));
            const int sub = lane_o & 7, g = lane_o >> 3;
            const int t0 = chunk * 128 + wave * 16;
            const unsigned char* tsl = tab + (size_t)slice * (16384 * 128) + sub * 16;
#define LD_EV(dst, tok) do { const uint4* ep_ = (const uint4*)((const unsigned short*)(p.ws + WS_EIDX16) + (size_t)(tok) * 128 + 16 * g); dst[0] = ep_[0]; dst[1] = ep_[1]; } while (0)
#define GATHER(dst, ev) do { const unsigned w_[8] = {ev[0].x, ev[0].y, ev[0].z, ev[0].w, ev[1].x, ev[1].y, ev[1].z, ev[1].w}; _Pragma("unroll") for (int q_ = 0; q_ < 8; ++q_) { \
            dst[2 * q_] = *(const uint4*)(tsl + (size_t)(w_[q_] & 0xffffu) * 128); dst[2 * q_ + 1] = *(const uint4*)(tsl + (size_t)(w_[q_] >> 16) * 128); } } while (0)
#define LD_SMALL(dst, tok) do { if (PH == 0) { const uint4* up_ = (const uint4*)(p.ws + WS_U2Q + (size_t)(tok) * 1024 + slice * 256 + sub * 32); dst[0] = up_[0]; dst[1] = up_[1]; } \
            else { const unsigned char* rb_ = (const unsigned char*)(coefp + (size_t)(tok) * 128); dst[0] = *(const uint4*)(rb_ + 16 * g); dst[1].x = *(const unsigned*)(rb_ + 128); \
                   const unsigned xq_ = *(const unsigned*)((const bf16_t*)xrow_w(p, (tok)) + ocol); const float2 gq_ = *(const float2*)(modp(p, l, (tok)) + 5120 + ocol); \
                   dst[2].x = xq_ << 16; dst[2].y = xq_ & 0xffff0000u; dst[2].z = __float_as_uint(gq_.x); dst[2].w = __float_as_uint(gq_.y); } } while (0)
            const int ocol = slice * 128 + sub * 16 + ((lane_o & 32) ? 8 : 0) + ((lane_o & 16) ? 4 : 0) + ((lane_o & 8) ? 2 : 0);
            auto compute = [&](const uint4 (&W)[16], const uint4 (&smx)[3], const int t) {
                if (PH == 0) {
                    float acc[16];
                    const unsigned uw[8] = {smx[0].x, smx[0].y, smx[0].z, smx[0].w, smx[1].x, smx[1].y, smx[1].z, smx[1].w};
                    unsigned ue[4], uo[4]; int su = 0;
#pragma unroll
                    for (int d = 0; d < 4; ++d) { ue[d] = __builtin_amdgcn_perm(uw[2 * d + 1], uw[2 * d], 0x06040200u); uo[d] = __builtin_amdgcn_perm(uw[2 * d + 1], uw[2 * d], 0x07050301u);
                        su = __builtin_amdgcn_sdot4((int)uw[2 * d], 0x01010101, su, false); su = __builtin_amdgcn_sdot4((int)uw[2 * d + 1], 0x01010101, su, false); }
                    const int a0 = -8 * su;
#pragma unroll
                    for (int b = 0; b < 16; ++b) {
                        const unsigned ww[4] = {W[b].x, W[b].y, W[b].z, W[b].w};
                        int a = a0;
#pragma unroll
                        for (int d = 0; d < 4; ++d) { a = __builtin_amdgcn_sdot4((int)(ww[d] & 0x0f0f0f0fu), (int)ue[d], a, false); a = __builtin_amdgcn_sdot4((int)((ww[d] >> 4) & 0x0f0f0f0fu), (int)uo[d], a, false); }
                        acc[b] = (float)a;
                    }
                    const bool s4 = sub & 4, s2 = sub & 2, s1 = sub & 1;
                    float d8[8];
#pragma unroll
                    for (int i = 0; i < 8; ++i) { const float lo_ = acc[i], hi_ = acc[i + 8]; const float keep = s4 ? hi_ : lo_, send = s4 ? lo_ : hi_; d8[i] = keep + __shfl_xor(send, 4); }
                    float d4[4];
#pragma unroll
                    for (int i = 0; i < 4; ++i) { const float lo_ = d8[i], hi_ = d8[i + 4]; const float keep = s2 ? hi_ : lo_, send = s2 ? lo_ : hi_; d4[i] = keep + __shfl_xor(send, 2); }
                    float d2[2];
#pragma unroll
                    for (int i = 0; i < 2; ++i) { const float lo_ = d4[i], hi_ = d4[i + 2]; const float keep = s1 ? hi_ : lo_, send = s1 ? lo_ : hi_; d2[i] = keep + __shfl_xor(send, 1); }
                    const int b0 = (s4 ? 8 : 0) + (s2 ? 4 : 0) + (s1 ? 2 : 0);
                    *(unsigned*)(pdb + ((size_t)slice * rows + t) * 128 + 16 * g + b0) = pk_bf16(d2[0], d2[1]);
                } else {
                    int yi[16];
#pragma unroll
                    for (int i = 0; i < 16; ++i) yi[i] = 0;
                    const unsigned cq[4] = {smx[0].x, smx[0].y, smx[0].z, smx[0].w};
                    const float csc = __uint_as_float(smx[1].x);
                    tdot4x4(yi, W[0], W[1], W[2], W[3], cq[0]); tdot4x4(yi, W[4], W[5], W[6], W[7], cq[1]);
                    tdot4x4(yi, W[8], W[9], W[10], W[11], cq[2]); tdot4x4(yi, W[12], W[13], W[14], W[15], cq[3]);
                    const bool h32 = lane_o & 32, h16 = lane_o & 16, h8 = lane_o & 8;
                    int y8[8];
#pragma unroll
                    for (int i = 0; i < 8; ++i) { const int lo_ = yi[i], hi_ = yi[i + 8]; const int keep = h32 ? hi_ : lo_, send = h32 ? lo_ : hi_; y8[i] = keep + __shfl_xor(send, 32); }
                    int y4[4];
#pragma unroll
                    for (int i = 0; i < 4; ++i) { const int lo_ = y8[i], hi_ = y8[i + 4]; const int keep = h16 ? hi_ : lo_, send = h16 ? lo_ : hi_; y4[i] = keep + __shfl_xor(send, 16); }
                    int y2[2];
#pragma unroll
                    for (int i = 0; i < 2; ++i) { const int lo_ = y4[i], hi_ = y4[i + 2]; const int keep = h8 ? hi_ : lo_, send = h8 ? lo_ : hi_; y2[i] = keep + __shfl_xor(send, 8); }
                    const float zx = ALPHA * __uint_as_float(smx[2].x) + __uint_as_float(smx[2].z) * ((float)y2[0] * csc), zy = ALPHA * __uint_as_float(smx[2].y) + __uint_as_float(smx[2].w) * ((float)y2[1] * csc);
                    *(unsigned*)((bf16_t*)(p.ws + WS_Z) + (size_t)t * 1024 + ocol) = pk_bf16(zx, zy);
                }
            };
            uint4 ev0[2], ev1[2];
            uint4 WA[16], WB[16];
            uint4 sm0[3], sm1[3];
            sm0[1] = make_uint4(0, 0, 0, 0); sm1[1] = make_uint4(0, 0, 0, 0); sm0[2] = make_uint4(0, 0, 0, 0); sm1[2] = make_uint4(0, 0, 0, 0);
            LD_EV(ev0, t0); LD_EV(ev1, t0 + 1);
            LD_SMALL(sm0, t0); LD_SMALL(sm1, t0 + 1);
            GATHER(WA, ev0);
            LD_EV(ev0, t0 + 2);
#pragma unroll 1
            for (int tk = 0; tk < 16; tk += 2) {
                const int t = t0 + tk;
                GATHER(WB, ev1);
                if (tk + 3 < 16) LD_EV(ev1, t + 3);
                compute(WA, sm0, t);
                if (tk + 2 < 16) { LD_SMALL(sm0, t + 2); GATHER(WA, ev0); }
                if (tk + 4 < 16) LD_EV(ev0, t + 4);
                compute(WB, sm1, t + 1);
                if (tk + 3 < 16) LD_SMALL(sm1, t + 3);
            }
#undef LD_EV
#undef GATHER
#undef LD_SMALL
        }
    }
    __syncthreads();
}

constexpr size_t WS_IDXT  = WS_Y;
constexpr size_t WS_COEFT = WS_Y + (size_t)M * 128 * 2;
constexpr size_t WS_CSC   = WS_GATES + (size_t)M * 4;
typedef unsigned e2v2_t __attribute__((ext_vector_type(2)));
struct E2Q { e2v2_t t0, t1, t2, t3; };
__device__ __forceinline__ void e2_gather(E2Q& q, unsigned w0, unsigned w1) {
    q.t0 = *(const PG8_LAS e2v2_t*)(w0 & 0x1ffffu); q.t1 = *(const PG8_LAS e2v2_t*)((w0 >> 17) << 3);
    q.t2 = *(const PG8_LAS e2v2_t*)(w1 & 0x1ffffu); q.t3 = *(const PG8_LAS e2v2_t*)((w1 >> 17) << 3);
}
__device__ __forceinline__ void e2_mac16(int (&y)[16], int& sumc, const E2Q& q, unsigned cq) {
    sumc = __builtin_amdgcn_sdot4(0x01010101, (int)cq, sumc, false);
#pragma unroll
    for (int r = 0; r < 2; ++r) {
        const unsigned a0 = r ? q.t0.y : q.t0.x, a1 = r ? q.t1.y : q.t1.x, a2 = r ? q.t2.y : q.t2.x, a3 = r ? q.t3.y : q.t3.x;
        const unsigned lo01 = __builtin_amdgcn_perm(a1, a0, 0x05010400u), hi01 = __builtin_amdgcn_perm(a1, a0, 0x07030602u);
        const unsigned lo23 = __builtin_amdgcn_perm(a3, a2, 0x05010400u), hi23 = __builtin_amdgcn_perm(a3, a2, 0x07030602u);
        const unsigned c[4] = {__builtin_amdgcn_perm(lo23, lo01, 0x05040100u), __builtin_amdgcn_perm(lo23, lo01, 0x07060302u),
                               __builtin_amdgcn_perm(hi23, hi01, 0x05040100u), __builtin_amdgcn_perm(hi23, hi01, 0x07060302u)};
#pragma unroll
        for (int j = 0; j < 4; ++j) {
            y[8 * r + 2 * j]     = __builtin_amdgcn_sdot4((int)(c[j] & 0x0f0f0f0fu), (int)cq, y[8 * r + 2 * j], false);
            y[8 * r + 2 * j + 1] = __builtin_amdgcn_sdot4((int)((c[j] >> 4) & 0x0f0f0f0fu), (int)cq, y[8 * r + 2 * j + 1], false);
        }
    }
}
__device__ __forceinline__ void e2_mac(int (&y)[8], const E2Q& q, unsigned cq) {
#pragma unroll
    for (int r = 0; r < 2; ++r) {
        const unsigned a0 = r ? q.t0.y : q.t0.x, a1 = r ? q.t1.y : q.t1.x, a2 = r ? q.t2.y : q.t2.x, a3 = r ? q.t3.y : q.t3.x;
        const unsigned lo01 = __builtin_amdgcn_perm(a1, a0, 0x05010400u), hi01 = __builtin_amdgcn_perm(a1, a0, 0x07030602u);
        const unsigned lo23 = __builtin_amdgcn_perm(a3, a2, 0x05010400u), hi23 = __builtin_amdgcn_perm(a3, a2, 0x07030602u);
        const unsigned c0 = __builtin_amdgcn_perm(lo23, lo01, 0x05040100u), c1 = __builtin_amdgcn_perm(lo23, lo01, 0x07060302u);
        const unsigned c2 = __builtin_amdgcn_perm(hi23, hi01, 0x05040100u), c3 = __builtin_amdgcn_perm(hi23, hi01, 0x07060302u);
        y[4 * r + 0] = __builtin_amdgcn_sdot4((int)c0, (int)cq, y[4 * r + 0], false);
        y[4 * r + 1] = __builtin_amdgcn_sdot4((int)c1, (int)cq, y[4 * r + 1], false);
        y[4 * r + 2] = __builtin_amdgcn_sdot4((int)c2, (int)cq, y[4 * r + 2], false);
        y[4 * r + 3] = __builtin_amdgcn_sdot4((int)c3, (int)cq, y[4 * r + 3], false);
    }
}
__device__ __forceinline__ void phase_e2lds(const P& p, int l, unsigned char* sm) {
    const int tid = opaque_tid(); const int lane = tid & 63, wave = __builtin_amdgcn_readfirstlane(tid >> 6);
    const int rows = (l == 0) ? M : ML;
    const int ngroups = rows >> 6;
    const int npart = max(1, (int)gridDim.x >> 6);
    PG8_LAS unsigned char* tb = (PG8_LAS unsigned char*)sm;
    const unsigned* idxt = (const unsigned*)(p.ws + WS_IDXT); const unsigned* coeft = (const unsigned*)(p.ws + WS_COEFT);
    const float* cscp = (const float*)(p.ws + WS_CSC);
    for (int u = blockIdx.x; u < 64 * npart; u += gridDim.x) {
        const int x = u & 7, ii = u >> 3;
        const int g = x * 8 + (ii & 7), part = ii >> 3;
        const int col = 16 * g;
        __syncthreads();
        {
            const unsigned char* strip = p.ws + WS_TDN + (size_t)g * (16384 * 8) + tid * 16;
#pragma unroll
            for (int it = 0; it < 16; it += 8) {
                uint4 v[8];
#pragma unroll
                for (int k = 0; k < 8; ++k) v[k] = *(const uint4*)(strip + (it + k) * 8192);
#pragma unroll
                for (int k = 0; k < 8; ++k) *(PG8_LAS pg8::u32x4*)(tb + tid * 16 + (it + k) * 8192) = (pg8::u32x4){v[k].x, v[k].y, v[k].z, v[k].w};
            }
        }
        __syncthreads();
        unsigned I0[8], C0[4], I1[8], C1[4], I2[8], C2[4], I3[8], C3[4];
        E2Q Q0, Q1, Q2, Q3;
#define E2_LD(k, ipp, cpp, bt) do { const unsigned char* bi_ = (const unsigned char*)((ipp) + (bt) * 512); const unsigned char* bc_ = (const unsigned char*)((cpp) + (bt) * 256); \
            _Pragma("unroll") for (int q_ = 0; q_ < 4; ++q_) { I##k[2 * q_] = *(const unsigned*)(bi_ + voff + (2 * q_) * 256); I##k[2 * q_ + 1] = *(const unsigned*)(bi_ + voff + (2 * q_ + 1) * 256); \
                                                                  C##k[q_] = *(const unsigned*)(bc_ + voff + q_ * 256); } } while (0)
#define E2_G(s, k, q) e2_gather(Q##s, I##k[2 * (q)], I##k[2 * (q) + 1])
#define E2_M(s, k, q) e2_mac16(acc, sumc, Q##s, C##k[q])
        const int tstride = npart * NW;
        unsigned voff = (unsigned)lane * 4u; asm volatile("" : "+v"(voff));
        int tg = part + npart * wave;
        { const int t0_ = min(tg, ngroups - 1); const unsigned* ip = idxt + (size_t)t0_ * 4096; const unsigned* cp = coeft + (size_t)t0_ * 2048;
          E2_LD(0, ip, cp, 0); E2_LD(1, ip, cp, 1); E2_G(0, 0, 0); E2_G(1, 0, 1); E2_G(2, 0, 2); }
#pragma unroll 1
        for (; tg < ngroups; tg += tstride) {
            const unsigned* ip = idxt + (size_t)tg * 4096; const unsigned* cp = coeft + (size_t)tg * 2048;
            const int tn = (tg + tstride < ngroups) ? tg + tstride : tg;
            const unsigned* ipn = idxt + (size_t)tn * 4096; const unsigned* cpn = coeft + (size_t)tn * 2048;
            const int tok = tg * 64 + lane;
            int acc[16]; int sumc = 0;
#pragma unroll
            for (int i = 0; i < 16; ++i) acc[i] = 0;
            E2_LD(2, ip, cp, 2);
            E2_G(3, 0, 3); E2_M(0, 0, 0);
            E2_G(0, 1, 0); E2_M(1, 0, 1);
            E2_G(1, 1, 1); E2_M(2, 0, 2);
            E2_G(2, 1, 2); E2_M(3, 0, 3);
            E2_LD(3, ip, cp, 3);
            E2_G(3, 1, 3); E2_M(0, 1, 0);
            E2_G(0, 2, 0); E2_M(1, 1, 1);
            E2_G(1, 2, 1); E2_M(2, 1, 2);
            E2_G(2, 2, 2); E2_M(3, 1, 3);
            E2_LD(0, ip, cp, 4);
            E2_G(3, 2, 3); E2_M(0, 2, 0);
            E2_G(0, 3, 0); E2_M(1, 2, 1);
            E2_G(1, 3, 1); E2_M(2, 2, 2);
            E2_G(2, 3, 2); E2_M(3, 2, 3);
            E2_LD(1, ip, cp, 5);
            E2_G(3, 3, 3); E2_M(0, 3, 0);
            E2_G(0, 0, 0); E2_M(1, 3, 1);
            E2_G(1, 0, 1); E2_M(2, 3, 2);
            E2_G(2, 0, 2); E2_M(3, 3, 3);
            E2_LD(2, ip, cp, 6);
            E2_G(3, 0, 3); E2_M(0, 0, 0);
            E2_G(0, 1, 0); E2_M(1, 0, 1);
            E2_G(1, 1, 1); E2_M(2, 0, 2);
            E2_G(2, 1, 2); E2_M(3, 0, 3);
            E2_LD(3, ip, cp, 7);
            E2_G(3, 1, 3); E2_M(0, 1, 0);
            E2_G(0, 2, 0); E2_M(1, 1, 1);
            E2_G(1, 2, 1); E2_M(2, 1, 2);
            E2_G(2, 2, 2); E2_M(3, 1, 3);
            const float* gp = modp(p, l, tg * 64) + 5120 + col;
            const float4 g0 = *(const float4*)gp, g1 = *(const float4*)(gp + 4), g2 = *(const float4*)(gp + 8), g3 = *(const float4*)(gp + 12);
            const float csc = cscp[tok];
            E2_LD(0, ipn, cpn, 0);
            E2_G(3, 2, 3); E2_M(0, 2, 0);
            E2_G(0, 3, 0); E2_M(1, 2, 1);
            E2_G(1, 3, 1); E2_M(2, 2, 2);
            E2_G(2, 3, 2); E2_M(3, 2, 3);
            E2_LD(1, ipn, cpn, 1);
            E2_G(3, 3, 3); E2_M(0, 3, 0);
            E2_G(0, 0, 0); E2_M(1, 3, 1);
            E2_G(1, 0, 1); E2_M(2, 3, 2);
            E2_G(2, 0, 2); E2_M(3, 3, 3);
            const float gg[16] = {g0.x, g0.y, g0.z, g0.w, g1.x, g1.y, g1.z, g1.w, g2.x, g2.y, g2.z, g2.w, g3.x, g3.y, g3.z, g3.w};
            unsigned zo[8];
#pragma unroll
            for (int i = 0; i < 8; ++i) {
                const float za = gg[2 * i] * ((float)(acc[2 * i] - 8 * sumc) * csc);
                const float zb = gg[2 * i + 1] * ((float)(acc[2 * i + 1] - 8 * sumc) * csc);
                zo[i] = pk_bf16(za, zb);
            }
            *(uint4*)((bf16_t*)(p.ws + WS_Z) + (size_t)tok * 1024 + col) = make_uint4(zo[0], zo[1], zo[2], zo[3]);
            *(uint4*)((bf16_t*)(p.ws + WS_Z) + (size_t)tok * 1024 + col + 8) = make_uint4(zo[4], zo[5], zo[6], zo[7]);
        }
#undef E2_LD
#undef E2_G
#undef E2_M
    }
    __syncthreads();
}

__device__ __forceinline__ void phase_ecoef(const P& p, int l, unsigned char* sm) {
    const int* eidx = (const int*)(p.ws + WS_EIDX); float* egate = (float*)(p.ws + WS_EGATE);
    const bf16_t* pdb = (const bf16_t*)(p.ws + WS_PD);
    const int tid_ = opaque_tid(); const int lane = tid_ & 63, wave = tid_ >> 6, hl = lane & 31;
    const int rows = (l == 0) ? M : ML;
    {
        const float4* gsc = (const float4*)(p.ws + WS_TSC);
        PG8_LAS pg8::u32x4* lsc4 = (PG8_LAS pg8::u32x4*)sm;
        __syncthreads();
#pragma unroll
        for (int it = 0; it < 16; it += 8) {
            float4 v[8];
#pragma unroll
            for (int k = 0; k < 8; ++k) v[k] = gsc[(it + k) * NT + tid_];
#pragma unroll
            for (int k = 0; k < 8; ++k) lsc4[(it + k) * NT + tid_] = (pg8::u32x4){__float_as_uint(v[k].x), __float_as_uint(v[k].y), __float_as_uint(v[k].z), __float_as_uint(v[k].w)};
        }
        __syncthreads();
    }
    const PG8_LAS float* scu = (const PG8_LAS float*)sm; const PG8_LAS float* scd = scu + 16384;
    for (int rp = blockIdx.x * NW + wave; rp < rows / 2; rp += gridDim.x * NW) {
        const int r = 2 * rp + (lane >> 5);
        const float usc = ((const float*)(p.ws + WS_USC))[r];
        float4 d = {0.f, 0.f, 0.f, 0.f};
#pragma unroll
        for (int x = 0; x < 4; ++x) { const uint2 v = *(const uint2*)(pdb + ((size_t)x * rows + r) * 128 + 4 * hl);
            d.x += __uint_as_float(v.x << 16); d.y += __uint_as_float(v.x & 0xffff0000u); d.z += __uint_as_float(v.y << 16); d.w += __uint_as_float(v.y & 0xffff0000u); }
        const uint2 ew_ = *(const uint2*)((const unsigned short*)(p.ws + WS_EIDX16) + (size_t)r * 128 + 4 * hl);
        const int4 e = make_int4((int)(ew_.x & 0xffffu), (int)(ew_.x >> 16), (int)(ew_.y & 0xffffu), (int)(ew_.y >> 16));
        const float4 g = *(const float4*)(egate + (size_t)r * 128 + 4 * hl);
        float cf[4];
        cf[0] = g.x * scd[e.x] * gelu_tanh(scu[e.x] * usc * d.x); cf[1] = g.y * scd[e.y] * gelu_tanh(scu[e.y] * usc * d.y);
        cf[2] = g.z * scd[e.z] * gelu_tanh(scu[e.z] * usc * d.z); cf[3] = g.w * scd[e.w] * gelu_tanh(scu[e.w] * usc * d.w);
        float am = fmaxf(fmaxf(fabsf(cf[0]), fabsf(cf[1])), fmaxf(fabsf(cf[2]), fabsf(cf[3])));
        am = fmaxf(am, __shfl_xor(am, 16)); am = fmaxf(am, __shfl_xor(am, 8)); am = fmaxf(am, __shfl_xor(am, 4)); am = fmaxf(am, __shfl_xor(am, 2)); am = fmaxf(am, __shfl_xor(am, 1));
        const float inv = am > 0.f ? 127.f / am : 0.f;
        unsigned w = 0;
#pragma unroll
        for (int i = 0; i < 4; ++i) w |= (unsigned)(min(max((int)rintf(cf[i] * inv), -127), 127) & 0xff) << (8 * i);
        const int tgi = r >> 6, tl = r & 63;
        unsigned* it_ = (unsigned*)(p.ws + WS_IDXT) + ((size_t)tgi * 64 + 2 * hl) * 64 + tl;
        it_[0] = ((unsigned)e.x << 3) | ((unsigned)e.y << 17); it_[64] = ((unsigned)e.z << 3) | ((unsigned)e.w << 17);
        ((unsigned*)(p.ws + WS_COEFT))[((size_t)tgi * 32 + hl) * 64 + tl] = w;
        if (hl == 0) ((float*)(p.ws + WS_CSC))[r] = am > 0.f ? am / 127.f : 0.f;
    }
    __syncthreads();
}

__device__ __forceinline__ void phase_eln(const P& p, int l, float* sm) {
    const float* lw = p.ln2_w + l * D; const float* lb = p.ln2_b + l * D;
    const int tid_ = opaque_tid(); const int lane = tid_ & 63, wave = tid_ >> 6;
    const int rows = (l == 0) ? M : ML;
    const bool nxt = (l == 0);
    bf16_t* u1 = (bf16_t*)(p.ws + WS_U1);
    const int k0 = lane * 16;
    const int nwv = gridDim.x * NW, ppw = (rows / 2 + nwv - 1) / nwv;
    const int rp_lo = (blockIdx.x * NW + wave) * ppw, rp_hi = min(rp_lo + ppw, rows / 2);
    float4 w4r[4], b4r[4], scr[4], shr[4];
#pragma unroll
    for (int v4 = 0; v4 < 4; ++v4) { w4r[v4] = *(const float4*)(lw + k0 + v4 * 4); b4r[v4] = *(const float4*)(lb + k0 + v4 * 4); scr[v4] = make_float4(0.f, 0.f, 0.f, 0.f); shr[v4] = make_float4(0.f, 0.f, 0.f, 0.f); }
    int cur_mr = -1;
    for (int rp = rp_lo; rp < rp_hi; ++rp) {
        if (nxt) { const int mr = mod_row(2 * rp);
            if (mr != cur_mr) { cur_mr = mr; const float* mp = modp(p, l + 1, 2 * rp);
#pragma unroll
                for (int v4 = 0; v4 < 4; ++v4) { scr[v4] = *(const float4*)(mp + 1024 + k0 + v4 * 4); shr[v4] = *(const float4*)(mp + k0 + v4 * 4); } } }
        float z[2][16]; float s[2] = {0.f, 0.f};
#pragma unroll
        for (int h = 0; h < 2; ++h) {
            const int r = 2 * rp + h;
            const uint4 za = *(const uint4*)((const bf16_t*)(p.ws + WS_Z) + (size_t)r * 1024 + k0), zb = *(const uint4*)((const bf16_t*)(p.ws + WS_Z) + (size_t)r * 1024 + k0 + 8);
            const uint4 xa = *(const uint4*)((const bf16_t*)xrow_w(p, r) + k0), xb = *(const uint4*)((const bf16_t*)xrow_w(p, r) + k0 + 8);
            const unsigned zw[8] = {za.x, za.y, za.z, za.w, zb.x, zb.y, zb.z, zb.w};
            const unsigned xw[8] = {xa.x, xa.y, xa.z, xa.w, xb.x, xb.y, xb.z, xb.w};
#pragma unroll
            for (int i = 0; i < 8; ++i) { z[h][2 * i] = ALPHA * __uint_as_float(xw[i] << 16) + __uint_as_float(zw[i] << 16); z[h][2 * i + 1] = ALPHA * __uint_as_float(xw[i] & 0xffff0000u) + __uint_as_float(zw[i] & 0xffff0000u); s[h] += z[h][2 * i] + z[h][2 * i + 1]; }
        }
        float mu[2], rstd[2];
#pragma unroll
        for (int h = 0; h < 2; ++h) mu[h] = wave_sum(s[h]) * (1.f / 1024.f);
#pragma unroll
        for (int h = 0; h < 2; ++h) {
            float q = 0.f;
#pragma unroll
            for (int i = 0; i < 16; ++i) { const float d = z[h][i] - mu[h]; q += d * d; }
            rstd[h] = rsqrtf(wave_sum(q) * (1.f / 1024.f) + LN_EPS);
        }
#pragma unroll
        for (int h = 0; h < 2; ++h) {
            const int r = 2 * rp + h;
            float* xo = xrow_w(p, r);
#pragma unroll
            for (int v4 = 0; v4 < 4; ++v4) {
                const int k = k0 + v4 * 4;
                const float4 w4 = w4r[v4], b4 = b4r[v4];
                float4 o;
                o.x = (z[h][v4 * 4] - mu[h]) * rstd[h] * w4.x + b4.x; o.y = (z[h][v4 * 4 + 1] - mu[h]) * rstd[h] * w4.y + b4.y;
                o.z = (z[h][v4 * 4 + 2] - mu[h]) * rstd[h] * w4.z + b4.z; o.w = (z[h][v4 * 4 + 3] - mu[h]) * rstd[h] * w4.w + b4.w;
                if (!nxt) *(float4*)(xo + k) = o;
                else *(uint2*)((bf16_t*)xo + k) = make_uint2(pk_bf16(o.x, o.y), pk_bf16(o.z, o.w));
                if (nxt) {
                    const float4 sc = scr[v4], sh = shr[v4];
                    uint2 pk; pk.x = pk_bf16(o.x * (1.f + sc.x) + sh.x, o.y * (1.f + sc.y) + sh.y); pk.y = pk_bf16(o.z * (1.f + sc.z) + sh.z, o.w * (1.f + sc.w) + sh.w);
                    *(uint2*)(u1 + (size_t)r * 1024 + k) = pk;
                }
            }
        }
    }
    __syncthreads();
}

#define XB_TMO      128
#define XB_XCNT(j)  (256  + 64 * (j))
#define XB_XSUB(j)  (1280 + 64 * (j))
#define XB_XGEN(j)  (2304 + 64 * (j))
#define XB_TOP      3328
#define XB_TOPGEN   3392
#define XCD_BAR_WORDS 3456
#define XB_SPIN_CAP (1u << 18)
#define LAS __attribute__((address_space(3)))

__device__ __forceinline__ unsigned xb_ld(unsigned* p)              { return __hip_atomic_load(p, __ATOMIC_RELAXED, __HIP_MEMORY_SCOPE_AGENT); }
__device__ __forceinline__ unsigned xb_add(unsigned* p, unsigned v) { return __hip_atomic_fetch_add(p, v, __ATOMIC_RELAXED, __HIP_MEMORY_SCOPE_AGENT); }
__device__ __forceinline__ unsigned xb_xcc_id() { return (unsigned)__builtin_amdgcn_s_getreg((3 << 11) | 20) & 0xFu; }
#define XB_SPIN(cond, bar) do { unsigned _sp = 0; while (cond) { __builtin_amdgcn_s_sleep(1); \
    if ((++_sp & 255u) == 0u) { if (xb_ld(&(bar)[XB_TMO])) break; if (_sp > XB_SPIN_CAP) { atomicAdd(&(bar)[XB_TMO], 1u); break; } } } } while (0)

struct XcdBarrier {
    unsigned* bar; unsigned x;
    volatile LAS unsigned* st;
};

__device__ __forceinline__ XcdBarrier xcd_barrier_post(unsigned* bar, volatile LAS unsigned* st) {
    XcdBarrier b; b.bar = bar; b.x = xb_xcc_id(); b.st = st;
    if (threadIdx.x == 0) (void)xb_add(&bar[XB_XCNT(b.x)], 1u);
    return b;
}
__device__ __forceinline__ void xcd_barrier_complete(unsigned* bar, unsigned x, unsigned& nloc, unsigned& nx) {
    const unsigned G = gridDim.x * gridDim.y * gridDim.z;
    unsigned sum, cnt, mine, sp = 0u;
    for (;;) {
        sum = 0u; cnt = 0u; mine = 0u;
#pragma unroll
        for (unsigned j = 0; j < 16; ++j) { const unsigned c = xb_ld(&bar[XB_XCNT(j)]); sum += c; cnt += (c > 0u) ? 1u : 0u; mine = (j == x) ? c : mine; }
        if (sum == G) break;
        __builtin_amdgcn_s_sleep(1);
        if ((++sp & 255u) == 0u) { if (xb_ld(&bar[XB_TMO])) break; if (sp > XB_SPIN_CAP) { atomicAdd(&bar[XB_TMO], 1u); break; } }
    }
    nloc = mine > 0u ? mine : 1u; nx = cnt > 0u ? cnt : 1u;
}

__device__ __forceinline__ void xcd_barrier(const XcdBarrier& b) {
    asm volatile("s_waitcnt vmcnt(0)" ::: "memory");
    __syncthreads();
    if (threadIdx.x == 0) {
        unsigned* bar = b.bar;
        __builtin_amdgcn_s_waitcnt(0);
        unsigned nloc = b.st[0], nx = b.st[1];
        if (nloc == 0u) { xcd_barrier_complete(bar, b.x, nloc, nx); b.st[0] = nloc; b.st[1] = nx; }
        const unsigned old = xb_add(&bar[XB_XSUB(b.x)], 1u);
        const unsigned gen = old / nloc;
        if (old + 1u == (gen + 1u) * nloc) {
            __builtin_amdgcn_fence(__ATOMIC_RELEASE, "agent");
            asm volatile("s_waitcnt vmcnt(0)" ::: "memory");
            const unsigned og = xb_add(&bar[XB_TOP], 1u);
            const unsigned tg = og / nx;
            if (og + 1u == (tg + 1u) * nx) xb_add(&bar[XB_TOPGEN], 1u);
            else XB_SPIN(xb_ld(&bar[XB_TOPGEN]) == tg, bar);
            __builtin_amdgcn_fence(__ATOMIC_ACQUIRE, "agent");
            xb_add(&bar[XB_XGEN(b.x)], 1u);
            asm volatile("s_waitcnt vmcnt(0)" ::: "memory");
        } else {
            XB_SPIN(xb_ld(&bar[XB_XGEN(b.x)]) == gen, bar);
            __builtin_amdgcn_fence(__ATOMIC_ACQUIRE, "agent");
            asm volatile("s_waitcnt vmcnt(0)" ::: "memory");
        }
    }
    __syncthreads();
}

__global__ void __launch_bounds__(NT, 2) mega(P p, int lo, int hi) {
    extern __shared__ __attribute__((aligned(16))) unsigned char smem_raw[];
    float* sm = (float*)smem_raw;
    cg::grid_group grid = cg::this_grid();
    volatile LAS unsigned* xb_st = (volatile LAS unsigned*)(smem_raw + 128 * 1024);
    if (threadIdx.x < 4) xb_st[threadIdx.x] = 0u;
    __syncthreads();
    const XcdBarrier xbar = xcd_barrier_post((unsigned*)(p.ws + WS_BAR), xb_st);
#define GRID_SYNC(k) do { if (hi > 1000000) grid.sync(); else xcd_barrier(xbar); } while (0)
#ifdef PROBE_MASK
    unsigned tacc_ = 0, t0_ = 0;
    const bool timer_ = (blockIdx.x == 0);
#define STEP(k, body) do { const int k_ = (k); if (lo <= k_ && k_ < hi) { if (timer_) t0_ = (unsigned)__builtin_amdgcn_s_memrealtime(); body; if (k_ + 1 < hi) GRID_SYNC(k_); \
        if (timer_ && ((PROBE_MASK >> (k_ == 0 ? 0 : 1 + (k_ - 1) % 13)) & 1)) tacc_ += (unsigned)__builtin_amdgcn_s_memrealtime() - t0_; } } while (0)
#else
#define STEP(k, body) do { const int k_ = (k); if (lo <= k_ && k_ < hi) { body; if (k_ + 1 < hi) GRID_SYNC(k_); } } while (0)
#endif
    STEP(0, { phase_mod(p, sm); phase_wprep(p, sm); });
#pragma unroll 1
    for (int l = 0; l < 2; ++l) {
        const int s0 = 1 + 13 * l;
        if (l == 0) STEP(s0 + 0, phase_u1prep(p, l));
        STEP(s0 + 1, phase_inproj(p, l, smem_raw));
        STEP(s0 + 2, { phase_conv(p, l, sm); phase_vtrans(p, smem_raw); });
        STEP(s0 + 3, { phase_gatescan(p, l, sm); __syncthreads(); phase_mlstm(p, l, smem_raw); __syncthreads(); phase_na(p, l, smem_raw); phase_tabprep(p, l, smem_raw); });
        STEP(s0 + 4, phase_combine(p, l));
        STEP(s0 + 5, phase_outproj(p, l, smem_raw));
        STEP(s0 + 6, phase_ln1(p, l));
        STEP(s0 + 7, phase_peerq(p, l, smem_raw));
        STEP(s0 + 8, phase_topk(p, l, smem_raw));
        STEP(s0 + 9, phase_eslice<0>(p, l, smem_raw));
        STEP(s0 + 10, phase_ecoef(p, l, smem_raw));
        STEP(s0 + 11, phase_e2lds(p, l, smem_raw));
        STEP(s0 + 12, phase_eln(p, l, sm));
    }
#undef STEP
#ifdef PROBE_MASK
    if (timer_) { const unsigned te = (unsigned)__builtin_amdgcn_s_memrealtime(); while ((unsigned)__builtin_amdgcn_s_memrealtime() - te < 8u * tacc_) __builtin_amdgcn_s_sleep(32); }
#endif
}

extern "C" void kernel_launch(void* const* d_in, const int* in_sizes, int n_in, void* d_out, int out_size, void* d_ws,
                              size_t ws_size, hipStream_t stream) {
    static int grid_blocks = 0;
    if (!grid_blocks) {
        int dev = 0, cus = 0, per_cu = 0;
        hipGetDevice(&dev);
        hipDeviceGetAttribute(&cus, hipDeviceAttributeMultiprocessorCount, dev);
        hipFuncSetAttribute((const void*)mega, hipFuncAttributeMaxDynamicSharedMemorySize, LDS_BYTES);
        hipOccupancyMaxActiveBlocksPerMultiprocessor(&per_cu, (const void*)mega, NT, LDS_BYTES);
        if (per_cu < 1) per_cu = 1;
        grid_blocks = cus * per_cu;
        if (ws_size < WS_END) fprintf(stderr, "kernel_launch: workspace too small: %zu < %zu\n", ws_size, (size_t)WS_END);
    }
    P p{};
    const float** pp = (const float**)&p;
    for (int i = 0; i < 20; ++i) pp[i] = (const float*)d_in[i];
    p.out = (float*)d_out;
    p.ws = (unsigned char*)d_ws;
    hipMemsetAsync((unsigned char*)d_ws + WS_BAR, 0, (WS_CNT - WS_BAR) + 8192, stream);
#if SINGLE_LAUNCH
    int lo = 0, hi = NSTEPS;
    void* args[] = {&p, &lo, &hi};
    hipError_t e = hipLaunchCooperativeKernel((const void*)mega, dim3(grid_blocks), dim3(NT), args, LDS_BYTES, stream);
    if (e != hipSuccess) fprintf(stderr, "cooperative launch failed: %s (grid %d)\n", hipGetErrorString(e), grid_blocks);
#else
    for (int s = 0; s < NSTEPS; ++s) {
        int lo = s, hi = s + 1;
        void* args[] = {&p, &lo, &hi};
        hipError_t e = hipLaunchCooperativeKernel((const void*)mega, dim3(grid_blocks), dim3(NT), args, LDS_BYTES, stream);
        if (e != hipSuccess) fprintf(stderr, "launch %d failed: %s (grid %d)\n", s, hipGetErrorString(e), grid_blocks);
    }
#endif
}
```
